# Optimizing an MI355X kernel written in HIP

```python
import jax, jax.numpy as jnp
from jax import lax
import numpy as np

D_MODEL = 1024
BATCH = 8
SEQ = 2048
DEPTH = 2

GRID_W = 64
Q_BLOCK = 128
HEAD_DIM = 64
ROPE_THETA = 10000.0
RMS_EPS = 1e-6
LN_EPS = 1e-5
A_HEADS = 4
A_KV_HEADS = 2
B_HEADS = 4
NA_WIN_H = 8
NA_WIN_W = 16
C_HEADS = 4
C_NOPE = 64
C_ROPE = 32
C_V = 64
C_Q_RANK = 192
C_KV_RANK = 128
D_CH = 256
CONV_W = 31
N_BRANCH = 4
MIX_W = 256
D_FF = 2816
N_EXPERTS = 8
TOP_K = 2
D_FF_EXPERT = 3584
ALPHA = (2 * DEPTH) ** 0.25
BETA = (8 * DEPTH) ** -0.25
D_IN = ((A_HEADS + 2 * A_KV_HEADS) * HEAD_DIM + 3 * B_HEADS * HEAD_DIM
        + C_Q_RANK + C_KV_RANK + C_ROPE + 2 * D_CH + N_BRANCH * D_MODEL)

kernel_name = 'hybrid_gated_encoder_block'


def _split_points():
    sizes = (A_HEADS * HEAD_DIM, A_KV_HEADS * HEAD_DIM, A_KV_HEADS * HEAD_DIM,
             B_HEADS * HEAD_DIM, B_HEADS * HEAD_DIM, B_HEADS * HEAD_DIM,
             C_Q_RANK, C_KV_RANK, C_ROPE, 2 * D_CH, N_BRANCH * D_MODEL)
    return [int(v) for v in np.cumsum(sizes)[:-1]]


def layer_norm(x, g, b):
    xf = x.astype(jnp.float32)
    mu = jnp.mean(xf, axis=-1, keepdims=True)
    var = jnp.mean(jnp.square(xf - mu), axis=-1, keepdims=True)
    return ((xf - mu) * lax.rsqrt(var + LN_EPS) * g.astype(jnp.float32) + b.astype(jnp.float32)).astype(x.dtype)


def rms_norm(x, g):
    xf = x.astype(jnp.float32)
    return (xf * lax.rsqrt(jnp.mean(xf * xf, axis=-1, keepdims=True) + RMS_EPS) * g.astype(jnp.float32)).astype(x.dtype)


def axial_rope(seq, rot_dim):
    t = jnp.arange(seq)
    row = (t // GRID_W).astype(jnp.float32)
    col = (t % GRID_W).astype(jnp.float32)
    n_freq = rot_dim // 4
    inv = ROPE_THETA ** (-jnp.arange(n_freq, dtype=jnp.float32) / n_freq)
    ang = jnp.concatenate([row[:, None] * inv, col[:, None] * inv], axis=-1)
    return jnp.cos(ang), jnp.sin(ang)


def apply_rope(x, cos, sin):
    extra = x.ndim - 3
    c = cos.reshape(cos.shape[:1] + (1,) * extra + cos.shape[1:])
    s = sin.reshape(sin.shape[:1] + (1,) * extra + sin.shape[1:])
    xf = x.astype(jnp.float32)
    x1, x2 = xf[..., 0::2], xf[..., 1::2]
    out = jnp.stack([x1 * c - x2 * s, x1 * s + x2 * c], axis=-1).reshape(x.shape)
    return out.astype(x.dtype)


def block_attention(q, k, v):
    b, s, kvh, g, dk = q.shape
    nblk = s // Q_BLOCK
    scale = dk ** -0.5
    qb = q.reshape(b, nblk, Q_BLOCK, kvh, g, dk).transpose(1, 0, 2, 3, 4, 5)

    def one_block(qi):
        sc = jnp.einsum('bqhgd,bkhd->bhgqk', qi, k, preferred_element_type=jnp.float32) * scale
        p = jax.nn.softmax(sc, axis=-1)
        return jnp.einsum('bhgqk,bkhd->bqhgd', p.astype(v.dtype), v)

    out = lax.map(one_block, qb)
    return out.transpose(1, 0, 2, 3, 4, 5).reshape(b, s, kvh, g, v.shape[-1])


def neighbourhood_attention(q, k, v, rpb):
    b, s, h, d = q.shape
    rows = s // GRID_W
    wh = min(NA_WIN_H, rows)
    r = jnp.arange(rows)
    c = jnp.arange(GRID_W)
    row_start = jnp.clip(r - wh // 2, 0, rows - wh)
    key_rows = row_start[:, None] + jnp.arange(wh)[None, :]
    col_start = jnp.clip(c - NA_WIN_W // 2, 0, GRID_W - NA_WIN_W)
    col_ok = (c[None, :] >= col_start[:, None]) & (c[None, :] < col_start[:, None] + NA_WIN_W)
    qg = q.reshape(b, rows, GRID_W, h, d)
    kg = k.reshape(b, rows, GRID_W, h, d)[:, key_rows]
    vg = v.reshape(b, rows, GRID_W, h, d)[:, key_rows]
    sc = jnp.einsum('brqhd,brwkhd->bhrqwk', qg, kg, preferred_element_type=jnp.float32) * (d ** -0.5)
    dr_idx = key_rows - r[:, None] + (NA_WIN_H - 1)
    dc_idx = jnp.clip(c[None, :] - c[:, None] + (NA_WIN_W - 1), 0, 2 * NA_WIN_W - 2)
    bias = rpb[:, dr_idx[:, None, :, None], dc_idx[None, :, None, :]]
    sc = sc + bias.astype(jnp.float32)[None]
    sc = jnp.where(col_ok[:, None, :], sc, -jnp.inf)
    p = jax.nn.softmax(sc, axis=(-2, -1))
    out = jnp.einsum('bhrqwk,brwkhd->brqhd', p.astype(v.dtype), vg)
    return out.reshape(b, s, h * d)


def hybrid_mixer(x, w_in, a_q_norm, a_k_norm, b_rpb, c_q_norm, c_kv_norm, c_w_uq, c_w_ukv,
                 d_conv_w, d_conv_b, d_ln_g, d_ln_b, w_branch, w_out, rope_a, rope_c):
    b, s, _ = x.shape
    h = x @ w_in
    (a_q, a_k, a_v, b_q, b_k, b_v, c_cq, c_ckv, c_kpe, d_glu, gate_logits) = jnp.split(h, _split_points(), axis=-1)

    qa = apply_rope(rms_norm(a_q.reshape(b, s, A_HEADS, HEAD_DIM), a_q_norm), *rope_a)
    ka = apply_rope(rms_norm(a_k.reshape(b, s, A_KV_HEADS, HEAD_DIM), a_k_norm), *rope_a)
    va = a_v.reshape(b, s, A_KV_HEADS, HEAD_DIM)
    qa = qa.reshape(b, s, A_KV_HEADS, A_HEADS // A_KV_HEADS, HEAD_DIM)
    y_a = block_attention(qa, ka, va).reshape(b, s, MIX_W)

    y_b = neighbourhood_attention(b_q.reshape(b, s, B_HEADS, HEAD_DIM),
                                  b_k.reshape(b, s, B_HEADS, HEAD_DIM),
                                  b_v.reshape(b, s, B_HEADS, HEAD_DIM), b_rpb)

    q_c = (rms_norm(c_cq, c_q_norm) @ c_w_uq).reshape(b, s, C_HEADS, C_NOPE + C_ROPE)
    q_nope = q_c[..., :C_NOPE]
    q_pe = apply_rope(q_c[..., C_NOPE:], *rope_c)
    kv_c = (rms_norm(c_ckv, c_kv_norm) @ c_w_ukv).reshape(b, s, C_HEADS, C_NOPE + C_V)
    k_nope = kv_c[..., :C_NOPE]
    v_c = kv_c[..., C_NOPE:]
    k_pe = apply_rope(c_kpe, *rope_c)
    q_full = jnp.concatenate([q_nope, q_pe], axis=-1)[:, :, :, None, :]
    k_full = jnp.concatenate([k_nope, jnp.broadcast_to(k_pe[:, :, None, :], (b, s, C_HEADS, C_ROPE))], axis=-1)
    y_c = block_attention(q_full, k_full, v_c).reshape(b, s, MIX_W)

    u = d_glu[..., :D_CH] * jax.nn.sigmoid(d_glu[..., D_CH:])
    u = lax.conv_general_dilated(u, d_conv_w, window_strides=(1,), padding=[(CONV_W // 2, CONV_W // 2)],
                                 dimension_numbers=('NWC', 'WIO', 'NWC'), feature_group_count=D_CH) + d_conv_b
    y_d = jax.nn.silu(layer_norm(u, d_ln_g, d_ln_b))

    ys = jnp.stack([y_a, y_b, y_c, y_d], axis=2)
    branches = jnp.einsum('bsnc,ncd->bsnd', ys, w_branch)
    gates = jax.nn.sigmoid(gate_logits.reshape(b, s, N_BRANCH, D_MODEL))
    merged = jnp.sum(gates * branches, axis=2)
    return merged @ w_out


def swiglu(x, w1, w3, w2):
    return (jax.nn.silu(x @ w1) * (x @ w3)) @ w2


def moe_swiglu(x, router, w1, w3, w2):
    logits = jnp.einsum('bsd,de->bse', x.astype(jnp.float32), router.astype(jnp.float32))
    top_logit, top_idx = lax.top_k(logits, TOP_K)
    top_w = jax.nn.softmax(top_logit, axis=-1)
    gate = jnp.sum(jax.nn.one_hot(top_idx, N_EXPERTS, dtype=jnp.float32) * top_w[..., None], axis=-2)
    gate = gate.astype(x.dtype)
    out = jnp.zeros_like(x)
    for e in range(N_EXPERTS):
        out = out + gate[..., e:e + 1] * swiglu(x, w1[e], w3[e], w2[e])
    return out


def setup_inputs(seed: int = 0) -> dict:
    key = jax.random.key(seed)
    ks = jax.random.split(key, 28)

    def nrm(k, shape, scale):
        return jax.random.normal(k, shape, jnp.float32) * scale

    def gain(k, shape):
        return 1.0 + 0.05 * jax.random.normal(k, shape, jnp.float32)

    n_dense = (DEPTH + 1) // 2
    n_moe = DEPTH // 2
    return {
        'x': nrm(ks[0], (BATCH, SEQ, D_MODEL), 1.0),
        'ln_in_g': gain(ks[1], (D_MODEL,)),
        'ln_in_b': nrm(ks[2], (D_MODEL,), 0.02),
        'w_in': nrm(ks[3], (DEPTH, D_MODEL, D_IN), D_MODEL ** -0.5),
        'a_q_norm': gain(ks[4], (DEPTH, HEAD_DIM)),
        'a_k_norm': gain(ks[5], (DEPTH, HEAD_DIM)),
        'b_rpb': nrm(ks[6], (DEPTH, B_HEADS, 2 * NA_WIN_H - 1, 2 * NA_WIN_W - 1), 0.1),
        'c_q_norm': gain(ks[7], (DEPTH, C_Q_RANK)),
        'c_kv_norm': gain(ks[8], (DEPTH, C_KV_RANK)),
        'c_w_uq': nrm(ks[9], (DEPTH, C_Q_RANK, C_HEADS * (C_NOPE + C_ROPE)), C_Q_RANK ** -0.5),
        'c_w_ukv': nrm(ks[10], (DEPTH, C_KV_RANK, C_HEADS * (C_NOPE + C_V)), C_KV_RANK ** -0.5),
        'd_conv_w': nrm(ks[11], (DEPTH, CONV_W, 1, D_CH), CONV_W ** -0.5),
        'd_conv_b': nrm(ks[12], (DEPTH, D_CH), 0.02),
        'd_ln_g': gain(ks[13], (DEPTH, D_CH)),
        'd_ln_b': nrm(ks[14], (DEPTH, D_CH), 0.02),
        'w_branch': nrm(ks[15], (DEPTH, N_BRANCH, MIX_W, D_MODEL), MIX_W ** -0.5),
        'w_out': nrm(ks[16], (DEPTH, D_MODEL, D_MODEL), BETA * D_MODEL ** -0.5),
        'ln_mix_g': gain(ks[17], (DEPTH, D_MODEL)),
        'ln_mix_b': nrm(ks[18], (DEPTH, D_MODEL), 0.02),
        'ffn_w1': nrm(ks[19], (n_dense, D_MODEL, D_FF), D_MODEL ** -0.5),
        'ffn_w3': nrm(ks[20], (n_dense, D_MODEL, D_FF), D_MODEL ** -0.5),
        'ffn_w2': nrm(ks[21], (n_dense, D_FF, D_MODEL), BETA * D_FF ** -0.5),
        'moe_router': nrm(ks[22], (n_moe, D_MODEL, N_EXPERTS), D_MODEL ** -0.5),
        'moe_w1': nrm(ks[23], (n_moe, N_EXPERTS, D_MODEL, D_FF_EXPERT), D_MODEL ** -0.5),
        'moe_w3': nrm(ks[24], (n_moe, N_EXPERTS, D_MODEL, D_FF_EXPERT), D_MODEL ** -0.5),
        'moe_w2': nrm(ks[25], (n_moe, N_EXPERTS, D_FF_EXPERT, D_MODEL), BETA * D_FF_EXPERT ** -0.5),
        'ln_ffn_g': gain(ks[26], (DEPTH, D_MODEL)),
        'ln_ffn_b': nrm(ks[27], (DEPTH, D_MODEL), 0.02),
    }


def reference(x, ln_in_g, ln_in_b, w_in, a_q_norm, a_k_norm, b_rpb, c_q_norm, c_kv_norm, c_w_uq, c_w_ukv,
              d_conv_w, d_conv_b, d_ln_g, d_ln_b, w_branch, w_out, ln_mix_g, ln_mix_b,
              ffn_w1, ffn_w3, ffn_w2, moe_router, moe_w1, moe_w3, moe_w2, ln_ffn_g, ln_ffn_b):
    s = x.shape[1]
    rope_a = axial_rope(s, HEAD_DIM)
    rope_c = axial_rope(s, C_ROPE)
    x = layer_norm(x, ln_in_g, ln_in_b)
    for l in range(DEPTH):
        mix = hybrid_mixer(x, w_in[l], a_q_norm[l], a_k_norm[l], b_rpb[l], c_q_norm[l], c_kv_norm[l],
                           c_w_uq[l], c_w_ukv[l], d_conv_w[l], d_conv_b[l], d_ln_g[l], d_ln_b[l],
                           w_branch[l], w_out[l], rope_a, rope_c)
        x = layer_norm(ALPHA * x + mix, ln_mix_g[l], ln_mix_b[l])
        if l % 2 == 0:
            f = swiglu(x, ffn_w1[l // 2], ffn_w3[l // 2], ffn_w2[l // 2])
        else:
            f = moe_swiglu(x, moe_router[l // 2], moe_w1[l // 2], moe_w3[l // 2], moe_w2[l // 2])
        x = layer_norm(ALPHA * x + f, ln_ffn_g[l], ln_ffn_b[l])
    return x
```

```cpp
#include <hip/hip_runtime.h>
#include <cstdio>
#include <cstdint>

#define LAS __attribute__((address_space(3)))
#define GAS __attribute__((address_space(1)))
typedef unsigned short bf16;
typedef short bf16x8 __attribute__((ext_vector_type(8)));
typedef short s16x4 __attribute__((ext_vector_type(4)));
typedef float f32x2 __attribute__((ext_vector_type(2)));
typedef float f32x4 __attribute__((ext_vector_type(4)));
typedef float f32x16 __attribute__((ext_vector_type(16)));
typedef unsigned u32x2 __attribute__((ext_vector_type(2)));
typedef unsigned u32x4 __attribute__((ext_vector_type(4)));
typedef GAS unsigned gu32;

__device__ __forceinline__ int lane_id_v() { int l; asm volatile("v_mbcnt_lo_u32_b32 %0, -1, 0\n\tv_mbcnt_hi_u32_b32 %0, -1, %0" : "=v"(l)); return l; }

constexpr int BATCH = 8, SEQ = 2048, DM = 1024, M = BATCH * SEQ, DEPTH = 2;
constexpr int GRIDW = 64, NROWS = SEQ / GRIDW;
constexpr int D_IN = 6240, NW_IN = 6400;
constexpr int HP = 2048;
constexpr int D_FF = 2816, D_FFE = 3584, NEXP = 8;
constexpr int OFF_AQ = 0, OFF_AK = 256, OFF_AV = 384, OFF_BQ = 512, OFF_BK = 768, OFF_BV = 1024, OFF_CQ = 1280, OFF_CKV = 1472, OFF_KPE = 1600, OFF_GLU = 1632, OFF_GATE = 2144;
constexpr float LOG2E = 1.4426950408889634f;
constexpr float ALPHA = 1.4142135623730951f;
constexpr float LN_EPS = 1e-5f, RMS_EPS = 1e-6f;
constexpr float QS64 = 0.125f * LOG2E;
constexpr float QS96 = 0.10206207261596575f * LOG2E;
constexpr int MAXTILES = 136, MAXSLOTS = MAXTILES * 256;

namespace pg8 {
constexpr int BM = 256, BK = 64, HALF = 128, HTB = HALF * BK * 2, STAGE_BYTES = 8 * HTB, NXCD = 8, WGM = 8;
__host__ __device__ __forceinline__ int lds_byte(int r, int c) { const int st = (r >> 4) * 2 + (c >> 5), rr = r & 15, cc = c & 31, ob = rr * 64 + cc * 2; return st * 1024 + (ob ^ (((ob >> 9) & 1) << 5)); }
__host__ __device__ __forceinline__ void stage_rc(int b, int& R, int& C) { const int st = b / 1024, sb = b % 1024, swz = sb ^ (((sb >> 9) & 1) << 5); R = (st >> 1) * 16 + swz / 64; C = (st & 1) * 32 + (swz % 64) / 2; }
__host__ __device__ __forceinline__ int perm32(int rho) { const int n = rho >> 4, i = rho & 15; return 8 * (i >> 2) + 4 * n + (i & 3); }

struct Unit { int pm, pn, aux; size_t ao, bo; };
struct Gemm { const bf16* A; const bf16* Bt; int K; };

__device__ __forceinline__ bool tile_of(long L, int nM, int nN, int& pm, int& pn) {
    const int nwg = nM * nN; if (L >= nwg) return false;
    int wgid = (int)L; { const int q = nwg / NXCD, r = nwg % NXCD, xcd = wgid % NXCD, off = wgid / NXCD; wgid = (xcd < r ? xcd * (q + 1) : r * (q + 1) + (xcd - r) * q) + off; }
    const int nig = WGM * nN, gid = wgid / nig, fm = gid * WGM, gsz = (nM - fm) < WGM ? (nM - fm) : WGM;
    pm = fm + ((wgid % nig) % gsz); pn = (wgid % nig) / gsz; return true;
}
struct SchedPlain {
    int nM, nN, G, c; size_t ts;
    __device__ __forceinline__ void init(int nM_, int nN_, int K, int G_, int c_) { nM = nM_; nN = nN_; G = G_; c = c_; ts = (size_t)BM * K * 2; }
    __device__ __forceinline__ bool next(int i, Unit& u) const { if (!tile_of((long)i * G + c, nM, nN, u.pm, u.pn)) return false; u.aux = 0; u.ao = (size_t)u.pm * ts; u.bo = (size_t)u.pn * ts; return true; }
};
struct SchedGroup {
    int nM, nN, G, c; size_t ts; const LAS unsigned char* tile_e;
    __device__ __forceinline__ void init(int nM_, int nN_, int K, int G_, int c_, const LAS unsigned char* te) { nM = nM_; nN = nN_; G = G_; c = c_; ts = (size_t)BM * K * 2; tile_e = te; }
    __device__ __forceinline__ bool next(int i, Unit& u) const { if (!tile_of((long)i * G + c, nM, nN, u.pm, u.pn)) return false;
        const int e = __builtin_amdgcn_readfirstlane((int)tile_e[u.pm]); u.aux = e; u.ao = (size_t)u.pm * ts; u.bo = ((size_t)e * nN + u.pn) * ts; return true; }
};
struct SchedMerge {
    int G, c;
    __device__ __forceinline__ void init(int G_, int c_) { G = G_; c = c_; }
    __device__ __forceinline__ bool next(int i, Unit& u) const { if (!tile_of((long)(i >> 2) * G + c, M / BM, DM / BM, u.pm, u.pn)) return false;
        const int n = i & 3; u.aux = n; u.ao = ((size_t)n * M + (size_t)u.pm * BM) * 256 * 2; u.bo = ((size_t)n * DM + (size_t)u.pn * BM) * 256 * 2; return true; }
};

typedef __bf16 bf16x2_t __attribute__((ext_vector_type(2)));
__device__ __forceinline__ unsigned cvt_pk_bf16(float lo, float hi) { const f32x2 v = {lo, hi}; const bf16x2_t b = __builtin_convertvector(v, bf16x2_t); return __builtin_bit_cast(unsigned, b); }
__device__ __forceinline__ float bf_lo(unsigned w) { return __uint_as_float(w << 16); }
__device__ __forceinline__ float bf_hi(unsigned w) { return __uint_as_float(w & 0xffff0000u); }
__device__ __forceinline__ float sigmoidf_(float x) { return __builtin_amdgcn_rcpf(1.0f + __builtin_amdgcn_exp2f(-LOG2E * x)); }

typedef f32x4 Acc[2][2][4][2];

struct EpiWin {
    static constexpr bool PERM = true;
    bf16* H; bf16* Gt;
    __device__ __forceinline__ bool operator()(Acc& acc, const Unit& u, int wr, int wc, int fr, int fq) const {
        const int row0 = u.pm * BM + wr * 64 + fr, pn = u.pn, cw = wc * 32 + 8 * fq;
        if (pn < 7) {
            const float sc = (pn == 2) ? QS64 : 1.0f;
#pragma unroll
            for (int ai = 0; ai < 2; ++ai)
#pragma unroll
                for (int m = 0; m < 4; ++m) { bf16* rowp = H + (size_t)(row0 + ai * HALF + m * 16) * HP + pn * BM + cw;
#pragma unroll
                    for (int bj = 0; bj < 2; ++bj) { const f32x4 v0 = acc[ai][bj][m][0] * sc, v1 = acc[ai][bj][m][1] * sc;
                        u32x4 w; w.x = cvt_pk_bf16(v0[0], v0[1]); w.y = cvt_pk_bf16(v0[2], v0[3]); w.z = cvt_pk_bf16(v1[0], v1[1]); w.w = cvt_pk_bf16(v1[2], v1[3]);
                        *(u32x4*)(rowp + bj * HALF) = w; } }
        } else if (pn < 9) {
#pragma unroll
            for (int ai = 0; ai < 2; ++ai)
#pragma unroll
                for (int m = 0; m < 4; ++m) { bf16* rowp = H + (size_t)(row0 + ai * HALF + m * 16) * HP + 1792 + (pn - 7) * HALF + cw;
                    float o[8];
#pragma unroll
                    for (int n = 0; n < 2; ++n)
#pragma unroll
                        for (int e = 0; e < 4; ++e) o[n * 4 + e] = acc[ai][0][m][n][e] * sigmoidf_(acc[ai][1][m][n][e]);
                    u32x4 w; w.x = cvt_pk_bf16(o[0], o[1]); w.y = cvt_pk_bf16(o[2], o[3]); w.z = cvt_pk_bf16(o[4], o[5]); w.w = cvt_pk_bf16(o[6], o[7]);
                    *(u32x4*)rowp = w; }
        } else {
#pragma unroll
            for (int ai = 0; ai < 2; ++ai)
#pragma unroll
                for (int m = 0; m < 4; ++m) { bf16* rowp = Gt + (size_t)(row0 + ai * HALF + m * 16) * 4096 + (pn - 9) * BM + cw;
#pragma unroll
                    for (int bj = 0; bj < 2; ++bj) { float o[8];
#pragma unroll
                        for (int n = 0; n < 2; ++n)
#pragma unroll
                            for (int e = 0; e < 4; ++e) o[n * 4 + e] = sigmoidf_(acc[ai][bj][m][n][e]);
                        u32x4 w; w.x = cvt_pk_bf16(o[0], o[1]); w.y = cvt_pk_bf16(o[2], o[3]); w.z = cvt_pk_bf16(o[4], o[5]); w.w = cvt_pk_bf16(o[6], o[7]);
                        *(u32x4*)(rowp + bj * HALF) = w; } }
        }
        return false;
    }
};
struct EpiUq {
    static constexpr bool PERM = true;
    bf16* QC; const float* cosC; const float* sinC;
    __device__ __forceinline__ bool operator()(Acc& acc, const Unit& u, int wr, int wc, int fr, int fq) const {
        const int row0 = u.pm * BM + wr * 64 + fr;
#pragma unroll
        for (int bj = 0; bj < 2; ++bj) { const int cb = u.pn * BM + bj * HALF + wc * 32; if (cb >= 384) continue;
            const int hh = cb / 96, jb = cb - hh * 96; const bool rot = (jb == 64); const int i0 = 4 * fq, c0 = cb + 8 * fq; (void)hh;
#pragma unroll
            for (int ai = 0; ai < 2; ++ai)
#pragma unroll
                for (int m = 0; m < 4; ++m) { const int row = row0 + ai * HALF + m * 16; f32x4 v0 = acc[ai][bj][m][0], v1 = acc[ai][bj][m][1];
                    if (rot) { const int s = row & (SEQ - 1); const f32x4 cs = *(const f32x4*)(cosC + s * 16 + i0), sn = *(const f32x4*)(sinC + s * 16 + i0);
                        const f32x4 a0 = v0, a1 = v1;
                        v0[0] = a0[0] * cs[0] - a0[1] * sn[0]; v0[1] = a0[0] * sn[0] + a0[1] * cs[0]; v0[2] = a0[2] * cs[1] - a0[3] * sn[1]; v0[3] = a0[2] * sn[1] + a0[3] * cs[1];
                        v1[0] = a1[0] * cs[2] - a1[1] * sn[2]; v1[1] = a1[0] * sn[2] + a1[1] * cs[2]; v1[2] = a1[2] * cs[3] - a1[3] * sn[3]; v1[3] = a1[2] * sn[3] + a1[3] * cs[3]; }
                    v0 = v0 * QS96; v1 = v1 * QS96;
                    u32x4 w; w.x = cvt_pk_bf16(v0[0], v0[1]); w.y = cvt_pk_bf16(v0[2], v0[3]); w.z = cvt_pk_bf16(v1[0], v1[1]); w.w = cvt_pk_bf16(v1[2], v1[3]);
                    *(u32x4*)(QC + (size_t)row * 384 + c0) = w; asm volatile("" ::: "memory"); } }
        return false;
    }
};
struct EpiUkv {
    static constexpr bool PERM = true;
    bf16* KC; bf16* VC;
    __device__ __forceinline__ bool operator()(Acc& acc, const Unit& u, int wr, int wc, int fr, int fq) const {
        const int row0 = u.pm * BM + wr * 64 + fr;
#pragma unroll
        for (int bj = 0; bj < 2; ++bj) { const int c0 = u.pn * BM + bj * HALF + wc * 32 + 8 * fq; const int hh = c0 >> 7, j = c0 & 127;
#pragma unroll
            for (int ai = 0; ai < 2; ++ai)
#pragma unroll
                for (int m = 0; m < 4; ++m) { const int row = row0 + ai * HALF + m * 16; const f32x4 v0 = acc[ai][bj][m][0], v1 = acc[ai][bj][m][1];
                    u32x4 w; w.x = cvt_pk_bf16(v0[0], v0[1]); w.y = cvt_pk_bf16(v0[2], v0[3]); w.z = cvt_pk_bf16(v1[0], v1[1]); w.w = cvt_pk_bf16(v1[2], v1[3]);
                    bf16* p = (j < 64) ? (KC + (size_t)row * 384 + hh * 96 + j) : (VC + (size_t)row * 256 + hh * 64 + (j - 64));
                    *(u32x4*)p = w; asm volatile("" ::: "memory"); } }
        return false;
    }
};
struct EpiMerge {
    static constexpr bool PERM = true;
    const bf16* Gt; bf16* MG;
    __device__ __forceinline__ bool operator()(Acc& acc, const Unit& u, int wr, int wc, int fr, int fq) const {
        const int row0 = u.pm * BM + wr * 64 + fr, n = u.aux, d0 = u.pn * BM + wc * 32 + 8 * fq;
        const float GMIN = 1e-18f;
#pragma unroll
        for (int ai = 0; ai < 2; ++ai)
#pragma unroll
            for (int m = 0; m < 4; ++m) { const int row = row0 + ai * HALF + m * 16; const bf16* gp = Gt + (size_t)row * 4096 + n * DM + d0;
#pragma unroll
                for (int bj = 0; bj < 2; ++bj) { const u32x4 ga = *(const u32x4*)(gp + bj * HALF);
                    float g[8] = {bf_lo(ga.x), bf_hi(ga.x), bf_lo(ga.y), bf_hi(ga.y), bf_lo(ga.z), bf_hi(ga.z), bf_lo(ga.w), bf_hi(ga.w)};
                    if (n < 3) { const u32x4 gb = *(const u32x4*)(gp + DM + bj * HALF);
                        const float h[8] = {bf_lo(gb.x), bf_hi(gb.x), bf_lo(gb.y), bf_hi(gb.y), bf_lo(gb.z), bf_hi(gb.z), bf_lo(gb.w), bf_hi(gb.w)};
#pragma unroll
                        for (int e = 0; e < 8; ++e) g[e] = fmaxf(g[e], GMIN) * __builtin_amdgcn_rcpf(fmaxf(h[e], GMIN));
#pragma unroll
                        for (int e = 0; e < 4; ++e) { acc[ai][bj][m][0][e] *= g[e]; acc[ai][bj][m][1][e] *= g[4 + e]; }
                    } else {
                        float o[8];
#pragma unroll
                        for (int e = 0; e < 4; ++e) { o[e] = acc[ai][bj][m][0][e] * fmaxf(g[e], GMIN); o[4 + e] = acc[ai][bj][m][1][e] * fmaxf(g[4 + e], GMIN); }
                        u32x4 w; w.x = cvt_pk_bf16(o[0], o[1]); w.y = cvt_pk_bf16(o[2], o[3]); w.z = cvt_pk_bf16(o[4], o[5]); w.w = cvt_pk_bf16(o[6], o[7]);
                        *(u32x4*)(MG + (size_t)row * DM + d0 + bj * HALF) = w; } }
                asm volatile("" ::: "memory"); }
        return n < 3;
    }
};
struct EpiRes {
    static constexpr bool PERM = false;
    const float* X; float* T;
    __device__ __forceinline__ bool operator()(Acc& acc, const Unit& u, int wr, int wc, int fr, int fq) const {
        const int row0 = u.pm * BM + wr * 64 + fr, col0 = u.pn * BM + wc * 32 + 4 * fq;
#pragma unroll
        for (int ai = 0; ai < 2; ++ai)
#pragma unroll
            for (int m = 0; m < 4; ++m) { const size_t off = (size_t)(row0 + ai * HALF + m * 16) * DM + col0;
#pragma unroll
                for (int bj = 0; bj < 2; ++bj)
#pragma unroll
                    for (int n = 0; n < 2; ++n) { const f32x4 x = *(const f32x4*)(X + off + bj * HALF + n * 16); *(f32x4*)(T + off + bj * HALF + n * 16) = x * ALPHA + acc[ai][bj][m][n]; }
                asm volatile("" ::: "memory"); }
        return false;
    }
};
struct EpiSwiGLU {
    static constexpr bool PERM = true;
    bf16* HID; int ld;
    __device__ __forceinline__ bool operator()(Acc& acc, const Unit& u, int wr, int wc, int fr, int fq) const {
        const int row0 = u.pm * BM + wr * 64 + fr, c0 = u.pn * HALF + wc * 32 + 8 * fq;
#pragma unroll
        for (int ai = 0; ai < 2; ++ai)
#pragma unroll
            for (int m = 0; m < 4; ++m) { float o[8];
#pragma unroll
                for (int n = 0; n < 2; ++n)
#pragma unroll
                    for (int e = 0; e < 4; ++e) { const float a = acc[ai][0][m][n][e]; o[n * 4 + e] = a * sigmoidf_(a) * acc[ai][1][m][n][e]; }
                u32x4 w; w.x = cvt_pk_bf16(o[0], o[1]); w.y = cvt_pk_bf16(o[2], o[3]); w.z = cvt_pk_bf16(o[4], o[5]); w.w = cvt_pk_bf16(o[6], o[7]);
                *(u32x4*)(HID + (size_t)(row0 + ai * HALF + m * 16) * ld + c0) = w; }
        return false;
    }
};
struct EpiO {
    static constexpr bool PERM = true;
    bf16* O;
    __device__ __forceinline__ bool operator()(Acc& acc, const Unit& u, int wr, int wc, int fr, int fq) const {
        const int row0 = u.pm * BM + wr * 64 + fr, c0 = u.pn * BM + wc * 32 + 8 * fq;
#pragma unroll
        for (int ai = 0; ai < 2; ++ai)
#pragma unroll
            for (int m = 0; m < 4; ++m) { bf16* rowp = O + (size_t)(row0 + ai * HALF + m * 16) * DM + c0;
#pragma unroll
                for (int bj = 0; bj < 2; ++bj) { const f32x4 v0 = acc[ai][bj][m][0], v1 = acc[ai][bj][m][1];
                    u32x4 w; w.x = cvt_pk_bf16(v0[0], v0[1]); w.y = cvt_pk_bf16(v0[2], v0[3]); w.z = cvt_pk_bf16(v1[0], v1[1]); w.w = cvt_pk_bf16(v1[2], v1[3]);
                    *(u32x4*)(rowp + bj * HALF) = w; } }
        return false;
    }
};
template <class Epi, class Sched, bool ALIGN_EPI = false, bool SP2 = false>
__device__ __forceinline__ void gemm_phase(LAS unsigned char* lds, const Gemm g, const Sched& S, const Epi& E, int wid_) {
    int wid = wid_; asm volatile("" : "+s"(wid));
    const int lane = lane_id_v(), tid = wid * 64 + lane, wr = wid >> 2, wc = wid & 3, fr = lane & 15, fq = lane >> 4;
    const int K = g.K, nt = K / BK;
    unsigned voffA[2], voffB[2];
#pragma unroll
    for (int i = 0; i < 2; ++i) { int R, C; stage_rc(tid * 16 + i * 8192, R, C); const int Rb = Epi::PERM ? ((R & ~31) + perm32(R & 31)) : R;
        voffA[i] = (unsigned)(R * K + C) * 2u; voffB[i] = (unsigned)(Rb * K + C) * 2u; }
    const size_t kstep = (size_t)(BK * 2);
    const size_t hstep = (size_t)HALF * K * 2;
    const unsigned ldsw = (unsigned)wid * 1024u;
    const int aoff = lds_byte(wr * 64 + fr, fq * 8), boff = lds_byte(wc * 32 + fr, fq * 8);
#define PG8_SA(b, h) (((b) * 2 + (h)) * HTB)
#define PG8_SB(b, h) ((4 + (b) * 2 + (h)) * HTB)
#define PG8_STAGE(bufoff, gbase, voff) do { _Pragma("unroll") for (int _i = 0; _i < 2; ++_i) \
        __builtin_amdgcn_global_load_lds((const unsigned*)((const char*)(gbase) + (voff)[_i]), (LAS unsigned*)(lds + (bufoff) + ldsw + _i * 8192), 16, 0, 0); } while (0)
#define PG8_LDA(dst, b, h) do { _Pragma("unroll") for (int m = 0; m < 4; ++m) _Pragma("unroll") for (int k = 0; k < 2; ++k) dst[m][k] = *(const LAS bf16x8*)(lds + PG8_SA(b, h) + aoff + m * 2048 + k * 1024); } while (0)
#define PG8_LDB(dst, b, h) do { _Pragma("unroll") for (int n = 0; n < 2; ++n) _Pragma("unroll") for (int k = 0; k < 2; ++k) dst[n][k] = *(const LAS bf16x8*)(lds + PG8_SB(b, h) + boff + n * 2048 + k * 1024); } while (0)
#define PG8_MMA(ai, bj, At, Bt) do { __builtin_amdgcn_s_setprio(1); _Pragma("unroll") for (int m = 0; m < 4; ++m) _Pragma("unroll") for (int n = 0; n < 2; ++n) _Pragma("unroll") for (int k = 0; k < 2; ++k) \
        acc[ai][bj][m][n] = __builtin_amdgcn_mfma_f32_16x16x32_bf16(Bt[n][k], At[m][k], acc[ai][bj][m][n], 0, 0, 0); __builtin_amdgcn_s_setprio(0); } while (0)
#define PG8_WAIT_V(n) asm volatile("s_waitcnt vmcnt(" #n ")" ::: "memory")
#define PG8_WAIT_L(n) asm volatile("s_waitcnt lgkmcnt(" #n ")" ::: "memory")
#define PG8_BAR __builtin_amdgcn_s_barrier()
#define PG8_SCHED __builtin_amdgcn_sched_barrier(0)
    Unit cur, nxt; int ui = 0;
    if (!S.next(0, cur)) return;
    Acc acc;
#pragma unroll
    for (int a = 0; a < 2; ++a)
#pragma unroll
        for (int b = 0; b < 2; ++b)
#pragma unroll
            for (int m = 0; m < 4; ++m)
#pragma unroll
                for (int n = 0; n < 2; ++n) acc[a][b][m][n] = (f32x4){0.f, 0.f, 0.f, 0.f};
    bf16x8 At[4][2], B0[2][2], B1[2][2];
    const char* cA = (const char*)g.A + cur.ao; const char* cB = (const char*)g.Bt + cur.bo;
    if constexpr (SP2) {
        PG8_STAGE(PG8_SB(0, 0), cB, voffB); PG8_STAGE(PG8_SB(0, 1), cB + hstep, voffB); PG8_STAGE(PG8_SA(0, 0), cA, voffA); PG8_STAGE(PG8_SA(0, 1), cA + hstep, voffA);
        if (wr == 1) PG8_BAR;
        PG8_WAIT_V(2); PG8_BAR;
        PG8_STAGE(PG8_SB(1, 0), cB + kstep, voffB); PG8_STAGE(PG8_SA(1, 0), cA + kstep, voffA); PG8_STAGE(PG8_SB(1, 1), cB + hstep + kstep, voffB);
        PG8_WAIT_V(6); PG8_BAR;
    } else {
        PG8_STAGE(PG8_SB(0, 0), cB, voffB); PG8_STAGE(PG8_SA(0, 0), cA, voffA); PG8_STAGE(PG8_SB(0, 1), cB + hstep, voffB); PG8_STAGE(PG8_SA(0, 1), cA + hstep, voffA);
        if (wr == 1) PG8_BAR;
        PG8_WAIT_V(4); PG8_BAR;
        PG8_STAGE(PG8_SB(1, 0), cB + kstep, voffB); PG8_STAGE(PG8_SA(1, 0), cA + kstep, voffA); PG8_STAGE(PG8_SB(1, 1), cB + hstep + kstep, voffB);
        PG8_WAIT_V(6); PG8_BAR;
    }
    for (;;) {
        const bool has_next = S.next(ui + 1, nxt);
        const char* nA = has_next ? (const char*)g.A + nxt.ao : cA; const char* nB = has_next ? (const char*)g.Bt + nxt.bo : cB;
        for (int t = 0; t < nt; t += 2) {
            const bool last = (t == nt - 2);
            const char* a1 = cA + (size_t)(t + 1) * kstep;
            const char* a2 = last ? nA : cA + (size_t)(t + 2) * kstep; const char* b2 = last ? nB : cB + (size_t)(t + 2) * kstep;
            const char* a3 = a2 + kstep; const char* b3 = b2 + kstep;
            if constexpr (SP2) {
            PG8_LDB(B0, 0, 0); PG8_LDB(B1, 0, 1); PG8_SCHED; PG8_LDA(At, 0, 0); PG8_STAGE(PG8_SA(1, 1), a1 + hstep, voffA);
            PG8_WAIT_V(8); PG8_WAIT_L(0); PG8_BAR; PG8_MMA(0, 0, At, B0); PG8_MMA(0, 1, At, B1); PG8_BAR; PG8_SCHED;
            PG8_LDA(At, 0, 1); PG8_STAGE(PG8_SB(0, 0), b2, voffB); PG8_STAGE(PG8_SB(0, 1), b2 + hstep, voffB); PG8_STAGE(PG8_SA(0, 0), a2, voffA);
            PG8_WAIT_V(8); PG8_WAIT_L(0); PG8_BAR; PG8_MMA(1, 0, At, B0); PG8_MMA(1, 1, At, B1); PG8_BAR; PG8_SCHED;
            PG8_LDB(B0, 1, 0); PG8_LDB(B1, 1, 1); PG8_SCHED; PG8_LDA(At, 1, 0); PG8_STAGE(PG8_SA(0, 1), a2 + hstep, voffA);
            PG8_WAIT_V(8); PG8_WAIT_L(0); PG8_BAR; PG8_MMA(0, 0, At, B0); PG8_MMA(0, 1, At, B1); PG8_BAR; PG8_SCHED;
            PG8_LDA(At, 1, 1); PG8_STAGE(PG8_SB(1, 0), b3, voffB); PG8_STAGE(PG8_SB(1, 1), b3 + hstep, voffB); PG8_STAGE(PG8_SA(1, 0), a3, voffA);
            PG8_WAIT_V(8); PG8_WAIT_L(0); PG8_BAR; PG8_MMA(1, 0, At, B0); PG8_MMA(1, 1, At, B1); PG8_BAR; PG8_SCHED;
            } else {
            PG8_LDB(B0, 0, 0); PG8_SCHED; PG8_LDA(At, 0, 0); PG8_STAGE(PG8_SA(1, 1), a1 + hstep, voffA);
            PG8_WAIT_L(8); PG8_BAR; PG8_WAIT_L(0); PG8_MMA(0, 0, At, B0); PG8_BAR; PG8_SCHED;
            PG8_LDB(B1, 0, 1); PG8_STAGE(PG8_SB(0, 0), b2, voffB);
            PG8_BAR; PG8_WAIT_L(0); PG8_MMA(0, 1, At, B1); PG8_BAR;
            PG8_LDA(At, 0, 1); PG8_STAGE(PG8_SA(0, 0), a2, voffA);
            PG8_BAR; PG8_WAIT_L(0); PG8_MMA(1, 0, At, B0); PG8_BAR; PG8_SCHED;
            PG8_STAGE(PG8_SB(0, 1), b2 + hstep, voffB);
            PG8_WAIT_V(6); PG8_BAR; PG8_MMA(1, 1, At, B1); PG8_BAR;
            PG8_LDB(B0, 1, 0); PG8_SCHED; PG8_LDA(At, 1, 0); PG8_STAGE(PG8_SA(0, 1), a2 + hstep, voffA);
            PG8_WAIT_L(8); PG8_BAR; PG8_WAIT_L(0); PG8_MMA(0, 0, At, B0); PG8_BAR; PG8_SCHED;
            PG8_LDB(B1, 1, 1); PG8_STAGE(PG8_SB(1, 0), b3, voffB);
            PG8_BAR; PG8_WAIT_L(0); PG8_MMA(0, 1, At, B1); PG8_BAR;
            PG8_LDA(At, 1, 1); PG8_STAGE(PG8_SA(1, 0), a3, voffA);
            PG8_BAR; PG8_WAIT_L(0); PG8_MMA(1, 0, At, B0); PG8_BAR; PG8_SCHED;
            PG8_STAGE(PG8_SB(1, 1), b3 + hstep, voffB);
            PG8_WAIT_V(6); PG8_BAR; PG8_MMA(1, 1, At, B1); PG8_BAR;
            }
        }
        if constexpr (ALIGN_EPI) { if (wr == 0) PG8_BAR; }
        bool keep; { const int le = lane_id_v(); keep = E(acc, cur, wr, wc, le & 15, le >> 4); }
        if (!has_next) break;
        if (!keep) {
#pragma unroll
        for (int a = 0; a < 2; ++a)
#pragma unroll
            for (int b = 0; b < 2; ++b)
#pragma unroll
                for (int m = 0; m < 4; ++m)
#pragma unroll
                    for (int n = 0; n < 2; ++n) acc[a][b][m][n] = (f32x4){0.f, 0.f, 0.f, 0.f};
        }
        cur = nxt; cA = nA; cB = nB; ++ui;
        if constexpr (ALIGN_EPI) { if (wr == 1) PG8_BAR; }
    }
    PG8_WAIT_V(0);
    if constexpr (!ALIGN_EPI) { if (wr == 0) PG8_BAR; }
    PG8_BAR;
#undef PG8_SA
#undef PG8_SB
#undef PG8_STAGE
#undef PG8_LDA
#undef PG8_LDB
#undef PG8_MMA
#undef PG8_WAIT_V
#undef PG8_WAIT_L
#undef PG8_BAR
#undef PG8_SCHED
}
}

#define RLX_AGENT __ATOMIC_RELAXED, __HIP_MEMORY_SCOPE_AGENT
#define LDS_WAIT() asm volatile("s_waitcnt lgkmcnt(0)" ::: "memory")
#define VM_WAIT() asm volatile("s_waitcnt vmcnt(0)" ::: "memory")
__device__ __forceinline__ unsigned pk2(float lo, float hi) { return pg8::cvt_pk_bf16(lo, hi); }
template <int X> __device__ __forceinline__ float swz_xor(float v) { return __int_as_float(__builtin_amdgcn_ds_swizzle(__float_as_int(v), (X << 10) | 0x1f)); }
__device__ __forceinline__ float half_sum(float v) { auto r = __builtin_amdgcn_permlane32_swap(__float_as_uint(v), __float_as_uint(v), false, false); return __uint_as_float(r[0]) + __uint_as_float(r[1]); }
__device__ __forceinline__ float half_max(float v) { auto r = __builtin_amdgcn_permlane32_swap(__float_as_uint(v), __float_as_uint(v), false, false); return fmaxf(__uint_as_float(r[0]), __uint_as_float(r[1])); }
__device__ __forceinline__ float sum16(float v) { v += swz_xor<1>(v); v += swz_xor<2>(v); v += swz_xor<4>(v); v += swz_xor<8>(v); return v; }
__device__ __forceinline__ float wave_sum(float v) { v = sum16(v); v += swz_xor<16>(v); return half_sum(v); }

#define XB_TMO      128
#define XB_XCNT(j)  (256  + 64 * (j))
#define XB_XSUB(j)  (1280 + 64 * (j))
#define XB_XGEN(j)  (2304 + 64 * (j))
#define XB_TOP      3328
#define XB_TOPGEN   3392
#define XCD_BAR_WORDS 3456
#define XB_SPIN_CAP (1u << 18)
__device__ __forceinline__ unsigned xb_ld(unsigned* p)              { return __hip_atomic_load(p, __ATOMIC_RELAXED, __HIP_MEMORY_SCOPE_AGENT); }
__device__ __forceinline__ unsigned xb_add(unsigned* p, unsigned v) { return __hip_atomic_fetch_add(p, v, __ATOMIC_RELAXED, __HIP_MEMORY_SCOPE_AGENT); }
__device__ __forceinline__ unsigned xb_xcc_id() { return (unsigned)__builtin_amdgcn_s_getreg((3 << 11) | 20) & 0xFu; }
#define XB_SPIN(cond, bar) do { unsigned _sp = 0; while (cond) { __builtin_amdgcn_s_sleep(1); \
    if ((++_sp & 255u) == 0u) { if (xb_ld(&(bar)[XB_TMO])) break; if (_sp > XB_SPIN_CAP) { atomicAdd(&(bar)[XB_TMO], 1u); break; } } } } while (0)
struct XcdBarrier { unsigned* bar; unsigned x; volatile LAS unsigned* st; };
__device__ __forceinline__ XcdBarrier xcd_barrier_post(unsigned* bar, volatile LAS unsigned* st) {
    XcdBarrier b; b.bar = bar; b.x = xb_xcc_id(); b.st = st;
    if (threadIdx.x == 0) (void)xb_add(&bar[XB_XCNT(b.x)], 1u);
    return b;
}
__device__ __forceinline__ void xcd_barrier_complete(unsigned* bar, unsigned x, unsigned& nloc, unsigned& nx) {
    const unsigned G = gridDim.x * gridDim.y * gridDim.z;
    unsigned sum, cnt, mine, sp = 0u;
    for (;;) {
        sum = 0u; cnt = 0u; mine = 0u;
#pragma unroll
        for (unsigned j = 0; j < 16; ++j) { const unsigned c = xb_ld(&bar[XB_XCNT(j)]); sum += c; cnt += (c > 0u) ? 1u : 0u; mine = (j == x) ? c : mine; }
        if (sum == G) break;
        __builtin_amdgcn_s_sleep(1);
        if ((++sp & 255u) == 0u) { if (xb_ld(&bar[XB_TMO])) break; if (sp > XB_SPIN_CAP) { atomicAdd(&bar[XB_TMO], 1u); break; } }
    }
    nloc = mine > 0u ? mine : 1u; nx = cnt > 0u ? cnt : 1u;
}
__device__ __forceinline__ void xcd_barrier(const XcdBarrier& b, const bool lead  ) {
    asm volatile("s_waitcnt vmcnt(0)" ::: "memory");
    __syncthreads();
    if (lead) {
        unsigned* bar = b.bar;
        __builtin_amdgcn_s_waitcnt(0);
        unsigned nloc = b.st[0], nx = b.st[1];
        if (nloc == 0u) { xcd_barrier_complete(bar, b.x, nloc, nx); b.st[0] = nloc; b.st[1] = nx; }
        const unsigned old = xb_add(&bar[XB_XSUB(b.x)], 1u);
        const unsigned gen = old / nloc;
        if (old + 1u == (gen + 1u) * nloc) {
            __builtin_amdgcn_fence(__ATOMIC_RELEASE, "agent");
            asm volatile("s_waitcnt vmcnt(0)" ::: "memory");
            const unsigned og = xb_add(&bar[XB_TOP], 1u);
            const unsigned tg = og / nx;
            if (og + 1u == (tg + 1u) * nx) xb_add(&bar[XB_TOPGEN], 1u);
            else XB_SPIN(xb_ld(&bar[XB_TOPGEN]) == tg, bar);
            __builtin_amdgcn_fence(__ATOMIC_ACQUIRE, "agent");
            xb_add(&bar[XB_XGEN(b.x)], 1u);
            asm volatile("s_waitcnt vmcnt(0)" ::: "memory");
        } else {
            XB_SPIN(xb_ld(&bar[XB_XGEN(b.x)]) == gen, bar);
            __builtin_amdgcn_fence(__ATOMIC_ACQUIRE, "agent");
            asm volatile("s_waitcnt vmcnt(0)" ::: "memory");
        }
    }
    __syncthreads();
}

namespace att {
typedef short v4i16_t __attribute__((ext_vector_type(4)));
__device__ __forceinline__ int crow(int r, int hi) { return (r & 3) + 8 * (r >> 2) + 4 * hi; }
__device__ __forceinline__ s16x4 vtr(const LAS unsigned char* p) { return __builtin_bit_cast(s16x4, __builtin_amdgcn_ds_read_tr16_b64_v4i16((LAS v4i16_t*)p)); }
constexpr int VBYTES = 8192;
template <int DK> struct Cfg { static constexpr int KSTR = DK * 2 + 16, KB = 64 * KSTR, BUF = KB + VBYTES; };
constexpr int RPB_OFF = 2 * (64 * 208 + VBYTES);
constexpr int LDS_NEED = RPB_OFF + 15 * 32 * 4;

template <int DK, int MODE>
__device__ __forceinline__ void attn_unit(LAS unsigned char* lds, const bf16* __restrict__ Q, int qp, const bf16* __restrict__ Kg, int kp, const bf16* __restrict__ Vg, int vp,
                                          bf16* __restrict__ O, int op, int ntile, int rg  , int wid_) {
    typedef Cfg<DK> C;
    constexpr int ND = DK / 16, CPR = DK / 8;
    int wid = wid_; asm volatile("" : "+s"(wid));
    const int lane = lane_id_v(), tid = wid * 64 + lane, r32 = lane & 31, hi = lane >> 5;
    const int kr0 = tid / CPR, kc0 = tid % CPR;
    const int kr1 = (tid + 512) / CPR, kc1 = (tid + 512) % CPR;
    const bool k2 = (DK == 96) && (tid < 256);
    const int vr = tid >> 3, vc = tid & 7;
    const int vlds = (vc >> 2) * 4096 + (vr >> 4) * 1024 + (vr & 15) * 64 + (vc & 3) * 16;
    const int kfo = r32 * C::KSTR + hi * 16;
    const int vfo = ((lane >> 4) & 1) * 32 + (lane & 3) * 8 + (4 * hi + ((lane & 15) >> 2)) * 64;
    bf16x8 qr[ND];
    { const bf16* qrow = Q + (size_t)(wid * 32 + r32) * qp + hi * 8;
#pragma unroll
      for (int d0 = 0; d0 < ND; ++d0) qr[d0] = *(const bf16x8*)(qrow + d0 * 16); }
    int t_lo = 0, t_hi = ntile, myrow = 0, qc = 0, cs = 0;
    if (MODE == 1) { myrow = rg + (wid >> 1); int rs = myrow - 4; rs = rs < 0 ? 0 : (rs > NROWS - 8 ? NROWS - 8 : rs); t_lo = rs; t_hi = rs + 8;
        qc = (wid & 1) * 32 + r32; cs = qc - 8; cs = cs < 0 ? 0 : (cs > GRIDW - 16 ? GRIDW - 16 : cs); }
    float mrun = -1e30f, lrun = 0.f; f32x16 o0 = {}, o1 = {};
    int T0 = 0, T1 = ntile;
    if (MODE == 1) { int a = rg - 4; a = a < 0 ? 0 : (a > NROWS - 8 ? NROWS - 8 : a); int b = rg + 3 - 4; b = b < 0 ? 0 : (b > NROWS - 8 ? NROWS - 8 : b); T0 = a; T1 = b + 8; }
    u32x4 kreg0, kreg1, vreg;
#define ATT_LOAD(t) do { const size_t rb = (size_t)(t) * 64; kreg0 = *(const u32x4*)(Kg + (rb + kr0) * kp + kc0 * 8); if (k2) kreg1 = *(const u32x4*)(Kg + (rb + kr1) * kp + kc1 * 8); \
        vreg = *(const u32x4*)(Vg + (rb + vr) * vp + vc * 8); } while (0)
#define ATT_STORE(buf) do { LAS unsigned char* bb = lds + (buf) * C::BUF; *(LAS u32x4*)(bb + kr0 * C::KSTR + kc0 * 16) = kreg0; if (k2) *(LAS u32x4*)(bb + kr1 * C::KSTR + kc1 * 16) = kreg1; \
        *(LAS u32x4*)(bb + C::KB + vlds) = vreg; } while (0)
    ATT_LOAD(T0); ATT_STORE(0);
    __syncthreads();
    for (int t = T0; t < T1; ++t) {
        const int buf = (t - T0) & 1;
        if (t + 1 < T1) ATT_LOAD(t + 1);
        if (MODE == 0 || (t >= t_lo && t < t_hi)) {
            const LAS unsigned char* kb_ = lds + buf * C::BUF; const LAS unsigned char* vb_ = kb_ + C::KB;
            f32x16 s0, s1;
            if (MODE == 1) {
                const LAS float* tab = (const LAS float*)(lds + RPB_OFF) + (t - myrow + 7) * 32;
#pragma unroll
                for (int r = 0; r < 16; ++r) { const int kc = crow(r, hi);
                    { int dc = kc - qc + 15; const bool ok = (kc >= cs) && (kc < cs + 16); dc = dc < 0 ? 0 : (dc > 30 ? 30 : dc); const float bv = tab[dc]; s0[r] = ok ? bv : -1e30f; }
                    { const int k2_ = kc + 32; int dc = k2_ - qc + 15; const bool ok = (k2_ >= cs) && (k2_ < cs + 16); dc = dc < 0 ? 0 : (dc > 30 ? 30 : dc); const float bv = tab[dc]; s1[r] = ok ? bv : -1e30f; } }
            } else { s0 = f32x16{}; s1 = f32x16{}; }
#pragma unroll
            for (int d0 = 0; d0 < ND; ++d0) {
                const bf16x8 k0 = *(const LAS bf16x8*)(kb_ + kfo + d0 * 32);
                const bf16x8 k1 = *(const LAS bf16x8*)(kb_ + kfo + 32 * C::KSTR + d0 * 32);
                s0 = __builtin_amdgcn_mfma_f32_32x32x16_bf16(k0, qr[d0], s0, 0, 0, 0);
                s1 = __builtin_amdgcn_mfma_f32_32x32x16_bf16(k1, qr[d0], s1, 0, 0, 0);
            }
            float mx = fmaxf(s0[0], s1[0]);
#pragma unroll
            for (int r = 1; r < 16; ++r) mx = fmaxf(mx, fmaxf(s0[r], s1[r]));
            mx = half_max(mx);
            const float mn = fmaxf(mrun, mx); const float al = __builtin_amdgcn_exp2f(mrun - mn); mrun = mn;
            float ls = 0.f;
#pragma unroll
            for (int r = 0; r < 16; ++r) { s0[r] = __builtin_amdgcn_exp2f(s0[r] - mn); s1[r] = __builtin_amdgcn_exp2f(s1[r] - mn); ls += s0[r] + s1[r]; }
            lrun = lrun * al + ls;
#pragma unroll
            for (int r = 0; r < 16; ++r) { o0[r] *= al; o1[r] *= al; }
            u32x4 pw[4];
#pragma unroll
            for (int j = 0; j < 4; ++j) { pw[0][j] = pk2(s0[2 * j], s0[2 * j + 1]); pw[1][j] = pk2(s0[8 + 2 * j], s0[9 + 2 * j]); pw[2][j] = pk2(s1[2 * j], s1[2 * j + 1]); pw[3][j] = pk2(s1[8 + 2 * j], s1[9 + 2 * j]); }
#pragma unroll
            for (int ks = 0; ks < 4; ++ks) {
                const s16x4 a0 = vtr(vb_ + vfo + ks * 1024), a1 = vtr(vb_ + vfo + ks * 1024 + 512);
                const s16x4 b0 = vtr(vb_ + vfo + 4096 + ks * 1024), b1 = vtr(vb_ + vfo + 4096 + ks * 1024 + 512);
                const bf16x8 va = (bf16x8){a0[0], a0[1], a0[2], a0[3], a1[0], a1[1], a1[2], a1[3]};
                const bf16x8 vb = (bf16x8){b0[0], b0[1], b0[2], b0[3], b1[0], b1[1], b1[2], b1[3]};
                const bf16x8 pf = __builtin_bit_cast(bf16x8, pw[ks]);
                o0 = __builtin_amdgcn_mfma_f32_32x32x16_bf16(va, pf, o0, 0, 0, 0);
                o1 = __builtin_amdgcn_mfma_f32_32x32x16_bf16(vb, pf, o1, 0, 0, 0);
            }
        }
        if (t + 1 < T1) ATT_STORE(buf ^ 1);
        __syncthreads();
    }
#undef ATT_LOAD
#undef ATT_STORE
    const float lt = half_sum(lrun); const float inv = 1.0f / lt;
    bf16* orow = O + (size_t)(wid * 32 + r32) * op + 4 * hi;
#pragma unroll
    for (int g = 0; g < 4; ++g) {
        u32x2 w0, w1;
        w0.x = pk2(o0[4 * g] * inv, o0[4 * g + 1] * inv); w0.y = pk2(o0[4 * g + 2] * inv, o0[4 * g + 3] * inv);
        w1.x = pk2(o1[4 * g] * inv, o1[4 * g + 1] * inv); w1.y = pk2(o1[4 * g + 2] * inv, o1[4 * g + 3] * inv);
        *(u32x2*)(orow + 8 * g) = w0; *(u32x2*)(orow + 32 + 8 * g) = w1;
    }
}
}

constexpr size_t MiB = 1u << 20;
constexpr size_t WS_CTL = 0, CTL_ZERO_BYTES = 256 * 1024;
constexpr size_t WS_ROPEA_C = 1 * MiB, WS_ROPEA_S = WS_ROPEA_C + 256 * 1024, WS_ROPEC_C = WS_ROPEA_S + 256 * 1024, WS_ROPEC_S = WS_ROPEC_C + 128 * 1024;
constexpr size_t WS_ROUTE = 2 * MiB;
constexpr size_t WS_SLOT = WS_ROUTE + 256 * 1024;
constexpr size_t WS_CNT = WS_SLOT + 128 * 1024;
constexpr size_t WS_META = WS_CNT + 8 * 1024;
constexpr size_t WS_XRES = 4 * MiB;
constexpr size_t WS_R = 68 * MiB;
constexpr size_t WS_WIN = WS_R;
constexpr size_t WS_WBR = WS_WIN + 25 * MiB;
constexpr size_t WS_WOUT = WS_WBR + 4 * MiB;
constexpr size_t WS_W13 = WS_WOUT + 4 * MiB;
constexpr size_t WS_W2 = WS_W13 + 11 * MiB;
constexpr size_t WS_WUQ = WS_W2 + 6 * MiB;
constexpr size_t WS_WUKV = WS_WUQ + MiB / 2;
constexpr size_t WS_XB = WS_R + 52 * MiB;
constexpr size_t WS_H = WS_XB + 32 * MiB;
constexpr size_t WS_T = WS_H;
constexpr size_t WS_G = WS_H + 64 * MiB;
constexpr size_t WS_HID0 = WS_G;
constexpr size_t WS_QA = WS_G + 128 * MiB;
constexpr size_t WS_KA = WS_QA + 8 * MiB;
constexpr size_t WS_CQN = WS_KA + 4 * MiB;
constexpr size_t WS_CKVN = WS_CQN + 8 * MiB;
constexpr size_t WS_QC = WS_CKVN + 8 * MiB;
constexpr size_t WS_KC = WS_QC + 12 * MiB;
constexpr size_t WS_VC = WS_KC + 12 * MiB;
constexpr size_t WS_MG = WS_QA;
constexpr size_t WS_YS = WS_VC + 8 * MiB;
constexpr size_t WS_DENSE_END = WS_YS + 32 * MiB;
constexpr size_t WS_MW13 = WS_R;
constexpr size_t WS_MW2 = WS_R;
constexpr size_t WS_MHID = WS_R + 112 * MiB;
constexpr size_t WS_XG = WS_MHID + 238 * MiB;
constexpr size_t WS_END = WS_XG + 68 * MiB;
static_assert(WS_DENSE_END <= WS_END && WS_WUKV + MiB / 2 <= WS_XB, "ws map");
static_assert((size_t)MAXSLOTS * D_FFE * 2 <= 238 * MiB && (size_t)MAXSLOTS * DM * 2 <= 68 * MiB, "ws map moe");
constexpr int CW_TMO = 0, CW_BAR = 4096;

constexpr int RING_BYTES = 131072;
constexpr int LDSCTL_OFF = RING_BYTES;
constexpr int LDS_BYTES = 147456;
constexpr int NWAVES = 8;

struct Frame { LAS unsigned char* lds; int tid, lane, wave, vcu, G; };

__device__ __forceinline__ void cvt_item(const float* W, int ldn, int n0, int k0, bool zero, bf16* WT, int ldk, int r0, LAS float* scr, int lane) {
    if (!zero) {
#pragma unroll 8
        for (int i = 0; i < 32; ++i) { const int kk = 2 * i + (lane >> 5); scr[kk * 33 + (lane & 31)] = W[(size_t)(k0 + kk) * ldn + n0 + (lane & 31)]; }
    }
    LDS_WAIT(); asm volatile("" ::: "memory");
    const int c = lane & 7;
#pragma unroll
    for (int j = 0; j < 4; ++j) { const int n = (lane >> 3) + 8 * j; const LAS float* s = scr + (8 * c) * 33 + n;
        u32x4 o;
        if (zero) { o = (u32x4){0u, 0u, 0u, 0u}; } else { o.x = pk2(s[0 * 33], s[1 * 33]); o.y = pk2(s[2 * 33], s[3 * 33]); o.z = pk2(s[4 * 33], s[5 * 33]); o.w = pk2(s[6 * 33], s[7 * 33]); }
        *(GAS u32x4*)(WT + (size_t)(r0 + n) * ldk + k0 + 8 * c) = o; }
    LDS_WAIT(); asm volatile("" ::: "memory");
}
__device__ __forceinline__ int win_src_col(int rb) {
    const int tile = rb >> 3, w = rb & 7;
    if (tile < 5) return rb * 32;
    if (tile == 5) return w < 6 ? OFF_CQ + 32 * w : -1;
    if (tile == 6) return w < 4 ? OFF_CKV + 32 * w : (w == 4 ? OFF_KPE : -1);
    if (tile < 9) return OFF_GLU + (w >> 2) * 256 + (tile - 7) * 128 + 32 * (w & 3);
    return OFF_GATE + (rb - 72) * 32;
}

__device__ __forceinline__ void ln_row(f32x4 (&v)[4], const float* g, const float* b, int lane) {
    float s = 0.f;
#pragma unroll
    for (int j = 0; j < 4; ++j) s += (v[j][0] + v[j][1]) + (v[j][2] + v[j][3]);
    const float mean = wave_sum(s) * (1.f / DM); float s2 = 0.f;
#pragma unroll
    for (int j = 0; j < 4; ++j) { v[j] = v[j] - mean; s2 += (v[j][0] * v[j][0] + v[j][1] * v[j][1]) + (v[j][2] * v[j][2] + v[j][3] * v[j][3]); }
    const float rstd = 1.0f / sqrtf(wave_sum(s2) * (1.f / DM) + LN_EPS);
#pragma unroll
    for (int j = 0; j < 4; ++j) { const f32x4 gg = *(const f32x4*)(g + 4 * lane + 256 * j), bb = *(const f32x4*)(b + 4 * lane + 256 * j); v[j] = v[j] * rstd * gg + bb; }
}
__device__ __forceinline__ void store_row_f32(float* p, const f32x4 (&v)[4], int lane) {
#pragma unroll
    for (int j = 0; j < 4; ++j) *(f32x4*)(p + 4 * lane + 256 * j) = v[j];
}
__device__ __forceinline__ void store_row_bf16(bf16* p, const f32x4 (&v)[4], int lane) {
#pragma unroll
    for (int j = 0; j < 4; ++j) { u32x2 w; w.x = pk2(v[j][0], v[j][1]); w.y = pk2(v[j][2], v[j][3]); *(u32x2*)(p + 4 * lane + 256 * j) = w; }
}
#ifndef DBG_REPORT
#define DBG_REPORT 0
#endif
#ifndef DBG_K0
#define DBG_K0 5
#endif
#ifndef DBG_CHK
#define DBG_CHK 0
#endif
#ifndef DBG_TOL
#define DBG_TOL 0.05f
#endif
#ifndef DBG_LDSFILL
#define DBG_LDSFILL 0
#endif
#ifndef DBG_LDSFILL_VAL
#define DBG_LDSFILL_VAL 0u
#endif
#ifndef DBG_ZERO_AC
#define DBG_ZERO_AC 0
#endif
#ifndef DBG_ZROWS
#define DBG_ZROWS 0
#endif
#ifndef DBG_ZCOND
#define DBG_ZCOND false
#endif
#ifndef DBG_ZERO_B
#define DBG_ZERO_B 0
#endif
#ifndef MK_ONE_LAUNCH
#define MK_ONE_LAUNCH 0
#endif
#ifndef PH_MASK
#define PH_MASK 0xFFFFFFFFu
#endif
__host__ __device__ constexpr bool EN(int k) { return ((PH_MASK) >> k) & 1u; }

#define WSP GAS unsigned char* wsp = (GAS unsigned char*)ws; int wave = F.wave, G_ = F.G, vcu = F.vcu, bid = blockIdx.x; asm volatile("" : "+s"(wsp), "+s"(wave), "+s"(G_), "+s"(vcu), "+s"(bid)); \
    const int lane = lane_id_v(), tid = wave * 64 + lane; const int gw = vcu * NWAVES + wave, NGW = G_ * NWAVES; (void)lane; (void)tid; (void)gw; (void)NGW; (void)bid
#define XRES ((float*)(wsp + WS_XRES))
#define XB ((bf16*)(wsp + WS_XB))
#define Hb ((bf16*)(wsp + WS_H))
#define Gt ((bf16*)(wsp + WS_G))
#define Tb ((float*)(wsp + WS_T))
#define QA ((bf16*)(wsp + WS_QA))
#define KA ((bf16*)(wsp + WS_KA))
#define CQN ((bf16*)(wsp + WS_CQN))
#define CKVN ((bf16*)(wsp + WS_CKVN))
#define QC ((bf16*)(wsp + WS_QC))
#define KC ((bf16*)(wsp + WS_KC))
#define VC ((bf16*)(wsp + WS_VC))
#define MG ((bf16*)(wsp + WS_MG))
#define YS ((bf16*)(wsp + WS_YS))
#define ropeA_c ((float*)(wsp + WS_ROPEA_C))
#define ropeA_s ((float*)(wsp + WS_ROPEA_S))
#define ropeC_c ((float*)(wsp + WS_ROPEC_C))
#define ropeC_s ((float*)(wsp + WS_ROPEC_S))
#define ROUTE ((unsigned*)(wsp + WS_ROUTE))
#define SLOT ((unsigned*)(wsp + WS_SLOT))
#define CNT ((unsigned*)(wsp + WS_CNT))
#define META ((unsigned*)(wsp + WS_META))
#define INP(i) ldptr(PTAB, (i))
__device__ __forceinline__ const float* ldptr(const LAS unsigned* tab, int i) { const unsigned lo = __builtin_amdgcn_readfirstlane(tab[2 * i]), hi = __builtin_amdgcn_readfirstlane(tab[2 * i + 1]); return (const float*)(const GAS float*)(((unsigned long long)hi << 32) | lo); }
struct Args {
    const float* in[28]; float* out; unsigned char* ws; int ph_lo, ph_hi;
};
constexpr int PH_PER_LAYER = 16, N_PHASES = 1 + 2 * PH_PER_LAYER;

__global__ void __launch_bounds__(NWAVES * 64, 2) fwd(Args args) {
    extern __shared__ __attribute__((aligned(16))) unsigned char lds_raw[];
    Frame F;
    F.lds = (LAS unsigned char*)lds_raw;
    F.tid = threadIdx.x; F.lane = F.tid & 63; F.wave = __builtin_amdgcn_readfirstlane(F.tid >> 6);
    F.G = gridDim.x; { const int bx = blockIdx.x; F.vcu = (F.G % 8 == 0) ? (bx % 8) * (F.G / 8) + bx / 8 : bx; }
    unsigned char* ws = args.ws;
    gu32* ctl = (gu32*)(ws + WS_CTL);
    volatile LAS unsigned* MISC = (volatile LAS unsigned*)(F.lds + LDSCTL_OFF);
    for (int u = F.tid; u < (LDS_BYTES - LDSCTL_OFF) / 4; u += NWAVES * 64) ((LAS unsigned*)(F.lds + LDSCTL_OFF))[u] = 0u;
    __syncthreads();
    if (F.tid < 29) { const unsigned long long pv = (F.tid < 28) ? (unsigned long long)args.in[F.tid] : (unsigned long long)args.out; LAS unsigned* pt = (LAS unsigned*)(F.lds + LDSCTL_OFF + 2048); pt[2 * F.tid] = (unsigned)pv; pt[2 * F.tid + 1] = (unsigned)(pv >> 32); }
    __syncthreads();
    const int lo = args.ph_lo, hi = args.ph_hi;
    const bool one_launch = (hi - lo) > 1;
    XcdBarrier bar; bar.bar = (unsigned*)(ctl + CW_BAR); bar.x = 0; bar.st = nullptr;
    if (one_launch) bar = xcd_barrier_post((unsigned*)(ctl + CW_BAR), MISC);
#define IN(k) (lo <= (k) && (k) < hi)
#define SEAM(k) do { if (IN(k) && IN((k) + 1)) { int w_ = F.wave; asm volatile("" : "+s"(w_)); xcd_barrier(bar, (w_ * 64 + lane_id_v()) == 0); } } while (0)

    const LAS unsigned* PTAB = (const LAS unsigned*)(F.lds + LDSCTL_OFF + 2048);

    if (IN(0) && EN(0)) { WSP;
        LAS float* scr = (LAS float*)(F.lds + wave * 16384);
        {
            const int nit = 2 * (NW_IN / 32) * 16;
            for (int it = gw; it < nit; it += NGW) { const int l = it / ((NW_IN / 32) * 16), r = it % ((NW_IN / 32) * 16), rb = r / 16, kb = r % 16; const int sc = win_src_col(rb);
                cvt_item(INP(3) + (size_t)l * 1024 * D_IN, D_IN, sc < 0 ? 0 : sc, kb * 64, sc < 0, (bf16*)(wsp + WS_WIN) + (size_t)l * NW_IN * 1024, 1024, rb * 32, scr, lane); }
        }
        {
            const int nit = 8 * 32 * 4;
            for (int it = gw; it < nit; it += NGW) { const int mat = it / 128, r = it % 128, rb = r / 4, kb = r % 4;
                cvt_item(INP(15) + (size_t)mat * 256 * 1024, 1024, rb * 32, kb * 64, false, (bf16*)(wsp + WS_WBR) + (size_t)mat * 1024 * 256, 256, rb * 32, scr, lane); }
        }
        {
            const int nit = 2 * 32 * 16;
            for (int it = gw; it < nit; it += NGW) { const int mat = it / 512, r = it % 512, rb = r / 16, kb = r % 16;
                cvt_item(INP(16) + (size_t)mat * 1024 * 1024, 1024, rb * 32, kb * 64, false, (bf16*)(wsp + WS_WOUT) + (size_t)mat * 1024 * 1024, 1024, rb * 32, scr, lane); }
        }
        {
            const int nit = (2 * D_FF / 32) * 16;
            for (int it = gw; it < nit; it += NGW) { const int rb = it / 16, kb = it % 16; const int tile = rb >> 3, w = rb & 7;
                cvt_item((w < 4) ? INP(19) : INP(20), D_FF, tile * 128 + (w & 3) * 32, kb * 64, false, (bf16*)(wsp + WS_W13), 1024, rb * 32, scr, lane); }
        }
        {
            const int nit = 32 * (D_FF / 64);
            for (int it = gw; it < nit; it += NGW) { const int rb = it / (D_FF / 64), kb = it % (D_FF / 64);
                cvt_item(INP(21), 1024, rb * 32, kb * 64, false, (bf16*)(wsp + WS_W2), D_FF, rb * 32, scr, lane); }
        }
        {
            const int nit = 2 * 2 * 16 * 4;
            for (int it = gw; it < nit; it += NGW) { const int which = it / 128, l = (it / 64) & 1, r = it % 64, rb = r / 4, kb = r % 4;
                if (which == 0) { const bool z = (rb >= 12) || (kb >= 3); cvt_item(INP(9) + (size_t)l * 192 * 384, 384, rb * 32, kb * 64, z, (bf16*)(wsp + WS_WUQ) + (size_t)l * 512 * 256, 256, rb * 32, scr, lane); }
                else { const bool z = (kb >= 2); cvt_item(INP(10) + (size_t)l * 128 * 512, 512, rb * 32, kb * 64, z, (bf16*)(wsp + WS_WUKV) + (size_t)l * 512 * 256, 256, rb * 32, scr, lane); } }
        }
        for (int i = bid * 512 + tid; i < SEQ * 32; i += G_ * 512) { const int s = i >> 5, f = i & 31; const float pos = (f < 16) ? (float)(s >> 6) : (float)(s & 63);
            const float inv = exp2f(-(float)(f & 15) * (13.287712379549449f / 16.0f)); const float a = pos * inv; ropeA_c[i] = cosf(a); ropeA_s[i] = sinf(a); }
        for (int i = bid * 512 + tid; i < SEQ * 16; i += G_ * 512) { const int s = i >> 4, f = i & 15; const float pos = (f < 8) ? (float)(s >> 6) : (float)(s & 63);
            const float inv = exp2f(-(float)(f & 7) * (13.287712379549449f / 8.0f)); const float a = pos * inv; ropeC_c[i] = cosf(a); ropeC_s[i] = sinf(a); }
        for (int m = gw; m < M; m += NGW) { f32x4 v[4];
#pragma unroll
            for (int j = 0; j < 4; ++j) v[j] = *(const f32x4*)(INP(0) + (size_t)m * DM + 4 * lane + 256 * j);
            ln_row(v, INP(1), INP(2), lane); store_row_f32(XRES + (size_t)m * DM, v, lane); store_row_bf16(XB + (size_t)m * DM, v, lane); }
    }
    SEAM(0);

    {
        constexpr int l = 0;
        const int pb = 1 + PH_PER_LAYER * l;
        const bool moe = (l & 1) != 0;
        if (IN(pb + 0) && EN(1)) { WSP;
            pg8::Gemm g{XB, (const bf16*)(wsp + WS_WIN) + (size_t)l * NW_IN * 1024, 1024}; pg8::SchedPlain S; S.init(M / 256, NW_IN / 256, 1024, G_, bid);
            pg8::EpiWin E{Hb, Gt};
            pg8::gemm_phase<pg8::EpiWin, pg8::SchedPlain, true, true>(F.lds, g, S, E, wave);
        }
        SEAM(pb + 0);
        if (IN(pb + 1) && EN(2)) { WSP;
            const float* aqn = INP(4) + l * 64; const float* akn = INP(5) + l * 64; const float* cqn = INP(7) + l * 192; const float* ckvn = INP(8) + l * 128;
            for (int t = gw; t < M; t += NGW) { const int s = t & (SEQ - 1); const bf16* hr = Hb + (size_t)t * HP;
                {
                    const u32x2 w = *(const u32x2*)(hr + 4 * lane); float v[4] = {pg8::bf_lo(w.x), pg8::bf_hi(w.x), pg8::bf_lo(w.y), pg8::bf_hi(w.y)};
                    float ss = v[0] * v[0] + v[1] * v[1] + v[2] * v[2] + v[3] * v[3]; ss = sum16(ss);
                    const float rs = 1.0f / sqrtf(ss * (1.f / 64.f) + RMS_EPS); const int d = 4 * (lane & 15); const f32x4 gg = *(const f32x4*)(aqn + d);
                    const f32x2 cs = *(const f32x2*)(ropeA_c + s * 32 + (d >> 1)), sn = *(const f32x2*)(ropeA_s + s * 32 + (d >> 1));
                    const float a0 = v[0] * rs * gg[0], a1 = v[1] * rs * gg[1], a2 = v[2] * rs * gg[2], a3 = v[3] * rs * gg[3];
                    u32x2 o; o.x = pk2((a0 * cs[0] - a1 * sn[0]) * QS64, (a0 * sn[0] + a1 * cs[0]) * QS64); o.y = pk2((a2 * cs[1] - a3 * sn[1]) * QS64, (a2 * sn[1] + a3 * cs[1]) * QS64);
                    *(u32x2*)(QA + (size_t)t * 256 + 4 * lane) = o; }
                if (lane < 32) {
                    const u32x2 w = *(const u32x2*)(hr + 256 + 4 * lane); float v[4] = {pg8::bf_lo(w.x), pg8::bf_hi(w.x), pg8::bf_lo(w.y), pg8::bf_hi(w.y)};
                    float ss = v[0] * v[0] + v[1] * v[1] + v[2] * v[2] + v[3] * v[3]; ss = sum16(ss);
                    const float rs = 1.0f / sqrtf(ss * (1.f / 64.f) + RMS_EPS); const int d = 4 * (lane & 15); const f32x4 gg = *(const f32x4*)(akn + d);
                    const f32x2 cs = *(const f32x2*)(ropeA_c + s * 32 + (d >> 1)), sn = *(const f32x2*)(ropeA_s + s * 32 + (d >> 1));
                    const float a0 = v[0] * rs * gg[0], a1 = v[1] * rs * gg[1], a2 = v[2] * rs * gg[2], a3 = v[3] * rs * gg[3];
                    u32x2 o; o.x = pk2(a0 * cs[0] - a1 * sn[0], a0 * sn[0] + a1 * cs[0]); o.y = pk2(a2 * cs[1] - a3 * sn[1], a2 * sn[1] + a3 * cs[1]);
                    *(u32x2*)(KA + (size_t)t * 128 + 4 * lane) = o; }
                {
                    float v[4] = {0.f, 0.f, 0.f, 0.f};
                    if (lane < 48) { const u32x2 w = *(const u32x2*)(hr + 1280 + 4 * lane); v[0] = pg8::bf_lo(w.x); v[1] = pg8::bf_hi(w.x); v[2] = pg8::bf_lo(w.y); v[3] = pg8::bf_hi(w.y); }
                    const float ss = wave_sum(v[0] * v[0] + v[1] * v[1] + v[2] * v[2] + v[3] * v[3]); const float rs = 1.0f / sqrtf(ss * (1.f / 192.f) + RMS_EPS);
                    u32x2 o = {0u, 0u};
                    if (lane < 48) { const f32x4 gg = *(const f32x4*)(cqn + 4 * lane); o.x = pk2(v[0] * rs * gg[0], v[1] * rs * gg[1]); o.y = pk2(v[2] * rs * gg[2], v[3] * rs * gg[3]); }
                    *(u32x2*)(CQN + (size_t)t * 256 + 4 * lane) = o; }
                {
                    float v[4] = {0.f, 0.f, 0.f, 0.f};
                    if (lane < 32) { const u32x2 w = *(const u32x2*)(hr + 1536 + 4 * lane); v[0] = pg8::bf_lo(w.x); v[1] = pg8::bf_hi(w.x); v[2] = pg8::bf_lo(w.y); v[3] = pg8::bf_hi(w.y); }
                    const float ss = wave_sum(v[0] * v[0] + v[1] * v[1] + v[2] * v[2] + v[3] * v[3]); const float rs = 1.0f / sqrtf(ss * (1.f / 128.f) + RMS_EPS);
                    u32x2 o = {0u, 0u};
                    if (lane < 32) { const f32x4 gg = *(const f32x4*)(ckvn + 4 * lane); o.x = pk2(v[0] * rs * gg[0], v[1] * rs * gg[1]); o.y = pk2(v[2] * rs * gg[2], v[3] * rs * gg[3]); }
                    *(u32x2*)(CKVN + (size_t)t * 256 + 4 * lane) = o; }
                if (lane < 32) {
                    const int j = lane & 7, hh = lane >> 3; const u32x2 w = *(const u32x2*)(hr + 1664 + 4 * j);
                    const float a0 = pg8::bf_lo(w.x), a1 = pg8::bf_hi(w.x), a2 = pg8::bf_lo(w.y), a3 = pg8::bf_hi(w.y);
                    const f32x2 cs = *(const f32x2*)(ropeC_c + s * 16 + 2 * j), sn = *(const f32x2*)(ropeC_s + s * 16 + 2 * j);
                    u32x2 o; o.x = pk2(a0 * cs[0] - a1 * sn[0], a0 * sn[0] + a1 * cs[0]); o.y = pk2(a2 * cs[1] - a3 * sn[1], a2 * sn[1] + a3 * cs[1]);
                    *(u32x2*)(KC + (size_t)t * 384 + hh * 96 + 64 + 4 * j) = o; }
            }
        }
        SEAM(pb + 1);
        if (IN(pb + 2) && EN(3)) { WSP;
            { pg8::Gemm g{CQN, (const bf16*)(wsp + WS_WUQ) + (size_t)l * 512 * 256, 256}; pg8::SchedPlain S; S.init(M / 256, 2, 256, G_, bid);
              pg8::EpiUq E{QC, ropeC_c, ropeC_s}; pg8::gemm_phase<pg8::EpiUq, pg8::SchedPlain, false, true>(F.lds, g, S, E, wave); }
            { pg8::Gemm g{CKVN, (const bf16*)(wsp + WS_WUKV) + (size_t)l * 512 * 256, 256}; pg8::SchedPlain S; S.init(M / 256, 2, 256, G_, bid);
              pg8::EpiUkv E{KC, VC}; pg8::gemm_phase<pg8::EpiUkv, pg8::SchedPlain, false, true>(F.lds, g, S, E, wave); }
        }
        SEAM(pb + 2);
        if (IN(pb + 3) && EN(4)) { WSP;
            for (int u = vcu; u < 256; u += G_) {
#if DBG_LDSFILL
                for (int i = tid; i < 49152 / 4; i += 512) ((LAS unsigned*)F.lds)[i] = DBG_LDSFILL_VAL; __syncthreads();
#endif
                const int b = u >> 5, hh = (u >> 3) & 3, qb = u & 7; const size_t r0 = (size_t)b * SEQ + qb * 256, b0 = (size_t)b * SEQ;
#if DBG_ZERO_AC
                for (int i = tid; i < 256 * 8; i += 512) { const int rr = i >> 3, c8 = i & 7; *(u32x4*)(YS + ((size_t)0 * M + r0 + rr) * 256 + hh * 64 + c8 * 8) = (u32x4){0u, 0u, 0u, 0u}; *(u32x4*)(YS + ((size_t)2 * M + r0 + rr) * 256 + hh * 64 + c8 * 8) = (u32x4){0u, 0u, 0u, 0u}; }
#else
                att::attn_unit<64, 0>(F.lds, QA + r0 * 256 + hh * 64, 256, KA + b0 * 128 + (hh >> 1) * 64, 128, Hb + b0 * HP + OFF_AV + (hh >> 1) * 64, HP, YS + r0 * 256 + hh * 64, 256, SEQ / 64, 0, wave);
                att::attn_unit<96, 0>(F.lds, QC + r0 * 384 + hh * 96, 384, KC + b0 * 384 + hh * 96, 384, VC + b0 * 256 + hh * 64, 256, YS + ((size_t)2 * M + r0) * 256 + hh * 64, 256, SEQ / 64, 0, wave);
#endif
                { const float* rpb = INP(6) + ((size_t)l * 4 + hh) * 15 * 31; LAS float* tab = (LAS float*)(F.lds + att::RPB_OFF);
                  if (tid < 480) { const int dr = tid >> 5, dc = tid & 31; tab[tid] = (dc < 31) ? rpb[dr * 31 + dc] * LOG2E : 0.f; }
                  __syncthreads(); }
#if DBG_ZERO_B
                for (int i = tid; i < 256 * 8; i += 512) { const int rr = i >> 3, c8 = i & 7; *(u32x4*)(YS + ((size_t)1 * M + r0 + rr) * 256 + hh * 64 + c8 * 8) = (u32x4){0u, 0u, 0u, 0u}; }
#else
                att::attn_unit<64, 1>(F.lds, Hb + r0 * HP + OFF_BQ + hh * 64, HP, Hb + b0 * HP + OFF_BK + hh * 64, HP, Hb + b0 * HP + OFF_BV + hh * 64, HP, YS + ((size_t)1 * M + r0) * 256 + hh * 64, 256, NROWS, qb * 4, wave);
#endif
                {
                    const int t0 = u * 64, s0 = t0 & (SEQ - 1); LAS bf16* tile = (LAS bf16*)F.lds;
                    for (int i = tid; i < 94 * 32; i += 512) { const int rr = i >> 5, c8 = i & 31; const int s = s0 - 15 + rr; u32x4 v = {0u, 0u, 0u, 0u};
                        if (s >= 0 && s < SEQ) v = *(const u32x4*)(Hb + (size_t)(t0 - 15 + rr) * HP + 1792 + c8 * 8);
                        *(LAS u32x4*)(tile + rr * 256 + c8 * 8) = v; }
                    __syncthreads();
                    const float* cw = INP(11) + (size_t)l * 31 * 256; const int c4 = 4 * lane;
                    f32x4 acc[8];
                    { const f32x4 bb = *(const f32x4*)(INP(12) + l * 256 + c4);
#pragma unroll
                      for (int j = 0; j < 8; ++j) acc[j] = bb; }
                    for (int k = 0; k < 31; ++k) { const f32x4 wk = *(const f32x4*)(cw + k * 256 + c4);
#pragma unroll
                        for (int j = 0; j < 8; ++j) { const u32x2 w = *(const LAS u32x2*)(tile + (wave * 8 + j + k) * 256 + c4);
                            acc[j][0] += wk[0] * pg8::bf_lo(w.x); acc[j][1] += wk[1] * pg8::bf_hi(w.x); acc[j][2] += wk[2] * pg8::bf_lo(w.y); acc[j][3] += wk[3] * pg8::bf_hi(w.y); } }
                    const f32x4 lg = *(const f32x4*)(INP(13) + l * 256 + c4), lb = *(const f32x4*)(INP(14) + l * 256 + c4);
#pragma unroll
                    for (int j = 0; j < 8; ++j) { f32x4 v = acc[j]; const float mean = wave_sum((v[0] + v[1]) + (v[2] + v[3])) * (1.f / 256.f); v = v - mean;
                        const float var = wave_sum((v[0] * v[0] + v[1] * v[1]) + (v[2] * v[2] + v[3] * v[3])) * (1.f / 256.f); const float rstd = 1.0f / sqrtf(var + LN_EPS);
                        v = v * rstd * lg + lb;
                        u32x2 o; o.x = pk2(v[0] * pg8::sigmoidf_(v[0]), v[1] * pg8::sigmoidf_(v[1])); o.y = pk2(v[2] * pg8::sigmoidf_(v[2]), v[3] * pg8::sigmoidf_(v[3]));
                        *(u32x2*)(YS + ((size_t)3 * M + t0 + wave * 8 + j) * 256 + c4) = o; }
                    __syncthreads();
                }
            }
        }
        SEAM(pb + 3);
        if (IN(pb + 4) && EN(5)) { WSP;
            pg8::Gemm g{YS, (const bf16*)(wsp + WS_WBR) + (size_t)l * 4 * 1024 * 256, 256}; pg8::SchedMerge S; S.init(G_, bid);
            pg8::EpiMerge E{Gt, MG}; pg8::gemm_phase<pg8::EpiMerge, pg8::SchedMerge, false, true>(F.lds, g, S, E, wave);
        }
        SEAM(pb + 4);
        if (IN(pb + 5) && EN(6)) { WSP;
            pg8::Gemm g{MG, (const bf16*)(wsp + WS_WOUT) + (size_t)l * 1024 * 1024, 1024}; pg8::SchedPlain S; S.init(M / 256, 4, 1024, G_, bid);
            pg8::EpiRes E{XRES, Tb}; pg8::gemm_phase<pg8::EpiRes, pg8::SchedPlain, false, true>(F.lds, g, S, E, wave);
        }
        SEAM(pb + 5);
        if (IN(pb + 6) && EN(7)) { WSP;
            const float* lg = INP(17) + l * DM; const float* lb = INP(18) + l * DM; const float* router = INP(22);
            LAS unsigned* lcnt = (LAS unsigned*)(F.lds + LDSCTL_OFF + 64);
            for (int blk = vcu; blk < 256; blk += G_) {
                if (moe) { if (tid < 8) lcnt[tid] = 0u; __syncthreads(); }
                for (int k = 0; k < 8; ++k) { const int t = blk * 64 + wave * 8 + k; f32x4 v[4];
#pragma unroll
                    for (int j = 0; j < 4; ++j) v[j] = *(const f32x4*)(Tb + (size_t)t * DM + 4 * lane + 256 * j);
                    ln_row(v, lg, lb, lane); store_row_f32(XRES + (size_t)t * DM, v, lane);
                    if (!moe) store_row_bf16(XB + (size_t)t * DM, v, lane);
                    else {
                        float lgt[8] = {0.f, 0.f, 0.f, 0.f, 0.f, 0.f, 0.f, 0.f};
#pragma unroll
                        for (int j = 0; j < 4; ++j)
#pragma unroll
                            for (int e4 = 0; e4 < 4; ++e4) { const float xv = v[j][e4]; const float* rr = router + (size_t)(4 * lane + 256 * j + e4) * 8; const f32x4 ra = *(const f32x4*)rr, rb = *(const f32x4*)(rr + 4);
                                lgt[0] += xv * ra[0]; lgt[1] += xv * ra[1]; lgt[2] += xv * ra[2]; lgt[3] += xv * ra[3]; lgt[4] += xv * rb[0]; lgt[5] += xv * rb[1]; lgt[6] += xv * rb[2]; lgt[7] += xv * rb[3]; }
#pragma unroll
                        for (int e = 0; e < 8; ++e) lgt[e] = wave_sum(lgt[e]);
                        int e0 = 0; float l0 = lgt[0];
#pragma unroll
                        for (int e = 1; e < 8; ++e) if (lgt[e] > l0) { l0 = lgt[e]; e0 = e; }
                        int e1 = -1; float l1 = -3.0e38f;
#pragma unroll
                        for (int e = 0; e < 8; ++e) if (e != e0 && lgt[e] > l1) { l1 = lgt[e]; e1 = e; }
                        const float ex = __expf(l1 - l0); const float w0 = 1.0f / (1.0f + ex), w1 = ex / (1.0f + ex);
                        if (lane == 0) { *(u32x4*)(ROUTE + (size_t)t * 4) = (u32x4){(unsigned)e0, (unsigned)e1, __float_as_uint(w0), __float_as_uint(w1)};
                            __hip_atomic_fetch_add(lcnt + e0, 1u, __ATOMIC_RELAXED, __HIP_MEMORY_SCOPE_WORKGROUP); __hip_atomic_fetch_add(lcnt + e1, 1u, __ATOMIC_RELAXED, __HIP_MEMORY_SCOPE_WORKGROUP); }
                    }
                }
                if (moe) { __syncthreads(); if (tid < 8) CNT[blk * 8 + tid] = lcnt[tid]; __syncthreads(); }
            }
        }
        SEAM(pb + 6);
        if (IN(pb + 7) && moe && EN(8)) { WSP;
            LAS float* scr = (LAS float*)(F.lds + wave * 16384);
            {
                const int per_e = (2 * D_FFE / 32) * 16, nit = NEXP * per_e;
                for (int it = gw; it < nit; it += NGW) { const int e = it / per_e, r = it % per_e, rb = r / 16, kb = r % 16; const int tile = rb >> 3, w = rb & 7;
                    cvt_item(((w < 4) ? INP(23) : INP(24)) + (size_t)e * 1024 * D_FFE, D_FFE, tile * 128 + (w & 3) * 32, kb * 64, false, (bf16*)(wsp + WS_MW13) + (size_t)e * 2 * D_FFE * 1024, 1024, rb * 32, scr, lane); }
            }
            __syncthreads();
            LAS unsigned* L = (LAS unsigned*)(F.lds + LDSCTL_OFF + 128);
            for (int blk = vcu; blk < 256; blk += G_) {
                if (tid < 16) L[tid] = 0u;
                __syncthreads();
                if (tid < 256) { const u32x4 c0 = *(const u32x4*)(CNT + tid * 8), c1 = *(const u32x4*)(CNT + tid * 8 + 4); const unsigned c[8] = {c0.x, c0.y, c0.z, c0.w, c1.x, c1.y, c1.z, c1.w};
#pragma unroll
                    for (int e = 0; e < 8; ++e) { __hip_atomic_fetch_add(L + e, c[e], __ATOMIC_RELAXED, __HIP_MEMORY_SCOPE_WORKGROUP); if (tid < blk) __hip_atomic_fetch_add(L + 8 + e, c[e], __ATOMIC_RELAXED, __HIP_MEMORY_SCOPE_WORKGROUP); } }
                __syncthreads();
                if (tid == 0) { unsigned off = 0; for (int e = 0; e < 8; ++e) { L[16 + e] = off; off += ((L[e] + 255u) >> 8) << 8; }
                    L[24] = off >> 8; }
                __syncthreads();
                if (blk == 0 && tid < MAXTILES) { unsigned e = 0;
#pragma unroll
                    for (unsigned k = 1; k < 8; ++k) if ((unsigned)tid >= (L[16 + k] >> 8) && L[k] > 0u) e = k;
                    ((unsigned char*)(META + 16))[tid] = (unsigned char)e; if (tid == 0) META[0] = L[24]; }
                if (wave == 0) { const int t = blk * 64 + lane; const u32x4 r = *(const u32x4*)(ROUTE + (size_t)t * 4); const int e0 = (int)r.x, e1 = (int)r.y; unsigned s0 = 0, s1 = 0;
                    const unsigned long long lt = (1ull << lane) - 1ull;
#pragma unroll
                    for (int e = 0; e < 8; ++e) { const unsigned long long m0 = __ballot(e0 == e), m1 = __ballot(e1 == e); const unsigned base = L[16 + e] + L[8 + e];
                        if (e0 == e) s0 = base + (unsigned)__popcll(m0 & lt); if (e1 == e) s1 = base + (unsigned)__popcll(m0) + (unsigned)__popcll(m1 & lt); }
                    L[32 + 2 * lane] = s0; L[33 + 2 * lane] = s1; *(u32x2*)(SLOT + (size_t)t * 2) = (u32x2){s0, s1}; }
                __syncthreads();
                for (int k = 0; k < 8; ++k) { const int tl = wave * 8 + k, t = blk * 64 + tl; const unsigned s0 = L[32 + 2 * tl], s1 = L[33 + 2 * tl];
                    bf16* d0 = (bf16*)(wsp + WS_XG) + (size_t)s0 * DM, *d1 = (bf16*)(wsp + WS_XG) + (size_t)s1 * DM;
#pragma unroll
                    for (int j = 0; j < 4; ++j) { const f32x4 v = *(const f32x4*)(XRES + (size_t)t * DM + 4 * lane + 256 * j); u32x2 w; w.x = pk2(v[0], v[1]); w.y = pk2(v[2], v[3]);
                        *(u32x2*)(d0 + 4 * lane + 256 * j) = w; *(u32x2*)(d1 + 4 * lane + 256 * j) = w; } }
                __syncthreads();
            }
        }
        SEAM(pb + 7);
        if (IN(pb + 8) && EN(9)) { WSP;
            LAS unsigned char* te = F.lds + LDSCTL_OFF + 1024;
            int ntiles = M / 256;
            if (moe) { ntiles = (int)META[0]; ntiles = ntiles > MAXTILES ? MAXTILES : ntiles; if (tid < MAXTILES) te[tid] = ((const unsigned char*)(META + 16))[tid]; }
            else { if (tid < MAXTILES) te[tid] = 0; }
            __syncthreads();
            ntiles = __builtin_amdgcn_readfirstlane(ntiles);
            if (!moe) { pg8::Gemm g{XB, (const bf16*)(wsp + WS_W13), 1024}; pg8::SchedGroup S; S.init(ntiles, 2 * D_FF / 256, 1024, G_, bid, te);
                pg8::EpiSwiGLU E{(bf16*)(wsp + WS_HID0), D_FF}; pg8::gemm_phase<pg8::EpiSwiGLU, pg8::SchedGroup, true, true>(F.lds, g, S, E, wave); }
            else { pg8::Gemm g{(const bf16*)(wsp + WS_XG), (const bf16*)(wsp + WS_MW13), 1024}; pg8::SchedGroup S; S.init(ntiles, 2 * D_FFE / 256, 1024, G_, bid, te);
                pg8::EpiSwiGLU E{(bf16*)(wsp + WS_MHID), D_FFE}; pg8::gemm_phase<pg8::EpiSwiGLU, pg8::SchedGroup, true, true>(F.lds, g, S, E, wave); }
        }
        SEAM(pb + 8);
        if (IN(pb + 9) && moe && EN(10)) { WSP;
            LAS float* scr = (LAS float*)(F.lds + wave * 16384);
            const int per_e = 32 * (D_FFE / 64), nit = NEXP * per_e;
            for (int it = gw; it < nit; it += NGW) { const int e = it / per_e, r = it % per_e, rb = r / (D_FFE / 64), kb = r % (D_FFE / 64);
                cvt_item(INP(25) + (size_t)e * D_FFE * 1024, 1024, rb * 32, kb * 64, false, (bf16*)(wsp + WS_MW2) + (size_t)e * 1024 * D_FFE, D_FFE, rb * 32, scr, lane); }
        }
        SEAM(pb + 9);
        if (IN(pb + 10) && EN(11)) { WSP;
            LAS unsigned char* te = F.lds + LDSCTL_OFF + 1024;
            if (!moe) { pg8::Gemm g{(const bf16*)(wsp + WS_HID0), (const bf16*)(wsp + WS_W2), D_FF}; pg8::SchedPlain S; S.init(M / 256, 4, D_FF, G_, bid);
                pg8::EpiRes E{XRES, Tb}; pg8::gemm_phase<pg8::EpiRes, pg8::SchedPlain, false, true>(F.lds, g, S, E, wave); }
            else { int ntiles = (int)META[0]; ntiles = ntiles > MAXTILES ? MAXTILES : ntiles; if (tid < MAXTILES) te[tid] = ((const unsigned char*)(META + 16))[tid];
                __syncthreads(); ntiles = __builtin_amdgcn_readfirstlane(ntiles);
                pg8::Gemm g{(const bf16*)(wsp + WS_MHID), (const bf16*)(wsp + WS_MW2), D_FFE}; pg8::SchedGroup S; S.init(ntiles, 4, D_FFE, G_, bid, te);
                pg8::EpiO E{(bf16*)(wsp + WS_XG)}; pg8::gemm_phase<pg8::EpiO, pg8::SchedGroup, true, true>(F.lds, g, S, E, wave); }
        }
        SEAM(pb + 10);
        if (IN(pb + 11) && EN(12)) { WSP;
            const float* lg = INP(26) + l * DM; const float* lb = INP(27) + l * DM; const bool last = (l == DEPTH - 1);
            const bf16* Ob = (const bf16*)(wsp + WS_XG);
            for (int t = gw; t < M; t += NGW) { f32x4 v[4];
                if (!moe) {
#pragma unroll
                    for (int j = 0; j < 4; ++j) v[j] = *(const f32x4*)(Tb + (size_t)t * DM + 4 * lane + 256 * j);
                } else { const u32x4 r = *(const u32x4*)(ROUTE + (size_t)t * 4); const u32x2 sl = *(const u32x2*)(SLOT + (size_t)t * 2); const float w0 = __uint_as_float(r.z), w1 = __uint_as_float(r.w);
#pragma unroll
                    for (int j = 0; j < 4; ++j) { const f32x4 xv = *(const f32x4*)(XRES + (size_t)t * DM + 4 * lane + 256 * j);
                        const u32x2 a = *(const u32x2*)(Ob + (size_t)sl.x * DM + 4 * lane + 256 * j), b = *(const u32x2*)(Ob + (size_t)sl.y * DM + 4 * lane + 256 * j);
                        v[j][0] = xv[0] * ALPHA + w0 * pg8::bf_lo(a.x) + w1 * pg8::bf_lo(b.x); v[j][1] = xv[1] * ALPHA + w0 * pg8::bf_hi(a.x) + w1 * pg8::bf_hi(b.x);
                        v[j][2] = xv[2] * ALPHA + w0 * pg8::bf_lo(a.y) + w1 * pg8::bf_lo(b.y); v[j][3] = xv[3] * ALPHA + w0 * pg8::bf_hi(a.y) + w1 * pg8::bf_hi(b.y); } }
                ln_row(v, lg, lb, lane);
#if DBG_ZROWS
                if (last && (DBG_ZCOND)) { v[0] = f32x4{}; v[1] = f32x4{}; v[2] = f32x4{}; v[3] = f32x4{}; }
#endif
                if (last) store_row_f32(((float*)INP(28)) + (size_t)t * DM, v, lane);
                else { store_row_f32(XRES + (size_t)t * DM, v, lane); store_row_bf16(XB + (size_t)t * DM, v, lane); } }
        }
        SEAM(pb + 11);
    }
    {
        constexpr int l = 1;
        const int pb = 1 + PH_PER_LAYER * l;
        const bool moe = (l & 1) != 0;
        if (IN(pb + 0) && EN(1)) { WSP;
            pg8::Gemm g{XB, (const bf16*)(wsp + WS_WIN) + (size_t)l * NW_IN * 1024, 1024}; pg8::SchedPlain S; S.init(M / 256, NW_IN / 256, 1024, G_, bid);
            pg8::EpiWin E{Hb, Gt};
            pg8::gemm_phase<pg8::EpiWin, pg8::SchedPlain, true, true>(F.lds, g, S, E, wave);
        }
        SEAM(pb + 0);
        if (IN(pb + 1) && EN(2)) { WSP;
            const float* aqn = INP(4) + l * 64; const float* akn = INP(5) + l * 64; const float* cqn = INP(7) + l * 192; const float* ckvn = INP(8) + l * 128;
            for (int t = gw; t < M; t += NGW) { const int s = t & (SEQ - 1); const bf16* hr = Hb + (size_t)t * HP;
                {
                    const u32x2 w = *(const u32x2*)(hr + 4 * lane); float v[4] = {pg8::bf_lo(w.x), pg8::bf_hi(w.x), pg8::bf_lo(w.y), pg8::bf_hi(w.y)};
                    float ss = v[0] * v[0] + v[1] * v[1] + v[2] * v[2] + v[3] * v[3]; ss = sum16(ss);
                    const float rs = 1.0f / sqrtf(ss * (1.f / 64.f) + RMS_EPS); const int d = 4 * (lane & 15); const f32x4 gg = *(const f32x4*)(aqn + d);
                    const f32x2 cs = *(const f32x2*)(ropeA_c + s * 32 + (d >> 1)), sn = *(const f32x2*)(ropeA_s + s * 32 + (d >> 1));
                    const float a0 = v[0] * rs * gg[0], a1 = v[1] * rs * gg[1], a2 = v[2] * rs * gg[2], a3 = v[3] * rs * gg[3];
                    u32x2 o; o.x = pk2((a0 * cs[0] - a1 * sn[0]) * QS64, (a0 * sn[0] + a1 * cs[0]) * QS64); o.y = pk2((a2 * cs[1] - a3 * sn[1]) * QS64, (a2 * sn[1] + a3 * cs[1]) * QS64);
                    *(u32x2*)(QA + (size_t)t * 256 + 4 * lane) = o; }
                if (lane < 32) {
                    const u32x2 w = *(const u32x2*)(hr + 256 + 4 * lane); float v[4] = {pg8::bf_lo(w.x), pg8::bf_hi(w.x), pg8::bf_lo(w.y), pg8::bf_hi(w.y)};
                    float ss = v[0] * v[0] + v[1] * v[1] + v[2] * v[2] + v[3] * v[3]; ss = sum16(ss);
                    const float rs = 1.0f / sqrtf(ss * (1.f / 64.f) + RMS_EPS); const int d = 4 * (lane & 15); const f32x4 gg = *(const f32x4*)(akn + d);
                    const f32x2 cs = *(const f32x2*)(ropeA_c + s * 32 + (d >> 1)), sn = *(const f32x2*)(ropeA_s + s * 32 + (d >> 1));
                    const float a0 = v[0] * rs * gg[0], a1 = v[1] * rs * gg[1], a2 = v[2] * rs * gg[2], a3 = v[3] * rs * gg[3];
                    u32x2 o; o.x = pk2(a0 * cs[0] - a1 * sn[0], a0 * sn[0] + a1 * cs[0]); o.y = pk2(a2 * cs[1] - a3 * sn[1], a2 * sn[1] + a3 * cs[1]);
                    *(u32x2*)(KA + (size_t)t * 128 + 4 * lane) = o; }
                {
                    float v[4] = {0.f, 0.f, 0.f, 0.f};
                    if (lane < 48) { const u32x2 w = *(const u32x2*)(hr + 1280 + 4 * lane); v[0] = pg8::bf_lo(w.x); v[1] = pg8::bf_hi(w.x); v[2] = pg8::bf_lo(w.y); v[3] = pg8::bf_hi(w.y); }
                    const float ss = wave_sum(v[0] * v[0] + v[1] * v[1] + v[2] * v[2] + v[3] * v[3]); const float rs = 1.0f / sqrtf(ss * (1.f / 192.f) + RMS_EPS);
                    u32x2 o = {0u, 0u};
                    if (lane < 48) { const f32x4 gg = *(const f32x4*)(cqn + 4 * lane); o.x = pk2(v[0] * rs * gg[0], v[1] * rs * gg[1]); o.y = pk2(v[2] * rs * gg[2], v[3] * rs * gg[3]); }
                    *(u32x2*)(CQN + (size_t)t * 256 + 4 * lane) = o; }
                {
                    float v[4] = {0.f, 0.f, 0.f, 0.f};
                    if (lane < 32) { const u32x2 w = *(const u32x2*)(hr + 1536 + 4 * lane); v[0] = pg8::bf_lo(w.x); v[1] = pg8::bf_hi(w.x); v[2] = pg8::bf_lo(w.y); v[3] = pg8::bf_hi(w.y); }
                    const float ss = wave_sum(v[0] * v[0] + v[1] * v[1] + v[2] * v[2] + v[3] * v[3]); const float rs = 1.0f / sqrtf(ss * (1.f / 128.f) + RMS_EPS);
                    u32x2 o = {0u, 0u};
                    if (lane < 32) { const f32x4 gg = *(const f32x4*)(ckvn + 4 * lane); o.x = pk2(v[0] * rs * gg[0], v[1] * rs * gg[1]); o.y = pk2(v[2] * rs * gg[2], v[3] * rs * gg[3]); }
                    *(u32x2*)(CKVN + (size_t)t * 256 + 4 * lane) = o; }
                if (lane < 32) {
                    const int j = lane & 7, hh = lane >> 3; const u32x2 w = *(const u32x2*)(hr + 1664 + 4 * j);
                    const float a0 = pg8::bf_lo(w.x), a1 = pg8::bf_hi(w.x), a2 = pg8::bf_lo(w.y), a3 = pg8::bf_hi(w.y);
                    const f32x2 cs = *(const f32x2*)(ropeC_c + s * 16 + 2 * j), sn = *(const f32x2*)(ropeC_s + s * 16 + 2 * j);
                    u32x2 o; o.x = pk2(a0 * cs[0] - a1 * sn[0], a0 * sn[0] + a1 * cs[0]); o.y = pk2(a2 * cs[1] - a3 * sn[1], a2 * sn[1] + a3 * cs[1]);
                    *(u32x2*)(KC + (size_t)t * 384 + hh * 96 + 64 + 4 * j) = o; }
            }
        }
        SEAM(pb + 1);
        if (IN(pb + 2) && EN(3)) { WSP;
            { pg8::Gemm g{CQN, (const bf16*)(wsp + WS_WUQ) + (size_t)l * 512 * 256, 256}; pg8::SchedPlain S; S.init(M / 256, 2, 256, G_, bid);
              pg8::EpiUq E{QC, ropeC_c, ropeC_s}; pg8::gemm_phase<pg8::EpiUq, pg8::SchedPlain, false, true>(F.lds, g, S, E, wave); }
            { pg8::Gemm g{CKVN, (const bf16*)(wsp + WS_WUKV) + (size_t)l * 512 * 256, 256}; pg8::SchedPlain S; S.init(M / 256, 2, 256, G_, bid);
              pg8::EpiUkv E{KC, VC}; pg8::gemm_phase<pg8::EpiUkv, pg8::SchedPlain, false, true>(F.lds, g, S, E, wave); }
        }
        SEAM(pb + 2);
        if (IN(pb + 3) && EN(4)) { WSP;
            for (int u = vcu; u < 256; u += G_) {
#if DBG_LDSFILL
                for (int i = tid; i < 49152 / 4; i += 512) ((LAS unsigned*)F.lds)[i] = DBG_LDSFILL_VAL; __syncthreads();
#endif
                const int b = u >> 5, hh = (u >> 3) & 3, qb = u & 7; const size_t r0 = (size_t)b * SEQ + qb * 256, b0 = (size_t)b * SEQ;
#if DBG_ZERO_AC
                for (int i = tid; i < 256 * 8; i += 512) { const int rr = i >> 3, c8 = i & 7; *(u32x4*)(YS + ((size_t)0 * M + r0 + rr) * 256 + hh * 64 + c8 * 8) = (u32x4){0u, 0u, 0u, 0u}; *(u32x4*)(YS + ((size_t)2 * M + r0 + rr) * 256 + hh * 64 + c8 * 8) = (u32x4){0u, 0u, 0u, 0u}; }
#else
                att::attn_unit<64, 0>(F.lds, QA + r0 * 256 + hh * 64, 256, KA + b0 * 128 + (hh >> 1) * 64, 128, Hb + b0 * HP + OFF_AV + (hh >> 1) * 64, HP, YS + r0 * 256 + hh * 64, 256, SEQ / 64, 0, wave);
                att::attn_unit<96, 0>(F.lds, QC + r0 * 384 + hh * 96, 384, KC + b0 * 384 + hh * 96, 384, VC + b0 * 256 + hh * 64, 256, YS + ((size_t)2 * M + r0) * 256 + hh * 64, 256, SEQ / 64, 0, wave);
#endif
                { const float* rpb = INP(6) + ((size_t)l * 4 + hh) * 15 * 31; LAS float* tab = (LAS float*)(F.lds + att::RPB_OFF);
                  if (tid < 480) { const int dr = tid >> 5, dc = tid & 31; tab[tid] = (dc < 31) ? rpb[dr * 31 + dc] * LOG2E : 0.f; }
                  __syncthreads(); }
#if DBG_ZERO_B
                for (int i = tid; i < 256 * 8; i += 512) { const int rr = i >> 3, c8 = i & 7; *(u32x4*)(YS + ((size_t)1 * M + r0 + rr) * 256 + hh * 64 + c8 * 8) = (u32x4){0u, 0u, 0u, 0u}; }
#else
                att::attn_unit<64, 1>(F.lds, Hb + r0 * HP + OFF_BQ + hh * 64, HP, Hb + b0 * HP + OFF_BK + hh * 64, HP, Hb + b0 * HP + OFF_BV + hh * 64, HP, YS + ((size_t)1 * M + r0) * 256 + hh * 64, 256, NROWS, qb * 4, wave);
#endif
                {
                    const int t0 = u * 64, s0 = t0 & (SEQ - 1); LAS bf16* tile = (LAS bf16*)F.lds;
                    for (int i = tid; i < 94 * 32; i += 512) { const int rr = i >> 5, c8 = i & 31; const int s = s0 - 15 + rr; u32x4 v = {0u, 0u, 0u, 0u};
                        if (s >= 0 && s < SEQ) v = *(const u32x4*)(Hb + (size_t)(t0 - 15 + rr) * HP + 1792 + c8 * 8);
                        *(LAS u32x4*)(tile + rr * 256 + c8 * 8) = v; }
                    __syncthreads();
                    const float* cw = INP(11) + (size_t)l * 31 * 256; const int c4 = 4 * lane;
                    f32x4 acc[8];
                    { const f32x4 bb = *(const f32x4*)(INP(12) + l * 256 + c4);
#pragma unroll
                      for (int j = 0; j < 8; ++j) acc[j] = bb; }
                    for (int k = 0; k < 31; ++k) { const f32x4 wk = *(const f32x4*)(cw + k * 256 + c4);
#pragma unroll
                        for (int j = 0; j < 8; ++j) { const u32x2 w = *(const LAS u32x2*)(tile + (wave * 8 + j + k) * 256 + c4);
                            acc[j][0] += wk[0] * pg8::bf_lo(w.x); acc[j][1] += wk[1] * pg8::bf_hi(w.x); acc[j][2] += wk[2] * pg8::bf_lo(w.y); acc[j][3] += wk[3] * pg8::bf_hi(w.y); } }
                    const f32x4 lg = *(const f32x4*)(INP(13) + l * 256 + c4), lb = *(const f32x4*)(INP(14) + l * 256 + c4);
#pragma unroll
                    for (int j = 0; j < 8; ++j) { f32x4 v = acc[j]; const float mean = wave_sum((v[0] + v[1]) + (v[2] + v[3])) * (1.f / 256.f); v = v - mean;
                        const float var = wave_sum((v[0] * v[0] + v[1] * v[1]) + (v[2] * v[2] + v[3] * v[3])) * (1.f / 256.f); const float rstd = 1.0f / sqrtf(var + LN_EPS);
                        v = v * rstd * lg + lb;
                        u32x2 o; o.x = pk2(v[0] * pg8::sigmoidf_(v[0]), v[1] * pg8::sigmoidf_(v[1])); o.y = pk2(v[2] * pg8::sigmoidf_(v[2]), v[3] * pg8::sigmoidf_(v[3]));
                        *(u32x2*)(YS + ((size_t)3 * M + t0 + wave * 8 + j) * 256 + c4) = o; }
                    __syncthreads();
                }
            }
        }
        SEAM(pb + 3);
        if (IN(pb + 4) && EN(5)) { WSP;
            pg8::Gemm g{YS, (const bf16*)(wsp + WS_WBR) + (size_t)l * 4 * 1024 * 256, 256}; pg8::SchedMerge S; S.init(G_, bid);
            pg8::EpiMerge E{Gt, MG}; pg8::gemm_phase<pg8::EpiMerge, pg8::SchedMerge, false, true>(F.lds, g, S, E, wave);
        }
        SEAM(pb + 4);
        if (IN(pb + 5) && EN(6)) { WSP;
            pg8::Gemm g{MG, (const bf16*)(wsp + WS_WOUT) + (size_t)l * 1024 * 1024, 1024}; pg8::SchedPlain S; S.init(M / 256, 4, 1024, G_, bid);
            pg8::EpiRes E{XRES, Tb}; pg8::gemm_phase<pg8::EpiRes, pg8::SchedPlain, false, true>(F.lds, g, S, E, wave);
        }
        SEAM(pb + 5);
        if (IN(pb + 6) && EN(7)) { WSP;
            const float* lg = INP(17) + l * DM; const float* lb = INP(18) + l * DM; const float* router = INP(22);
            LAS unsigned* lcnt = (LAS unsigned*)(F.lds + LDSCTL_OFF + 64);
            for (int blk = vcu; blk < 256; blk += G_) {
                if (moe) { if (tid < 8) lcnt[tid] = 0u; __syncthreads(); }
                for (int k = 0; k < 8; ++k) { const int t = blk * 64 + wave * 8 + k; f32x4 v[4];
#pragma unroll
                    for (int j = 0; j < 4; ++j) v[j] = *(const f32x4*)(Tb + (size_t)t * DM + 4 * lane + 256 * j);
                    ln_row(v, lg, lb, lane); store_row_f32(XRES + (size_t)t * DM, v, lane);
                    if (!moe) store_row_bf16(XB + (size_t)t * DM, v, lane);
                    else {
                        float lgt[8] = {0.f, 0.f, 0.f, 0.f, 0.f, 0.f, 0.f, 0.f};
#pragma unroll
                        for (int j = 0; j < 4; ++j)
#pragma unroll
                            for (int e4 = 0; e4 < 4; ++e4) { const float xv = v[j][e4]; const float* rr = router + (size_t)(4 * lane + 256 * j + e4) * 8; const f32x4 ra = *(const f32x4*)rr, rb = *(const f32x4*)(rr + 4);
                                lgt[0] += xv * ra[0]; lgt[1] += xv * ra[1]; lgt[2] += xv * ra[2]; lgt[3] += xv * ra[3]; lgt[4] += xv * rb[0]; lgt[5] += xv * rb[1]; lgt[6] += xv * rb[2]; lgt[7] += xv * rb[3]; }
#pragma unroll
                        for (int e = 0; e < 8; ++e) lgt[e] = wave_sum(lgt[e]);
                        int e0 = 0; float l0 = lgt[0];
#pragma unroll
                        for (int e = 1; e < 8; ++e) if (lgt[e] > l0) { l0 = lgt[e]; e0 = e; }
                        int e1 = -1; float l1 = -3.0e38f;
#pragma unroll
                        for (int e = 0; e < 8; ++e) if (e != e0 && lgt[e] > l1) { l1 = lgt[e]; e1 = e; }
                        const float ex = __expf(l1 - l0); const float w0 = 1.0f / (1.0f + ex), w1 = ex / (1.0f + ex);
                        if (lane == 0) { *(u32x4*)(ROUTE + (size_t)t * 4) = (u32x4){(unsigned)e0, (unsigned)e1, __float_as_uint(w0), __float_as_uint(w1)};
                            __hip_atomic_fetch_add(lcnt + e0, 1u, __ATOMIC_RELAXED, __HIP_MEMORY_SCOPE_WORKGROUP); __hip_atomic_fetch_add(lcnt + e1, 1u, __ATOMIC_RELAXED, __HIP_MEMORY_SCOPE_WORKGROUP); }
                    }
                }
                if (moe) { __syncthreads(); if (tid < 8) CNT[blk * 8 + tid] = lcnt[tid]; __syncthreads(); }
            }
        }
        SEAM(pb + 6);
        if (IN(pb + 7) && moe && EN(8)) { WSP;
            LAS float* scr = (LAS float*)(F.lds + wave * 16384);
            {
                const int per_e = (2 * D_FFE / 32) * 16, nit = NEXP * per_e;
                for (int it = gw; it < nit; it += NGW) { const int e = it / per_e, r = it % per_e, rb = r / 16, kb = r % 16; const int tile = rb >> 3, w = rb & 7;
                    cvt_item(((w < 4) ? INP(23) : INP(24)) + (size_t)e * 1024 * D_FFE, D_FFE, tile * 128 + (w & 3) * 32, kb * 64, false, (bf16*)(wsp + WS_MW13) + (size_t)e * 2 * D_FFE * 1024, 1024, rb * 32, scr, lane); }
            }
            __syncthreads();
            LAS unsigned* L = (LAS unsigned*)(F.lds + LDSCTL_OFF + 128);
            for (int blk = vcu; blk < 256; blk += G_) {
                if (tid < 16) L[tid] = 0u;
                __syncthreads();
                if (tid < 256) { const u32x4 c0 = *(const u32x4*)(CNT + tid * 8), c1 = *(const u32x4*)(CNT + tid * 8 + 4); const unsigned c[8] = {c0.x, c0.y, c0.z, c0.w, c1.x, c1.y, c1.z, c1.w};
#pragma unroll
                    for (int e = 0; e < 8; ++e) { __hip_atomic_fetch_add(L + e, c[e], __ATOMIC_RELAXED, __HIP_MEMORY_SCOPE_WORKGROUP); if (tid < blk) __hip_atomic_fetch_add(L + 8 + e, c[e], __ATOMIC_RELAXED, __HIP_MEMORY_SCOPE_WORKGROUP); } }
                __syncthreads();
                if (tid == 0) { unsigned off = 0; for (int e = 0; e < 8; ++e) { L[16 + e] = off; off += ((L[e] + 255u) >> 8) << 8; }
                    L[24] = off >> 8; }
                __syncthreads();
                if (blk == 0 && tid < MAXTILES) { unsigned e = 0;
#pragma unroll
                    for (unsigned k = 1; k < 8; ++k) if ((unsigned)tid >= (L[16 + k] >> 8) && L[k] > 0u) e = k;
                    ((unsigned char*)(META + 16))[tid] = (unsigned char)e; if (tid == 0) META[0] = L[24]; }
                if (wave == 0) { const int t = blk * 64 + lane; const u32x4 r = *(const u32x4*)(ROUTE + (size_t)t * 4); const int e0 = (int)r.x, e1 = (int)r.y; unsigned s0 = 0, s1 = 0;
                    const unsigned long long lt = (1ull << lane) - 1ull;
#pragma unroll
                    for (int e = 0; e < 8; ++e) { const unsigned long long m0 = __ballot(e0 == e), m1 = __ballot(e1 == e); const unsigned base = L[16 + e] + L[8 + e];
                        if (e0 == e) s0 = base + (unsigned)__popcll(m0 & lt); if (e1 == e) s1 = base + (unsigned)__popcll(m0) + (unsigned)__popcll(m1 & lt); }
                    L[32 + 2 * lane] = s0; L[33 + 2 * lane] = s1; *(u32x2*)(SLOT + (size_t)t * 2) = (u32x2){s0, s1}; }
                __syncthreads();
                for (int k = 0; k < 8; ++k) { const int tl = wave * 8 + k, t = blk * 64 + tl; const unsigned s0 = L[32 + 2 * tl], s1 = L[33 + 2 * tl];
                    bf16* d0 = (bf16*)(wsp + WS_XG) + (size_t)s0 * DM, *d1 = (bf16*)(wsp + WS_XG) + (size_t)s1 * DM;
#pragma unroll
                    for (int j = 0; j < 4; ++j) { const f32x4 v = *(const f32x4*)(XRES + (size_t)t * DM + 4 * lane + 256 * j); u32x2 w; w.x = pk2(v[0], v[1]); w.y = pk2(v[2], v[3]);
                        *(u32x2*)(d0 + 4 * lane + 256 * j) = w; *(u32x2*)(d1 + 4 * lane + 256 * j) = w; } }
                __syncthreads();
            }
        }
        SEAM(pb + 7);
        if (IN(pb + 8) && EN(9)) { WSP;
            LAS unsigned char* te = F.lds + LDSCTL_OFF + 1024;
            int ntiles = M / 256;
            if (moe) { ntiles = (int)META[0]; ntiles = ntiles > MAXTILES ? MAXTILES : ntiles; if (tid < MAXTILES) te[tid] = ((const unsigned char*)(META + 16))[tid]; }
            else { if (tid < MAXTILES) te[tid] = 0; }
            __syncthreads();
            ntiles = __builtin_amdgcn_readfirstlane(ntiles);
            if (!moe) { pg8::Gemm g{XB, (const bf16*)(wsp + WS_W13), 1024}; pg8::SchedGroup S; S.init(ntiles, 2 * D_FF / 256, 1024, G_, bid, te);
                pg8::EpiSwiGLU E{(bf16*)(wsp + WS_HID0), D_FF}; pg8::gemm_phase<pg8::EpiSwiGLU, pg8::SchedGroup, true, true>(F.lds, g, S, E, wave); }
            else { pg8::Gemm g{(const bf16*)(wsp + WS_XG), (const bf16*)(wsp + WS_MW13), 1024}; pg8::SchedGroup S; S.init(ntiles, 2 * D_FFE / 256, 1024, G_, bid, te);
                pg8::EpiSwiGLU E{(bf16*)(wsp + WS_MHID), D_FFE}; pg8::gemm_phase<pg8::EpiSwiGLU, pg8::SchedGroup, true, true>(F.lds, g, S, E, wave); }
        }
        SEAM(pb + 8);
        if (IN(pb + 9) && moe && EN(10)) { WSP;
            LAS float* scr = (LAS float*)(F.lds + wave * 16384);
            const int per_e = 32 * (D_FFE / 64), nit = NEXP * per_e;
            for (int it = gw; it < nit; it += NGW) { const int e = it / per_e, r = it % per_e, rb = r / (D_FFE / 64), kb = r % (D_FFE / 64);
                cvt_item(INP(25) + (size_t)e * D_FFE * 1024, 1024, rb * 32, kb * 64, false, (bf16*)(wsp + WS_MW2) + (size_t)e * 1024 * D_FFE, D_FFE, rb * 32, scr, lane); }
        }
        SEAM(pb + 9);
        if (IN(pb + 10) && EN(11)) { WSP;
            LAS unsigned char* te = F.lds + LDSCTL_OFF + 1024;
            if (!moe) { pg8::Gemm g{(const bf16*)(wsp + WS_HID0), (const bf16*)(wsp + WS_W2), D_FF}; pg8::SchedPlain S; S.init(M / 256, 4, D_FF, G_, bid);
                pg8::EpiRes E{XRES, Tb}; pg8::gemm_phase<pg8::EpiRes, pg8::SchedPlain, false, true>(F.lds, g, S, E, wave); }
            else { int ntiles = (int)META[0]; ntiles = ntiles > MAXTILES ? MAXTILES : ntiles; if (tid < MAXTILES) te[tid] = ((const unsigned char*)(META + 16))[tid];
                __syncthreads(); ntiles = __builtin_amdgcn_readfirstlane(ntiles);
                pg8::Gemm g{(const bf16*)(wsp + WS_MHID), (const bf16*)(wsp + WS_MW2), D_FFE}; pg8::SchedGroup S; S.init(ntiles, 4, D_FFE, G_, bid, te);
                pg8::EpiO E{(bf16*)(wsp + WS_XG)}; pg8::gemm_phase<pg8::EpiO, pg8::SchedGroup, true, true>(F.lds, g, S, E, wave); }
        }
        SEAM(pb + 10);
        if (IN(pb + 11) && EN(12)) { WSP;
            const float* lg = INP(26) + l * DM; const float* lb = INP(27) + l * DM; const bool last = (l == DEPTH - 1);
            const bf16* Ob = (const bf16*)(wsp + WS_XG);
            for (int t = gw; t < M; t += NGW) { f32x4 v[4];
                if (!moe) {
#pragma unroll
                    for (int j = 0; j < 4; ++j) v[j] = *(const f32x4*)(Tb + (size_t)t * DM + 4 * lane + 256 * j);
                } else { const u32x4 r = *(const u32x4*)(ROUTE + (size_t)t * 4); const u32x2 sl = *(const u32x2*)(SLOT + (size_t)t * 2); const float w0 = __uint_as_float(r.z), w1 = __uint_as_float(r.w);
#pragma unroll
                    for (int j = 0; j < 4; ++j) { const f32x4 xv = *(const f32x4*)(XRES + (size_t)t * DM + 4 * lane + 256 * j);
                        const u32x2 a = *(const u32x2*)(Ob + (size_t)sl.x * DM + 4 * lane + 256 * j), b = *(const u32x2*)(Ob + (size_t)sl.y * DM + 4 * lane + 256 * j);
                        v[j][0] = xv[0] * ALPHA + w0 * pg8::bf_lo(a.x) + w1 * pg8::bf_lo(b.x); v[j][1] = xv[1] * ALPHA + w0 * pg8::bf_hi(a.x) + w1 * pg8::bf_hi(b.x);
                        v[j][2] = xv[2] * ALPHA + w0 * pg8::bf_lo(a.y) + w1 * pg8::bf_lo(b.y); v[j][3] = xv[3] * ALPHA + w0 * pg8::bf_hi(a.y) + w1 * pg8::bf_hi(b.y); } }
                ln_row(v, lg, lb, lane);
#if DBG_ZROWS
                if (last && (DBG_ZCOND)) { v[0] = f32x4{}; v[1] = f32x4{}; v[2] = f32x4{}; v[3] = f32x4{}; }
#endif
                if (last) store_row_f32(((float*)INP(28)) + (size_t)t * DM, v, lane);
                else { store_row_f32(XRES + (size_t)t * DM, v, lane); store_row_bf16(XB + (size_t)t * DM, v, lane); } }
        }
        SEAM(pb + 11);
    }
#undef IN
#undef SEAM
}


#if DBG_CHK
#undef XRES
#undef XB
#undef Hb
#undef Gt
#undef Tb
#undef QA
#undef KA
#undef CQN
#undef CKVN
#undef QC
#undef KC
#undef VC
#undef MG
#undef YS
#undef ROUTE
#undef SLOT
#undef CNT
#undef META
namespace chk {
__device__ __forceinline__ float b2f(bf16 v) { return __uint_as_float(((unsigned)v) << 16); }
__device__ __forceinline__ float rbf(float f) { unsigned u = __float_as_uint(f); u = (u + 0x7fffu + ((u >> 16) & 1u)) & 0xffff0000u; return __uint_as_float(u); }
__device__ __forceinline__ float sg(float x) { return 1.0f / (1.0f + expf(-x)); }
__device__ __forceinline__ void rec(unsigned* met, int k, float err) { if (!(err == err)) err = 1e30f; atomicMax(met + k, __float_as_uint(fabsf(err))); }
__device__ __forceinline__ int srow(int i) { return 16 * i + ((i * 5) & 15); }
__device__ __forceinline__ float bsum(float v, float* sh) { const int t = threadIdx.x; __syncthreads(); sh[t] = v; __syncthreads(); for (int s = 128; s > 0; s >>= 1) { if (t < s) sh[t] += sh[t + s]; __syncthreads(); } const float r = sh[0]; __syncthreads(); return r; }
__device__ __forceinline__ float bmax(float v, float* sh) { const int t = threadIdx.x; __syncthreads(); sh[t] = v; __syncthreads(); for (int s = 128; s > 0; s >>= 1) { if (t < s) sh[t] = fmaxf(sh[t], sh[t + s]); __syncthreads(); } const float r = sh[0]; __syncthreads(); return r; }
}
__global__ void __launch_bounds__(256) chk_kernel(Args args, int l, int which) {
    using namespace chk;
    __shared__ float sh[256]; __shared__ float sc[2048]; __shared__ float rowbuf[1024];
    unsigned char* ws = args.ws; unsigned* met = (unsigned*)(ws + WS_CTL) + 1024;
    const int tid = threadIdx.x, t = srow(blockIdx.x), s = t & (SEQ - 1), b0 = t - s;
    const bf16* XB = (const bf16*)(ws + WS_XB); const float* XRES = (const float*)(ws + WS_XRES); const bf16* H = (const bf16*)(ws + WS_H); const bf16* G = (const bf16*)(ws + WS_G);
    const float* T = (const float*)(ws + WS_T); const bf16* QA = (const bf16*)(ws + WS_QA); const bf16* KA = (const bf16*)(ws + WS_KA); const bf16* CQN = (const bf16*)(ws + WS_CQN); const bf16* CKVN = (const bf16*)(ws + WS_CKVN);
    const bf16* QC = (const bf16*)(ws + WS_QC); const bf16* KC = (const bf16*)(ws + WS_KC); const bf16* VC = (const bf16*)(ws + WS_VC); const bf16* MG = (const bf16*)(ws + WS_MG); const bf16* YS = (const bf16*)(ws + WS_YS);
    const bf16* HID0 = (const bf16*)(ws + WS_HID0);
#define in args.in
    float worst = 0.f;
    if (which == 2) {
        const float* w = in[3] + (size_t)l * 1024 * D_IN;
        for (int i = tid; i < 1024; i += 256) rowbuf[i] = b2f(XB[(size_t)t * DM + i]);
        __syncthreads();
        for (int c = tid; c < D_IN; c += 256) {
            if (c >= OFF_GLU + 256 && c < OFF_GATE) continue;
            float h = 0.f; for (int k = 0; k < 1024; ++k) h += rowbuf[k] * rbf(w[(size_t)k * D_IN + c]);
            float ref, got;
            if (c < 1280) { ref = (c >= 512 && c < 768) ? h * QS64 : h; got = b2f(H[(size_t)t * HP + c]); }
            else if (c < OFF_CKV) { ref = h; got = b2f(H[(size_t)t * HP + 1280 + (c - OFF_CQ)]); }
            else if (c < OFF_KPE) { ref = h; got = b2f(H[(size_t)t * HP + 1536 + (c - OFF_CKV)]); }
            else if (c < OFF_GLU) { ref = h; got = b2f(H[(size_t)t * HP + 1664 + (c - OFF_KPE)]); }
            else if (c < OFF_GLU + 256) { float g2 = 0.f; for (int k = 0; k < 1024; ++k) g2 += rowbuf[k] * rbf(w[(size_t)k * D_IN + c + 256]); ref = h * sg(g2); got = b2f(H[(size_t)t * HP + 1792 + (c - OFF_GLU)]); }
            else { ref = sg(h); got = b2f(G[(size_t)t * 4096 + (c - OFF_GATE)]); }
            const float er_ = fabsf(ref - got) / (0.05f + fabsf(ref)); worst = fmaxf(worst, er_);
            if (l == 0 && er_ > DBG_TOL) atomicMax(met + 100, 0xFFFFFFFFu - ((unsigned)blockIdx.x * 8192u + (unsigned)c));
            if (l == 0 && er_ > DBG_TOL) { atomicMax(met + 103, (unsigned)c); atomicAdd(met + (c < OFF_GATE ? 104 : 105), 1u); }
        }
        { const float wm = bmax(worst, sh); if (l == 0 && tid == 0 && wm > DBG_TOL) { atomicAdd(met + 101, 1u); atomicMax(met + 102, (unsigned)blockIdx.x); } rec(met + 32 * l, 2, wm); }
    } else if (which == 3) {
        const float* aqn = in[4] + l * 64; const float* akn = in[5] + l * 64; const float* cqn = in[7] + l * 192; const float* ckvn = in[8] + l * 128;
        const float row = (float)(s / GRIDW), col = (float)(s % GRIDW);
        for (int i = tid; i < 256 + 128; i += 256) { const bool isq = i < 256; const int hd = isq ? i / 64 : (i - 256) / 64, d = i % 64; const bf16* src = H + (size_t)t * HP + (isq ? 0 : 256) + hd * 64;
            float ss = 0.f; for (int k = 0; k < 64; ++k) { const float v = b2f(src[k]); ss += v * v; } const float rs = 1.0f / sqrtf(ss / 64.f + 1e-6f); const float* gn = isq ? aqn : akn;
            const int p = d >> 1; const float inv = powf(10000.f, -(float)(p & 15) / 16.f); const float ang = (p < 16 ? row : col) * inv; const float c_ = cosf(ang), s_ = sinf(ang);
            const float x1 = b2f(src[2 * p]) * rs * gn[2 * p], x2 = b2f(src[2 * p + 1]) * rs * gn[2 * p + 1]; float ref = (d & 1) ? (x1 * s_ + x2 * c_) : (x1 * c_ - x2 * s_); if (isq) ref *= QS64;
            const float got = isq ? b2f(QA[(size_t)t * 256 + i]) : b2f(KA[(size_t)t * 128 + (i - 256)]); worst = fmaxf(worst, fabsf(ref - got) / (0.05f + fabsf(ref))); }
        for (int i = tid; i < 256; i += 256) { float ss = 0.f; for (int k = 0; k < 192; ++k) { const float v = b2f(H[(size_t)t * HP + 1280 + k]); ss += v * v; } const float rs = 1.0f / sqrtf(ss / 192.f + 1e-6f);
            const float ref = i < 192 ? b2f(H[(size_t)t * HP + 1280 + i]) * rs * cqn[i] : 0.f; worst = fmaxf(worst, fabsf(ref - b2f(CQN[(size_t)t * 256 + i])) / (0.05f + fabsf(ref)));
            float s2 = 0.f; for (int k = 0; k < 128; ++k) { const float v = b2f(H[(size_t)t * HP + 1536 + k]); s2 += v * v; } const float r2 = 1.0f / sqrtf(s2 / 128.f + 1e-6f);
            const float ref2 = i < 128 ? b2f(H[(size_t)t * HP + 1536 + i]) * r2 * ckvn[i] : 0.f; worst = fmaxf(worst, fabsf(ref2 - b2f(CKVN[(size_t)t * 256 + i])) / (0.05f + fabsf(ref2))); }
        for (int i = tid; i < 128; i += 256) { const int hh = i / 32, d = i % 32, p = d >> 1; const float inv = powf(10000.f, -(float)(p & 7) / 8.f); const float ang = (p < 8 ? row : col) * inv; const float c_ = cosf(ang), s_ = sinf(ang);
            const float x1 = b2f(H[(size_t)t * HP + 1664 + 2 * p]), x2 = b2f(H[(size_t)t * HP + 1664 + 2 * p + 1]); const float ref = (d & 1) ? (x1 * s_ + x2 * c_) : (x1 * c_ - x2 * s_);
            worst = fmaxf(worst, fabsf(ref - b2f(KC[(size_t)t * 384 + hh * 96 + 64 + d])) / (0.05f + fabsf(ref))); }
        rec(met + 32 * l, 3, bmax(worst, sh));
    } else if (which == 4) {
        const float* wq = in[9] + (size_t)l * 192 * 384; const float* wkv = in[10] + (size_t)l * 128 * 512; const float row = (float)(s / GRIDW), col = (float)(s % GRIDW);
        for (int i = tid; i < 384; i += 256) sc[i] = 0.f; __syncthreads();
        for (int c = tid; c < 384; c += 256) { float a = 0.f; for (int k = 0; k < 192; ++k) a += b2f(CQN[(size_t)t * 256 + k]) * rbf(wq[(size_t)k * 384 + c]); sc[c] = a; }
        __syncthreads();
        for (int c = tid; c < 384; c += 256) { const int j = c % 96; float ref;
            if (j < 64) ref = sc[c]; else { const int d = j - 64, p = d >> 1; const float inv = powf(10000.f, -(float)(p & 7) / 8.f); const float ang = (p < 8 ? row : col) * inv; const float c_ = cosf(ang), s_ = sinf(ang);
                const float x1 = sc[c - d + 2 * p], x2 = sc[c - d + 2 * p + 1]; ref = (d & 1) ? (x1 * s_ + x2 * c_) : (x1 * c_ - x2 * s_); }
            ref *= QS96; worst = fmaxf(worst, fabsf(ref - b2f(QC[(size_t)t * 384 + c])) / (0.05f + fabsf(ref))); }
        for (int c = tid; c < 512; c += 256) { float a = 0.f; for (int k = 0; k < 128; ++k) a += b2f(CKVN[(size_t)t * 256 + k]) * rbf(wkv[(size_t)k * 512 + c]); const int hh = c / 128, j = c % 128;
            const float got = j < 64 ? b2f(KC[(size_t)t * 384 + hh * 96 + j]) : b2f(VC[(size_t)t * 256 + hh * 64 + (j - 64)]); worst = fmaxf(worst, fabsf(a - got) / (0.05f + fabsf(a))); }
        rec(met + 32 * l, 4, bmax(worst, sh));
    } else if (which == 5 || which == 6) {
        const bool isA = which == 5; const int DK = isA ? 64 : 96;
        for (int hh = 0; hh < 4; ++hh) {
            const bf16* q = isA ? QA + (size_t)t * 256 + hh * 64 : QC + (size_t)t * 384 + hh * 96;
            for (int k = tid; k < SEQ; k += 256) { const bf16* kp = isA ? KA + (size_t)(b0 + k) * 128 + (hh >> 1) * 64 : KC + (size_t)(b0 + k) * 384 + hh * 96; float a = 0.f; for (int d = 0; d < DK; ++d) a += b2f(q[d]) * b2f(kp[d]); sc[k] = a; }
            __syncthreads();
            float mx = -1e30f; for (int k = tid; k < SEQ; k += 256) mx = fmaxf(mx, sc[k]); mx = bmax(mx, sh);
            float sm = 0.f; for (int k = tid; k < SEQ; k += 256) { sc[k] = exp2f(sc[k] - mx); sm += sc[k]; } sm = bsum(sm, sh);
            if (tid < 64) { float o = 0.f; for (int k = 0; k < SEQ; ++k) { const float v = isA ? b2f(H[(size_t)(b0 + k) * HP + OFF_AV + (hh >> 1) * 64 + tid]) : b2f(VC[(size_t)(b0 + k) * 256 + hh * 64 + tid]); o += sc[k] * v; } o /= sm;
                const float got = b2f(YS[((size_t)(isA ? 0 : 2) * M + t) * 256 + hh * 64 + tid]); worst = fmaxf(worst, fabsf(o - got) / (0.01f + fabsf(o))); }
            __syncthreads();
        }
        rec(met + 32 * l, which, bmax(worst, sh));
    } else if (which == 7) {
        const int r = s / GRIDW, c = s % GRIDW; int rs = r - 4; rs = rs < 0 ? 0 : (rs > NROWS - 8 ? NROWS - 8 : rs); int cs = c - 8; cs = cs < 0 ? 0 : (cs > GRIDW - 16 ? GRIDW - 16 : cs);
        for (int hh = 0; hh < 4; ++hh) { const float* rpb = in[6] + ((size_t)l * 4 + hh) * 15 * 31; const bf16* q = H + (size_t)t * HP + OFF_BQ + hh * 64;
            if (tid < 128) { const int kr = rs + tid / 16, kc = cs + tid % 16; const bf16* kp = H + (size_t)(b0 + kr * GRIDW + kc) * HP + OFF_BK + hh * 64; float a = 0.f; for (int d = 0; d < 64; ++d) a += b2f(q[d]) * b2f(kp[d]);
                int dc = kc - c + 15; dc = dc < 0 ? 0 : (dc > 30 ? 30 : dc); sc[tid] = a + rpb[(kr - r + 7) * 31 + dc] * LOG2E; }
            __syncthreads();
            float mx = -1e30f; if (tid < 128) mx = sc[tid]; mx = bmax(mx, sh); float sm = 0.f; if (tid < 128) { sc[tid] = exp2f(sc[tid] - mx); sm = sc[tid]; } sm = bsum(sm, sh);
            if (tid < 64) { float o = 0.f; for (int k = 0; k < 128; ++k) { const int kr = rs + k / 16, kc = cs + k % 16; o += sc[k] * b2f(H[(size_t)(b0 + kr * GRIDW + kc) * HP + OFF_BV + hh * 64 + tid]); } o /= sm;
                const float got = b2f(YS[((size_t)1 * M + t) * 256 + hh * 64 + tid]); worst = fmaxf(worst, fabsf(o - got) / (0.05f + fabsf(o))); }
            __syncthreads(); }
        rec(met + 32 * l, 7, bmax(worst, sh));
    } else if (which == 8) {
        const float* cw = in[11] + (size_t)l * 31 * 256; float a = in[12][l * 256 + tid];
        for (int k = 0; k < 31; ++k) { const int s2 = s + k - 15; if (s2 >= 0 && s2 < SEQ) a += cw[k * 256 + tid] * b2f(H[(size_t)(b0 + s2) * HP + 1792 + tid]); }
        const float mean = bsum(a, sh) / 256.f; const float dv = a - mean; const float var = bsum(dv * dv, sh) / 256.f; const float y = dv / sqrtf(var + 1e-5f) * in[13][l * 256 + tid] + in[14][l * 256 + tid]; const float ref = y * sg(y);
        worst = fabsf(ref - b2f(YS[((size_t)3 * M + t) * 256 + tid])) / (0.05f + fabsf(ref)); rec(met + 32 * l, 8, bmax(worst, sh));
    } else if (which == 9) {
        const float* wb = in[15] + (size_t)l * 4 * 256 * 1024;
        for (int d = tid; d < 1024; d += 256) { float m = 0.f; for (int n = 0; n < 4; ++n) { float a = 0.f; for (int c = 0; c < 256; ++c) a += b2f(YS[((size_t)n * M + t) * 256 + c]) * rbf(wb[((size_t)n * 256 + c) * 1024 + d]); m += b2f(G[(size_t)t * 4096 + n * 1024 + d]) * a; }
            worst = fmaxf(worst, fabsf(m - b2f(MG[(size_t)t * DM + d])) / (0.02f + fabsf(m))); }
        rec(met + 32 * l, 9, bmax(worst, sh));
    } else if (which == 10) {
        const float* wo = in[16] + (size_t)l * 1024 * 1024;
        for (int d = tid; d < 1024; d += 256) { float a = 0.f; for (int k = 0; k < 1024; ++k) a += b2f(MG[(size_t)t * DM + k]) * rbf(wo[(size_t)k * 1024 + d]); const float ref = ALPHA * XRES[(size_t)t * DM + d] + a;
            worst = fmaxf(worst, fabsf(ref - T[(size_t)t * DM + d]) / (0.05f + fabsf(ref))); }
        rec(met + 32 * l, 10, bmax(worst, sh));
    } else if (which == 11 || which == 14) {
        const float* g = (which == 11 ? in[17] : in[26]) + l * DM; const float* bb = (which == 11 ? in[18] : in[27]) + l * DM;
        float sm = 0.f; for (int d = tid; d < 1024; d += 256) sm += T[(size_t)t * DM + d]; const float mean = bsum(sm, sh) / 1024.f; float vq = 0.f; for (int d = tid; d < 1024; d += 256) { const float dv = T[(size_t)t * DM + d] - mean; vq += dv * dv; }
        const float rstd = 1.0f / sqrtf(bsum(vq, sh) / 1024.f + 1e-5f);
        for (int d = tid; d < 1024; d += 256) { const float ref = (T[(size_t)t * DM + d] - mean) * rstd * g[d] + bb[d]; worst = fmaxf(worst, fabsf(ref - XRES[(size_t)t * DM + d]) / (0.05f + fabsf(ref))); }
        rec(met + 32 * l, which, bmax(worst, sh));
    } else if (which == 12) {
        for (int j = tid; j < D_FF; j += 256) { float a = 0.f, b = 0.f; for (int k = 0; k < 1024; ++k) { const float xv = b2f(XB[(size_t)t * DM + k]); a += xv * rbf(in[19][(size_t)k * D_FF + j]); b += xv * rbf(in[20][(size_t)k * D_FF + j]); }
            const float ref = a * sg(a) * b; worst = fmaxf(worst, fabsf(ref - b2f(HID0[(size_t)t * D_FF + j])) / (0.05f + fabsf(ref))); }
        rec(met + 32 * l, 12, bmax(worst, sh));
    } else if (which == 13) {
        for (int d = tid; d < 1024; d += 256) { float a = 0.f; for (int j = 0; j < D_FF; ++j) a += b2f(HID0[(size_t)t * D_FF + j]) * rbf(in[21][(size_t)j * 1024 + d]); const float ref = ALPHA * XRES[(size_t)t * DM + d] + a;
            worst = fmaxf(worst, fabsf(ref - T[(size_t)t * DM + d]) / (0.05f + fabsf(ref))); }
        rec(met + 32 * l, 13, bmax(worst, sh));
    } else if (which == 1) {
        const float* x = in[0] + (size_t)t * DM; float sm = 0.f; for (int d = tid; d < 1024; d += 256) sm += x[d]; const float mean = bsum(sm, sh) / 1024.f; float vq = 0.f; for (int d = tid; d < 1024; d += 256) { const float dv = x[d] - mean; vq += dv * dv; }
        const float rstd = 1.0f / sqrtf(bsum(vq, sh) / 1024.f + 1e-5f);
        for (int d = tid; d < 1024; d += 256) { const float ref = (x[d] - mean) * rstd * in[1][d] + in[2][d]; worst = fmaxf(worst, fabsf(ref - XRES[(size_t)t * DM + d]) / (0.05f + fabsf(ref))); worst = fmaxf(worst, fabsf(ref - b2f(XB[(size_t)t * DM + d])) / (0.05f + fabsf(ref))); }
        rec(met + 32 * l, 1, bmax(worst, sh));
    } else if (which >= 20) {
        const unsigned* ROUTE = (const unsigned*)(ws + WS_ROUTE); const unsigned* SLOT = (const unsigned*)(ws + WS_SLOT); const unsigned* META = (const unsigned*)(ws + WS_META);
        const int e0 = (int)ROUTE[t * 4], e1 = (int)ROUTE[t * 4 + 1]; const float w0 = __uint_as_float(ROUTE[t * 4 + 2]), w1 = __uint_as_float(ROUTE[t * 4 + 3]); const unsigned s0 = SLOT[t * 2], s1 = SLOT[t * 2 + 1];
        const bf16* XG = (const bf16*)(ws + WS_XG); const bf16* MH = (const bf16*)(ws + WS_MHID);
        if (which == 20) { __shared__ float lg[8]; for (int e = 0; e < 8; ++e) { float a = 0.f; for (int d = tid; d < 1024; d += 256) a += XRES[(size_t)t * DM + d] * in[22][(size_t)d * 8 + e]; a = bsum(a, sh); if (tid == 0) lg[e] = a; }
            __syncthreads(); if (tid == 0) { int b0_ = 0; for (int e = 1; e < 8; ++e) if (lg[e] > lg[b0_]) b0_ = e; int b1_ = -1; for (int e = 0; e < 8; ++e) if (e != b0_ && (b1_ < 0 || lg[e] > lg[b1_])) b1_ = e;
                const float m0 = expf(lg[b0_] - lg[b0_]), m1 = expf(lg[b1_] - lg[b0_]); float er = (b0_ != e0 || b1_ != e1) ? 1.0f : 0.f; er = fmaxf(er, fabsf(m0 / (m0 + m1) - w0)); er = fmaxf(er, fabsf(m1 / (m0 + m1) - w1));
                const unsigned te0 = ((const unsigned char*)(META + 16))[s0 >> 8], te1 = ((const unsigned char*)(META + 16))[s1 >> 8]; if ((int)te0 != e0 || (int)te1 != e1 || s0 >= META[0] * 256 || s1 >= META[0] * 256) er = 2.0f; worst = er; } }
        else if (which == 21) { for (int d = tid; d < 1024; d += 256) { const float ref = rbf(XRES[(size_t)t * DM + d]); worst = fmaxf(worst, fabsf(ref - b2f(XG[(size_t)s0 * DM + d]))); worst = fmaxf(worst, fabsf(ref - b2f(XG[(size_t)s1 * DM + d]))); } }
        else if (which == 22) { for (int q = 0; q < 2; ++q) { const int e = q ? e1 : e0; const unsigned sl = q ? s1 : s0; const float* w1p = in[23] + (size_t)e * 1024 * D_FFE; const float* w3p = in[24] + (size_t)e * 1024 * D_FFE;
                for (int j = tid; j < D_FFE; j += 256) { float a = 0.f, b = 0.f; for (int k = 0; k < 1024; ++k) { const float xv = b2f(XG[(size_t)sl * DM + k]); a += xv * rbf(w1p[(size_t)k * D_FFE + j]); b += xv * rbf(w3p[(size_t)k * D_FFE + j]); }
                    const float ref = a * sg(a) * b; worst = fmaxf(worst, fabsf(ref - b2f(MH[(size_t)sl * D_FFE + j])) / (0.05f + fabsf(ref))); } } }
        else if (which == 23) { for (int q = 0; q < 2; ++q) { const int e = q ? e1 : e0; const unsigned sl = q ? s1 : s0; const float* w2p = in[25] + (size_t)e * D_FFE * 1024;
                for (int d = tid; d < 1024; d += 256) { float a = 0.f; for (int j = 0; j < D_FFE; ++j) a += b2f(MH[(size_t)sl * D_FFE + j]) * rbf(w2p[(size_t)j * 1024 + d]); worst = fmaxf(worst, fabsf(a - b2f(XG[(size_t)sl * DM + d])) / (0.02f + fabsf(a))); } } }
        else if (which == 24) { for (int d = tid; d < 1024; d += 256) rowbuf[d] = ALPHA * XRES[(size_t)t * DM + d] + w0 * b2f(XG[(size_t)s0 * DM + d]) + w1 * b2f(XG[(size_t)s1 * DM + d]); __syncthreads();
            float sm = 0.f; for (int d = tid; d < 1024; d += 256) sm += rowbuf[d]; const float mean = bsum(sm, sh) / 1024.f; float vq = 0.f; for (int d = tid; d < 1024; d += 256) { const float dv = rowbuf[d] - mean; vq += dv * dv; } const float rstd = 1.0f / sqrtf(bsum(vq, sh) / 1024.f + 1e-5f);
            for (int d = tid; d < 1024; d += 256) { const float ref = (rowbuf[d] - mean) * rstd * in[26][l * DM + d] + in[27][l * DM + d]; worst = fmaxf(worst, fabsf(ref - args.out[(size_t)t * DM + d]) / (0.05f + fabsf(ref))); } }
        rec(met + 32 * l, which, bmax(worst, sh));
    }
}
#undef in
__global__ void chk_report(Args args) {
    const unsigned* met = (const unsigned*)(args.ws + WS_CTL) + 1024;
#if DBG_REPORT == 0
    int bad = -1;
    for (int k = 0; k < 64; ++k) { const float v = __uint_as_float(met[k]); if (v > DBG_TOL) { bad = k; break; } }
    if (bad >= 0) args.out[0] = 100.0f + 10.0f * (float)bad;
#elif DBG_REPORT == 1
    int mask = 0; for (int k = 0; k < 4; ++k) if (__uint_as_float(met[DBG_K0 + k]) > DBG_TOL) mask |= 1 << k;
    args.out[0] = 100.0f + 10.0f * (float)mask;
#elif DBG_REPORT == 7
    args.out[0] = 100.0f + 10.0f * (float)(met[101] >> 4);
#elif DBG_REPORT == 8
    args.out[0] = 100.0f + 10.0f * (float)(met[102] >> 5);
#elif DBG_REPORT == 9
    args.out[0] = 100.0f + 10.0f * (float)(met[102] & 31u);
#elif DBG_REPORT == 10
    args.out[0] = 100.0f + 10.0f * (float)(met[103] >> 8);
#elif DBG_REPORT == 11
    args.out[0] = 100.0f + 10.0f * (float)(met[104] > 60u ? 60u : met[104]);
#elif DBG_REPORT == 12
    { unsigned v = met[105] >> 8; args.out[0] = 100.0f + 10.0f * (float)(v > 80u ? 80u : v); }
#elif DBG_REPORT == 13
    { const unsigned key = 0xFFFFFFFFu - met[100]; args.out[0] = 100.0f + 10.0f * (float)(key & 7u); }
#elif DBG_REPORT == 3
    { const unsigned key = 0xFFFFFFFFu - met[100]; args.out[0] = 100.0f + 10.0f * (float)((key >> 13) >> 5); }
#elif DBG_REPORT == 4
    { const unsigned key = 0xFFFFFFFFu - met[100]; args.out[0] = 100.0f + 10.0f * (float)((key >> 13) & 31u); }
#elif DBG_REPORT == 5
    { const unsigned key = 0xFFFFFFFFu - met[100]; args.out[0] = 100.0f + 10.0f * (float)((key & 8191u) >> 8); }
#elif DBG_REPORT == 6
    { const unsigned key = 0xFFFFFFFFu - met[100]; args.out[0] = 100.0f + 10.0f * (float)(((key & 8191u) >> 3) & 31u); }
#else
    float v = __uint_as_float(met[DBG_K0]) * 100.0f; v = v > 9000.f ? 9000.f : v; args.out[0] = 10.0f + v;
#endif
}
#endif

extern "C" void kernel_launch(void* const* d_in, const int* in_sizes, int n_in, void* d_out, int out_size, void* d_ws, size_t ws_size, hipStream_t stream) {
    static int grid = 0;
    if (grid == 0) {
        if (n_in != 28 || in_sizes[0] != M * DM || out_size != M * DM || ws_size < WS_END) { fprintf(stderr, "kernel_launch: unexpected shapes (n_in %d, in0 %d, out %d, ws %zu, need %zu); nothing launched\n", n_in, n_in > 0 ? in_sizes[0] : -1, out_size, ws_size, (size_t)WS_END); grid = -1; return; }
        int dev = 0, cus = 0, per_cu = 0;
        if (hipGetDevice(&dev) != hipSuccess || hipDeviceGetAttribute(&cus, hipDeviceAttributeMultiprocessorCount, dev) != hipSuccess) { grid = -1; return; }
        if (hipFuncSetAttribute((const void*)fwd, hipFuncAttributeMaxDynamicSharedMemorySize, LDS_BYTES) != hipSuccess) { fprintf(stderr, "kernel_launch: hipFuncSetAttribute failed\n"); grid = -1; return; }
        if (hipOccupancyMaxActiveBlocksPerMultiprocessor(&per_cu, (const void*)fwd, NWAVES * 64, LDS_BYTES) != hipSuccess || per_cu < 1) fprintf(stderr, "kernel_launch: occupancy query reports %d\n", per_cu);
        (void)hipGetLastError();
        grid = cus;
    }
    if (grid < 0) return;
    (void)hipMemsetAsync((char*)d_ws + WS_CTL, 0, CTL_ZERO_BYTES, stream);
    Args a{};
    for (int i = 0; i < 28; ++i) a.in[i] = (const float*)d_in[i];
    a.out = (float*)d_out; a.ws = (unsigned char*)d_ws;
#if MK_ONE_LAUNCH
    a.ph_lo = 0; a.ph_hi = 1 + PH_PER_LAYER + 12;
    hipLaunchKernelGGL(fwd, dim3(grid), dim3(NWAVES * 64), LDS_BYTES, stream, a);
#else
    for (int p = 0; p < N_PHASES; ++p) {
        const int r = (p - 1) % PH_PER_LAYER, l = (p - 1) / PH_PER_LAYER;
        if (p > 0 && (r > 11 || ((l & 1) == 0 && (r == 7 || r == 9)))) continue;
        a.ph_lo = p; a.ph_hi = p + 1;
        hipLaunchKernelGGL(fwd, dim3(grid), dim3(NWAVES * 64), LDS_BYTES, stream, a);
#if DBG_CHK
        {   const bool moe_ = (l & 1) != 0;
#define CHK(w) hipLaunchKernelGGL(chk_kernel, dim3(1024), dim3(256), 0, stream, a, l, (w))
            if (p == 0) { const int l = 0; CHK(1); }
            else if (r == 0) CHK(2); else if (r == 1) CHK(3); else if (r == 2) CHK(4); else if (r == 3) { CHK(5); CHK(6); CHK(7); CHK(8); } else if (r == 4) CHK(9); else if (r == 5) CHK(10); else if (r == 6) CHK(11);
            else if (r == 7 && moe_) { CHK(20); CHK(21); } else if (r == 8) { if (moe_) CHK(22); else CHK(12); } else if (r == 10) { if (moe_) CHK(23); else CHK(13); } else if (r == 11) { if (moe_) CHK(24); else CHK(14); }
#undef CHK
        }
#endif
    }
#if DBG_CHK
    hipLaunchKernelGGL(chk_report, dim3(1), dim3(1), 0, stream, a);
#endif
#endif
}
```

```cpp
#include <hip/hip_runtime.h>
#include <cstdio>
#include <cstdint>

#define LAS __attribute__((address_space(3)))
#define GAS __attribute__((address_space(1)))
typedef unsigned short bf16;
typedef short bf16x8 __attribute__((ext_vector_type(8)));
typedef short s16x4 __attribute__((ext_vector_type(4)));
typedef float f32x2 __attribute__((ext_vector_type(2)));
typedef float f32x4 __attribute__((ext_vector_type(4)));
typedef float f32x16 __attribute__((ext_vector_type(16)));
typedef unsigned u32x2 __attribute__((ext_vector_type(2)));
typedef unsigned u32x4 __attribute__((ext_vector_type(4)));
typedef GAS unsigned gu32;

__device__ __forceinline__ int lane_id_v() { int l; asm volatile("v_mbcnt_lo_u32_b32 %0, -1, 0\n\tv_mbcnt_hi_u32_b32 %0, -1, %0" : "=v"(l)); return l; }

constexpr int BATCH = 8, SEQ = 2048, DM = 1024, M = BATCH * SEQ, DEPTH = 2;
constexpr int GRIDW = 64, NROWS = SEQ / GRIDW;
constexpr int D_IN = 6240, NW_IN = 6400;
constexpr int HP = 2048;
constexpr int D_FF = 2816, D_FFE = 3584, NEXP = 8;
constexpr int OFF_AQ = 0, OFF_AK = 256, OFF_AV = 384, OFF_BQ = 512, OFF_BK = 768, OFF_BV = 1024, OFF_CQ = 1280, OFF_CKV = 1472, OFF_KPE = 1600, OFF_GLU = 1632, OFF_GATE = 2144;
constexpr float LOG2E = 1.4426950408889634f;
constexpr float ALPHA = 1.4142135623730951f;
constexpr float LN_EPS = 1e-5f, RMS_EPS = 1e-6f;
constexpr float QS64 = 0.125f * LOG2E;
constexpr float QS96 = 0.10206207261596575f * LOG2E;
constexpr int MAXTILES = 136, MAXSLOTS = MAXTILES * 256;

namespace pg8 {
constexpr int BM = 256, BK = 64, HALF = 128, HTB = HALF * BK * 2, STAGE_BYTES = 8 * HTB, NXCD = 8, WGM = 8;
__host__ __device__ __forceinline__ int lds_byte(int r, int c) { const int st = (r >> 4) * 2 + (c >> 5), rr = r & 15, cc = c & 31, ob = rr * 64 + cc * 2; return st * 1024 + (ob ^ (((ob >> 9) & 1) << 5)); }
__host__ __device__ __forceinline__ void stage_rc(int b, int& R, int& C) { const int st = b / 1024, sb = b % 1024, swz = sb ^ (((sb >> 9) & 1) << 5); R = (st >> 1) * 16 + swz / 64; C = (st & 1) * 32 + (swz % 64) / 2; }
__host__ __device__ __forceinline__ int perm32(int rho) { const int n = rho >> 4, i = rho & 15; return 8 * (i >> 2) + 4 * n + (i & 3); }

struct Unit { int pm, pn, aux; size_t ao, bo; };
struct Gemm { const bf16* A; const bf16* Bt; int K; };

__device__ __forceinline__ bool tile_of(long L, int nM, int nN, int& pm, int& pn) {
    const int nwg = nM * nN; if (L >= nwg) return false;
    int wgid = (int)L; { const int q = nwg / NXCD, r = nwg % NXCD, xcd = wgid % NXCD, off = wgid / NXCD; wgid = (xcd < r ? xcd * (q + 1) : r * (q + 1) + (xcd - r) * q) + off; }
    const int nig = WGM * nN, gid = wgid / nig, fm = gid * WGM, gsz = (nM - fm) < WGM ? (nM - fm) : WGM;
    pm = fm + ((wgid % nig) % gsz); pn = (wgid % nig) / gsz; return true;
}
struct SchedPlain {
    int nM, nN, G, c; size_t ts;
    __device__ __forceinline__ void init(int nM_, int nN_, int K, int G_, int c_) { nM = nM_; nN = nN_; G = G_; c = c_; ts = (size_t)BM * K * 2; }
    __device__ __forceinline__ bool next(int i, Unit& u) const { if (!tile_of((long)i * G + c, nM, nN, u.pm, u.pn)) return false; u.aux = 0; u.ao = (size_t)u.pm * ts; u.bo = (size_t)u.pn * ts; return true; }
};
struct SchedGroup {
    int nM, nN, G, c; size_t ts; const LAS unsigned char* tile_e;
    __device__ __forceinline__ void init(int nM_, int nN_, int K, int G_, int c_, const LAS unsigned char* te) { nM = nM_; nN = nN_; G = G_; c = c_; ts = (size_t)BM * K * 2; tile_e = te; }
    __device__ __forceinline__ bool next(int i, Unit& u) const { if (!tile_of((long)i * G + c, nM, nN, u.pm, u.pn)) return false;
        const int e = __builtin_amdgcn_readfirstlane((int)tile_e[u.pm]); u.aux = e; u.ao = (size_t)u.pm * ts; u.bo = ((size_t)e * nN + u.pn) * ts; return true; }
};
struct SchedMerge {
    int G, c;
    __device__ __forceinline__ void init(int G_, int c_) { G = G_; c = c_; }
    __device__ __forceinline__ bool next(int i, Unit& u) const { if (!tile_of((long)(i >> 2) * G + c, M / BM, DM / BM, u.pm, u.pn)) return false;
        const int n = i & 3; u.aux = n; u.ao = ((size_t)n * M + (size_t)u.pm * BM) * 256 * 2; u.bo = ((size_t)n * DM + (size_t)u.pn * BM) * 256 * 2; return true; }
};

typedef __bf16 bf16x2_t __attribute__((ext_vector_type(2)));
__device__ __forceinline__ unsigned cvt_pk_bf16(float lo, float hi) { const f32x2 v = {lo, hi}; const bf16x2_t b = __builtin_convertvector(v, bf16x2_t); return __builtin_bit_cast(unsigned, b); }
__device__ __forceinline__ float bf_lo(unsigned w) { return __uint_as_float(w << 16); }
__device__ __forceinline__ float bf_hi(unsigned w) { return __uint_as_float(w & 0xffff0000u); }
__device__ __forceinline__ float sigmoidf_(float x) { return __builtin_amdgcn_rcpf(1.0f + __builtin_amdgcn_exp2f(-LOG2E * x)); }

typedef f32x4 Acc[2][2][4][2];

struct EpiWin {
    static constexpr bool PERM = true;
    bf16* H; bf16* Gt;
    __device__ __forceinline__ bool operator()(Acc& acc, const Unit& u, int wr, int wc, int fr, int fq) const {
        const int row0 = u.pm * BM + wr * 64 + fr, pn = u.pn, cw = wc * 32 + 8 * fq;
        if (pn < 7) {
            const float sc = (pn == 2) ? QS64 : 1.0f;
#pragma unroll
            for (int ai = 0; ai < 2; ++ai)
#pragma unroll
                for (int m = 0; m < 4; ++m) { bf16* rowp = H + (size_t)(row0 + ai * HALF + m * 16) * HP + pn * BM + cw;
#pragma unroll
                    for (int bj = 0; bj < 2; ++bj) { const f32x4 v0 = acc[ai][bj][m][0] * sc, v1 = acc[ai][bj][m][1] * sc;
                        u32x4 w; w.x = cvt_pk_bf16(v0[0], v0[1]); w.y = cvt_pk_bf16(v0[2], v0[3]); w.z = cvt_pk_bf16(v1[0], v1[1]); w.w = cvt_pk_bf16(v1[2], v1[3]);
                        *(u32x4*)(rowp + bj * HALF) = w; } }
        } else if (pn < 9) {
#pragma unroll
            for (int ai = 0; ai < 2; ++ai)
#pragma unroll
                for (int m = 0; m < 4; ++m) { bf16* rowp = H + (size_t)(row0 + ai * HALF + m * 16) * HP + 1792 + (pn - 7) * HALF + cw;
                    float o[8];
#pragma unroll
                    for (int n = 0; n < 2; ++n)
#pragma unroll
                        for (int e = 0; e < 4; ++e) o[n * 4 + e] = acc[ai][0][m][n][e] * sigmoidf_(acc[ai][1][m][n][e]);
                    u32x4 w; w.x = cvt_pk_bf16(o[0], o[1]); w.y = cvt_pk_bf16(o[2], o[3]); w.z = cvt_pk_bf16(o[4], o[5]); w.w = cvt_pk_bf16(o[6], o[7]);
                    *(u32x4*)rowp = w; }
        } else {
#pragma unroll
            for (int ai = 0; ai < 2; ++ai)
#pragma unroll
                for (int m = 0; m < 4; ++m) { bf16* rowp = Gt + (size_t)(row0 + ai * HALF + m * 16) * 4096 + (pn - 9) * BM + cw;
#pragma unroll
                    for (int bj = 0; bj < 2; ++bj) { float o[8];
#pragma unroll
                        for (int n = 0; n < 2; ++n)
#pragma unroll
                            for (int e = 0; e < 4; ++e) o[n * 4 + e] = sigmoidf_(acc[ai][bj][m][n][e]);
                        u32x4 w; w.x = cvt_pk_bf16(o[0], o[1]); w.y = cvt_pk_bf16(o[2], o[3]); w.z = cvt_pk_bf16(o[4], o[5]); w.w = cvt_pk_bf16(o[6], o[7]);
                        *(u32x4*)(rowp + bj * HALF) = w; } }
        }
        return false;
    }
};
struct EpiUq {
    static constexpr bool PERM = true;
    bf16* QC; const float* cosC; const float* sinC;
    __device__ __forceinline__ bool operator()(Acc& acc, const Unit& u, int wr, int wc, int fr, int fq) const {
        const int row0 = u.pm * BM + wr * 64 + fr;
#pragma unroll
        for (int bj = 0; bj < 2; ++bj) { const int cb = u.pn * BM + bj * HALF + wc * 32; if (cb >= 384) continue;
            const int hh = cb / 96, jb = cb - hh * 96; const bool rot = (jb == 64); const int i0 = 4 * fq, c0 = cb + 8 * fq; (void)hh;
#pragma unroll
            for (int ai = 0; ai < 2; ++ai)
#pragma unroll
                for (int m = 0; m < 4; ++m) { const int row = row0 + ai * HALF + m * 16; f32x4 v0 = acc[ai][bj][m][0], v1 = acc[ai][bj][m][1];
                    if (rot) { const int s = row & (SEQ - 1); const f32x4 cs = *(const f32x4*)(cosC + s * 16 + i0), sn = *(const f32x4*)(sinC + s * 16 + i0);
                        const f32x4 a0 = v0, a1 = v1;
                        v0[0] = a0[0] * cs[0] - a0[1] * sn[0]; v0[1] = a0[0] * sn[0] + a0[1] * cs[0]; v0[2] = a0[2] * cs[1] - a0[3] * sn[1]; v0[3] = a0[2] * sn[1] + a0[3] * cs[1];
                        v1[0] = a1[0] * cs[2] - a1[1] * sn[2]; v1[1] = a1[0] * sn[2] + a1[1] * cs[2]; v1[2] = a1[2] * cs[3] - a1[3] * sn[3]; v1[3] = a1[2] * sn[3] + a1[3] * cs[3]; }
                    v0 = v0 * QS96; v1 = v1 * QS96;
                    u32x4 w; w.x = cvt_pk_bf16(v0[0], v0[1]); w.y = cvt_pk_bf16(v0[2], v0[3]); w.z = cvt_pk_bf16(v1[0], v1[1]); w.w = cvt_pk_bf16(v1[2], v1[3]);
                    *(u32x4*)(QC + (size_t)row * 384 + c0) = w; asm volatile("" ::: "memory"); } }
        return false;
    }
};
struct EpiUkv {
    static constexpr bool PERM = true;
    bf16* KC; bf16* VC;
    __device__ __forceinline__ bool operator()(Acc& acc, const Unit& u, int wr, int wc, int fr, int fq) const {
        const int row0 = u.pm * BM + wr * 64 + fr;
#pragma unroll
        for (int bj = 0; bj < 2; ++bj) { const int c0 = u.pn * BM + bj * HALF + wc * 32 + 8 * fq; const int hh = c0 >> 7, j = c0 & 127;
#pragma unroll
            for (int ai = 0; ai < 2; ++ai)
#pragma unroll
                for (int m = 0; m < 4; ++m) { const int row = row0 + ai * HALF + m * 16; const f32x4 v0 = acc[ai][bj][m][0], v1 = acc[ai][bj][m][1];
                    u32x4 w; w.x = cvt_pk_bf16(v0[0], v0[1]); w.y = cvt_pk_bf16(v0[2], v0[3]); w.z = cvt_pk_bf16(v1[0], v1[1]); w.w = cvt_pk_bf16(v1[2], v1[3]);
                    bf16* p = (j < 64) ? (KC + (size_t)row * 384 + hh * 96 + j) : (VC + (size_t)row * 256 + hh * 64 + (j - 64));
                    *(u32x4*)p = w; asm volatile("" ::: "memory"); } }
        return false;
    }
};
struct EpiMerge {
    static constexpr bool PERM = true;
    const bf16* Gt; bf16* MG;
    __device__ __forceinline__ bool operator()(Acc& acc, const Unit& u, int wr, int wc, int fr, int fq) const {
        const int row0 = u.pm * BM + wr * 64 + fr, n = u.aux, d0 = u.pn * BM + wc * 32 + 8 * fq;
        const float GMIN = 1e-18f;
#pragma unroll
        for (int ai = 0; ai < 2; ++ai)
#pragma unroll
            for (int m = 0; m < 4; ++m) { const int row = row0 + ai * HALF + m * 16; const bf16* gp = Gt + (size_t)row * 4096 + n * DM + d0;
#pragma unroll
                for (int bj = 0; bj < 2; ++bj) { const u32x4 ga = *(const u32x4*)(gp + bj * HALF);
                    float g[8] = {bf_lo(ga.x), bf_hi(ga.x), bf_lo(ga.y), bf_hi(ga.y), bf_lo(ga.z), bf_hi(ga.z), bf_lo(ga.w), bf_hi(ga.w)};
                    if (n < 3) { const u32x4 gb = *(const u32x4*)(gp + DM + bj * HALF);
                        const float h[8] = {bf_lo(gb.x), bf_hi(gb.x), bf_lo(gb.y), bf_hi(gb.y), bf_lo(gb.z), bf_hi(gb.z), bf_lo(gb.w), bf_hi(gb.w)};
#pragma unroll
                        for (int e = 0; e < 8; ++e) g[e] = fmaxf(g[e], GMIN) * __builtin_amdgcn_rcpf(fmaxf(h[e], GMIN));
#pragma unroll
                        for (int e = 0; e < 4; ++e) { acc[ai][bj][m][0][e] *= g[e]; acc[ai][bj][m][1][e] *= g[4 + e]; }
                    } else {
                        float o[8];
#pragma unroll
                        for (int e = 0; e < 4; ++e) { o[e] = acc[ai][bj][m][0][e] * fmaxf(g[e], GMIN); o[4 + e] = acc[ai][bj][m][1][e] * fmaxf(g[4 + e], GMIN); }
                        u32x4 w; w.x = cvt_pk_bf16(o[0], o[1]); w.y = cvt_pk_bf16(o[2], o[3]); w.z = cvt_pk_bf16(o[4], o[5]); w.w = cvt_pk_bf16(o[6], o[7]);
                        *(u32x4*)(MG + (size_t)row * DM + d0 + bj * HALF) = w; } }
                asm volatile("" ::: "memory"); }
        return n < 3;
    }
};
struct EpiRes {
    static constexpr bool PERM = false;
    const float* X; float* T;
    __device__ __forceinline__ bool operator()(Acc& acc, const Unit& u, int wr, int wc, int fr, int fq) const {
        const int row0 = u.pm * BM + wr * 64 + fr, col0 = u.pn * BM + wc * 32 + 4 * fq;
#pragma unroll
        for (int ai = 0; ai < 2; ++ai)
#pragma unroll
            for (int m = 0; m < 4; ++m) { const size_t off = (size_t)(row0 + ai * HALF + m * 16) * DM + col0;
#pragma unroll
                for (int bj = 0; bj < 2; ++bj)
#pragma unroll
                    for (int n = 0; n < 2; ++n) { const f32x4 x = *(const f32x4*)(X + off + bj * HALF + n * 16); *(f32x4*)(T + off + bj * HALF + n * 16) = x * ALPHA + acc[ai][bj][m][n]; }
                asm volatile("" ::: "memory"); }
        return false;
    }
};
struct EpiSwiGLU {
    static constexpr bool PERM = true;
    bf16* HID; int ld;
    __device__ __forceinline__ bool operator()(Acc& acc, const Unit& u, int wr, int wc, int fr, int fq) const {
        const int row0 = u.pm * BM + wr * 64 + fr, c0 = u.pn * HALF + wc * 32 + 8 * fq;
#pragma unroll
        for (int ai = 0; ai < 2; ++ai)
#pragma unroll
            for (int m = 0; m < 4; ++m) { float o[8];
#pragma unroll
                for (int n = 0; n < 2; ++n)
#pragma unroll
                    for (int e = 0; e < 4; ++e) { const float a = acc[ai][0][m][n][e]; o[n * 4 + e] = a * sigmoidf_(a) * acc[ai][1][m][n][e]; }
                u32x4 w; w.x = cvt_pk_bf16(o[0], o[1]); w.y = cvt_pk_bf16(o[2], o[3]); w.z = cvt_pk_bf16(o[4], o[5]); w.w = cvt_pk_bf16(o[6], o[7]);
                *(u32x4*)(HID + (size_t)(row0 + ai * HALF + m * 16) * ld + c0) = w; }
        return false;
    }
};
struct EpiO {
    static constexpr bool PERM = true;
    bf16* O;
    __device__ __forceinline__ bool operator()(Acc& acc, const Unit& u, int wr, int wc, int fr, int fq) const {
        const int row0 = u.pm * BM + wr * 64 + fr, c0 = u.pn * BM + wc * 32 + 8 * fq;
#pragma unroll
        for (int ai = 0; ai < 2; ++ai)
#pragma unroll
            for (int m = 0; m < 4; ++m) { bf16* rowp = O + (size_t)(row0 + ai * HALF + m * 16) * DM + c0;
#pragma unroll
                for (int bj = 0; bj < 2; ++bj) { const f32x4 v0 = acc[ai][bj][m][0], v1 = acc[ai][bj][m][1];
                    u32x4 w; w.x = cvt_pk_bf16(v0[0], v0[1]); w.y = cvt_pk_bf16(v0[2], v0[3]); w.z = cvt_pk_bf16(v1[0], v1[1]); w.w = cvt_pk_bf16(v1[2], v1[3]);
                    *(u32x4*)(rowp + bj * HALF) = w; } }
        return false;
    }
};
template <class Epi, class Sched, bool ALIGN_EPI = false, bool SP2 = false>
__device__ __forceinline__ void gemm_phase(LAS unsigned char* lds, const Gemm g, const Sched& S, const Epi& E, int wid_) {
    int wid = wid_; asm volatile("" : "+s"(wid));
    const int lane = lane_id_v(), tid = wid * 64 + lane, wr = wid >> 2, wc = wid & 3, fr = lane & 15, fq = lane >> 4;
    const int K = g.K, nt = K / BK;
    unsigned voffA[2], voffB[2];
#pragma unroll
    for (int i = 0; i < 2; ++i) { int R, C; stage_rc(tid * 16 + i * 8192, R, C); const int Rb = Epi::PERM ? ((R & ~31) + perm32(R & 31)) : R;
        voffA[i] = (unsigned)(R * K + C) * 2u; voffB[i] = (unsigned)(Rb * K + C) * 2u; }
    const size_t kstep = (size_t)(BK * 2);
    const size_t hstep = (size_t)HALF * K * 2;
    const unsigned ldsw = (unsigned)wid * 1024u;
    const int aoff = lds_byte(wr * 64 + fr, fq * 8), boff = lds_byte(wc * 32 + fr, fq * 8);
#define PG8_SA(b, h) (((b) * 2 + (h)) * HTB)
#define PG8_SB(b, h) ((4 + (b) * 2 + (h)) * HTB)
#define PG8_STAGE(bufoff, gbase, voff) do { _Pragma("unroll") for (int _i = 0; _i < 2; ++_i) \
        __builtin_amdgcn_global_load_lds((const unsigned*)((const char*)(gbase) + (voff)[_i]), (LAS unsigned*)(lds + (bufoff) + ldsw + _i * 8192), 16, 0, 0); } while (0)
#define PG8_LDA(dst, b, h) do { _Pragma("unroll") for (int m = 0; m < 4; ++m) _Pragma("unroll") for (int k = 0; k < 2; ++k) dst[m][k] = *(const LAS bf16x8*)(lds + PG8_SA(b, h) + aoff + m * 2048 + k * 1024); } while (0)
#define PG8_LDB(dst, b, h) do { _Pragma("unroll") for (int n = 0; n < 2; ++n) _Pragma("unroll") for (int k = 0; k < 2; ++k) dst[n][k] = *(const LAS bf16x8*)(lds + PG8_SB(b, h) + boff + n * 2048 + k * 1024); } while (0)
#define PG8_MMA(ai, bj, At, Bt) do { __builtin_amdgcn_s_setprio(1); _Pragma("unroll") for (int m = 0; m < 4; ++m) _Pragma("unroll") for (int n = 0; n < 2; ++n) _Pragma("unroll") for (int k = 0; k < 2; ++k) \
        acc[ai][bj][m][n] = __builtin_amdgcn_mfma_f32_16x16x32_bf16(Bt[n][k], At[m][k], acc[ai][bj][m][n], 0, 0, 0); __builtin_amdgcn_s_setprio(0); } while (0)
#define PG8_WAIT_V(n) asm volatile("s_waitcnt vmcnt(" #n ")" ::: "memory")
#define PG8_WAIT_L(n) asm volatile("s_waitcnt lgkmcnt(" #n ")" ::: "memory")
#define PG8_BAR __builtin_amdgcn_s_barrier()
#define PG8_SCHED __builtin_amdgcn_sched_barrier(0)
    Unit cur, nxt; int ui = 0;
    if (!S.next(0, cur)) return;
    Acc acc;
#pragma unroll
    for (int a = 0; a < 2; ++a)
#pragma unroll
        for (int b = 0; b < 2; ++b)
#pragma unroll
            for (int m = 0; m < 4; ++m)
#pragma unroll
                for (int n = 0; n < 2; ++n) acc[a][b][m][n] = (f32x4){0.f, 0.f, 0.f, 0.f};
    bf16x8 At[4][2], B0[2][2], B1[2][2];
    const char* cA = (const char*)g.A + cur.ao; const char* cB = (const char*)g.Bt + cur.bo;
    if constexpr (SP2) {
        PG8_STAGE(PG8_SB(0, 0), cB, voffB); PG8_STAGE(PG8_SB(0, 1), cB + hstep, voffB); PG8_STAGE(PG8_SA(0, 0), cA, voffA); PG8_STAGE(PG8_SA(0, 1), cA + hstep, voffA);
        if (wr == 1) PG8_BAR;
        PG8_WAIT_V(2); PG8_BAR;
        PG8_STAGE(PG8_SB(1, 0), cB + kstep, voffB); PG8_STAGE(PG8_SA(1, 0), cA + kstep, voffA); PG8_STAGE(PG8_SB(1, 1), cB + hstep + kstep, voffB);
        PG8_WAIT_V(6); PG8_BAR;
    } else {
        PG8_STAGE(PG8_SB(0, 0), cB, voffB); PG8_STAGE(PG8_SA(0, 0), cA, voffA); PG8_STAGE(PG8_SB(0, 1), cB + hstep, voffB); PG8_STAGE(PG8_SA(0, 1), cA + hstep, voffA);
        if (wr == 1) PG8_BAR;
        PG8_WAIT_V(4); PG8_BAR;
        PG8_STAGE(PG8_SB(1, 0), cB + kstep, voffB); PG8_STAGE(PG8_SA(1, 0), cA + kstep, voffA); PG8_STAGE(PG8_SB(1, 1), cB + hstep + kstep, voffB);
        PG8_WAIT_V(6); PG8_BAR;
    }
    for (;;) {
        const bool has_next = S.next(ui + 1, nxt);
        const char* nA = has_next ? (const char*)g.A + nxt.ao : cA; const char* nB = has_next ? (const char*)g.Bt + nxt.bo : cB;
        for (int t = 0; t < nt; t += 2) {
            const bool last = (t == nt - 2);
            const char* a1 = cA + (size_t)(t + 1) * kstep;
            const char* a2 = last ? nA : cA + (size_t)(t + 2) * kstep; const char* b2 = last ? nB : cB + (size_t)(t + 2) * kstep;
            const char* a3 = a2 + kstep; const char* b3 = b2 + kstep;
            if constexpr (SP2) {
            PG8_LDB(B0, 0, 0); PG8_LDB(B1, 0, 1); PG8_SCHED; PG8_LDA(At, 0, 0); PG8_STAGE(PG8_SA(1, 1), a1 + hstep, voffA);
            PG8_WAIT_V(8); PG8_WAIT_L(0); PG8_BAR; PG8_MMA(0, 0, At, B0); PG8_MMA(0, 1, At, B1); PG8_BAR; PG8_SCHED;
            PG8_LDA(At, 0, 1); PG8_STAGE(PG8_SB(0, 0), b2, voffB); PG8_STAGE(PG8_SB(0, 1), b2 + hstep, voffB); PG8_STAGE(PG8_SA(0, 0), a2, voffA);
            PG8_WAIT_V(8); PG8_WAIT_L(0); PG8_BAR; PG8_MMA(1, 0, At, B0); PG8_MMA(1, 1, At, B1); PG8_BAR; PG8_SCHED;
            PG8_LDB(B0, 1, 0); PG8_LDB(B1, 1, 1); PG8_SCHED; PG8_LDA(At, 1, 0); PG8_STAGE(PG8_SA(0, 1), a2 + hstep, voffA);
            PG8_WAIT_V(8); PG8_WAIT_L(0); PG8_BAR; PG8_MMA(0, 0, At, B0); PG8_MMA(0, 1, At, B1); PG8_BAR; PG8_SCHED;
            PG8_LDA(At, 1, 1); PG8_STAGE(PG8_SB(1, 0), b3, voffB); PG8_STAGE(PG8_SB(1, 1), b3 + hstep, voffB); PG8_STAGE(PG8_SA(1, 0), a3, voffA);
            PG8_WAIT_V(8); PG8_WAIT_L(0); PG8_BAR; PG8_MMA(1, 0, At, B0); PG8_MMA(1, 1, At, B1); PG8_BAR; PG8_SCHED;
            } else {
            PG8_LDB(B0, 0, 0); PG8_SCHED; PG8_LDA(At, 0, 0); PG8_STAGE(PG8_SA(1, 1), a1 + hstep, voffA);
            PG8_WAIT_L(8); PG8_BAR; PG8_WAIT_L(0); PG8_MMA(0, 0, At, B0); PG8_BAR; PG8_SCHED;
            PG8_LDB(B1, 0, 1); PG8_STAGE(PG8_SB(0, 0), b2, voffB);
            PG8_BAR; PG8_WAIT_L(0); PG8_MMA(0, 1, At, B1); PG8_BAR;
            PG8_LDA(At, 0, 1); PG8_STAGE(PG8_SA(0, 0), a2, voffA);
            PG8_BAR; PG8_WAIT_L(0); PG8_MMA(1, 0, At, B0); PG8_BAR; PG8_SCHED;
            PG8_STAGE(PG8_SB(0, 1), b2 + hstep, voffB);
            PG8_WAIT_V(6); PG8_BAR; PG8_MMA(1, 1, At, B1); PG8_BAR;
            PG8_LDB(B0, 1, 0); PG8_SCHED; PG8_LDA(At, 1, 0); PG8_STAGE(PG8_SA(0, 1), a2 + hstep, voffA);
            PG8_WAIT_L(8); PG8_BAR; PG8_WAIT_L(0); PG8_MMA(0, 0, At, B0); PG8_BAR; PG8_SCHED;
            PG8_LDB(B1, 1, 1); PG8_STAGE(PG8_SB(1, 0), b3, voffB);
            PG8_BAR; PG8_WAIT_L(0); PG8_MMA(0, 1, At, B1); PG8_BAR;
            PG8_LDA(At, 1, 1); PG8_STAGE(PG8_SA(1, 0), a3, voffA);
            PG8_BAR; PG8_WAIT_L(0); PG8_MMA(1, 0, At, B0); PG8_BAR; PG8_SCHED;
            PG8_STAGE(PG8_SB(1, 1), b3 + hstep, voffB);
            PG8_WAIT_V(6); PG8_BAR; PG8_MMA(1, 1, At, B1); PG8_BAR;
            }
        }
        if constexpr (ALIGN_EPI) { if (wr == 0) PG8_BAR; }
        bool keep; { const int le = lane_id_v(); keep = E(acc, cur, wr, wc, le & 15, le >> 4); }
        if (!has_next) break;
        if (!keep) {
#pragma unroll
        for (int a = 0; a < 2; ++a)
#pragma unroll
            for (int b = 0; b < 2; ++b)
#pragma unroll
                for (int m = 0; m < 4; ++m)
#pragma unroll
                    for (int n = 0; n < 2; ++n) acc[a][b][m][n] = (f32x4){0.f, 0.f, 0.f, 0.f};
        }
        cur = nxt; cA = nA; cB = nB; ++ui;
        if constexpr (ALIGN_EPI) { if (wr == 1) PG8_BAR; }
    }
    PG8_WAIT_V(0);
    if constexpr (!ALIGN_EPI) { if (wr == 0) PG8_BAR; }
    PG8_BAR;
#undef PG8_SA
#undef PG8_SB
#undef PG8_STAGE
#undef PG8_LDA
#undef PG8_LDB
#undef PG8_MMA
#undef PG8_WAIT_V
#undef PG8_WAIT_L
#undef PG8_BAR
#undef PG8_SCHED
}
}

#define RLX_AGENT __ATOMIC_RELAXED, __HIP_MEMORY_SCOPE_AGENT
#define LDS_WAIT() asm volatile("s_waitcnt lgkmcnt(0)" ::: "memory")
#define VM_WAIT() asm volatile("s_waitcnt vmcnt(0)" ::: "memory")
__device__ __forceinline__ unsigned pk2(float lo, float hi) { return pg8::cvt_pk_bf16(lo, hi); }
template <int X> __device__ __forceinline__ float swz_xor(float v) { return __int_as_float(__builtin_amdgcn_ds_swizzle(__float_as_int(v), (X << 10) | 0x1f)); }
__device__ __forceinline__ float half_sum(float v) { auto r = __builtin_amdgcn_permlane32_swap(__float_as_uint(v), __float_as_uint(v), false, false); return __uint_as_float(r[0]) + __uint_as_float(r[1]); }
__device__ __forceinline__ float half_max(float v) { auto r = __builtin_amdgcn_permlane32_swap(__float_as_uint(v), __float_as_uint(v), false, false); return fmaxf(__uint_as_float(r[0]), __uint_as_float(r[1])); }
__device__ __forceinline__ float sum16(float v) { v += swz_xor<1>(v); v += swz_xor<2>(v); v += swz_xor<4>(v); v += swz_xor<8>(v); return v; }
__device__ __forceinline__ float wave_sum(float v) { v = sum16(v); v += swz_xor<16>(v); return half_sum(v); }

#define XB_TMO      128
#define XB_XCNT(j)  (256  + 64 * (j))
#define XB_XSUB(j)  (1280 + 64 * (j))
#define XB_XGEN(j)  (2304 + 64 * (j))
#define XB_TOP      3328
#define XB_TOPGEN   3392
#define XCD_BAR_WORDS 3456
#define XB_SPIN_CAP (1u << 18)
__device__ __forceinline__ unsigned xb_ld(unsigned* p)              { return __hip_atomic_load(p, __ATOMIC_RELAXED, __HIP_MEMORY_SCOPE_AGENT); }
__device__ __forceinline__ unsigned xb_add(unsigned* p, unsigned v) { return __hip_atomic_fetch_add(p, v, __ATOMIC_RELAXED, __HIP_MEMORY_SCOPE_AGENT); }
__device__ __forceinline__ unsigned xb_xcc_id() { return (unsigned)__builtin_amdgcn_s_getreg((3 << 11) | 20) & 0xFu; }
#define XB_SPIN(cond, bar) do { unsigned _sp = 0; while (cond) { __builtin_amdgcn_s_sleep(1); \
    if ((++_sp & 255u) == 0u) { if (xb_ld(&(bar)[XB_TMO])) break; if (_sp > XB_SPIN_CAP) { atomicAdd(&(bar)[XB_TMO], 1u); break; } } } } while (0)
struct XcdBarrier { unsigned* bar; unsigned x; volatile LAS unsigned* st; };
__device__ __forceinline__ XcdBarrier xcd_barrier_post(unsigned* bar, volatile LAS unsigned* st) {
    XcdBarrier b; b.bar = bar; b.x = xb_xcc_id(); b.st = st;
    if (threadIdx.x == 0) (void)xb_add(&bar[XB_XCNT(b.x)], 1u);
    return b;
}
__device__ __forceinline__ void xcd_barrier_complete(unsigned* bar, unsigned x, unsigned& nloc, unsigned& nx) {
    const unsigned G = gridDim.x * gridDim.y * gridDim.z;
    unsigned sum, cnt, mine, sp = 0u;
    for (;;) {
        sum = 0u; cnt = 0u; mine = 0u;
#pragma unroll
        for (unsigned j = 0; j < 16; ++j) { const unsigned c = xb_ld(&bar[XB_XCNT(j)]); sum += c; cnt += (c > 0u) ? 1u : 0u; mine = (j == x) ? c : mine; }
        if (sum == G) break;
        __builtin_amdgcn_s_sleep(1);
        if ((++sp & 255u) == 0u) { if (xb_ld(&bar[XB_TMO])) break; if (sp > XB_SPIN_CAP) { atomicAdd(&bar[XB_TMO], 1u); break; } }
    }
    nloc = mine > 0u ? mine : 1u; nx = cnt > 0u ? cnt : 1u;
}
__device__ __forceinline__ void xcd_barrier(const XcdBarrier& b, const bool lead  ) {
    asm volatile("s_waitcnt vmcnt(0)" ::: "memory");
    __syncthreads();
    if (lead) {
        unsigned* bar = b.bar;
        __builtin_amdgcn_s_waitcnt(0);
        unsigned nloc = b.st[0], nx = b.st[1];
        if (nloc == 0u) { xcd_barrier_complete(bar, b.x, nloc, nx); b.st[0] = nloc; b.st[1] = nx; }
        const unsigned old = xb_add(&bar[XB_XSUB(b.x)], 1u);
        const unsigned gen = old / nloc;
        if (old + 1u == (gen + 1u) * nloc) {
            __builtin_amdgcn_fence(__ATOMIC_RELEASE, "agent");
            asm volatile("s_waitcnt vmcnt(0)" ::: "memory");
            const unsigned og = xb_add(&bar[XB_TOP], 1u);
            const unsigned tg = og / nx;
            if (og + 1u == (tg + 1u) * nx) xb_add(&bar[XB_TOPGEN], 1u);
            else XB_SPIN(xb_ld(&bar[XB_TOPGEN]) == tg, bar);
            __builtin_amdgcn_fence(__ATOMIC_ACQUIRE, "agent");
            xb_add(&bar[XB_XGEN(b.x)], 1u);
            asm volatile("s_waitcnt vmcnt(0)" ::: "memory");
        } else {
            XB_SPIN(xb_ld(&bar[XB_XGEN(b.x)]) == gen, bar);
            __builtin_amdgcn_fence(__ATOMIC_ACQUIRE, "agent");
            asm volatile("s_waitcnt vmcnt(0)" ::: "memory");
        }
    }
    __syncthreads();
}

namespace att {
typedef short v4i16_t __attribute__((ext_vector_type(4)));
__device__ __forceinline__ int crow(int r, int hi) { return (r & 3) + 8 * (r >> 2) + 4 * hi; }
__device__ __forceinline__ s16x4 vtr(const LAS unsigned char* p) { return __builtin_bit_cast(s16x4, __builtin_amdgcn_ds_read_tr16_b64_v4i16((LAS v4i16_t*)p)); }
constexpr int VBYTES = 8192;
template <int DK> struct Cfg { static constexpr int KSTR = DK * 2 + 16, KB = 64 * KSTR, BUF = KB + VBYTES; };
constexpr int RPB_OFF = 2 * (64 * 208 + VBYTES);
constexpr int LDS_NEED = RPB_OFF + 15 * 32 * 4;

template <int DK, int MODE>
__device__ __forceinline__ void attn_unit(LAS unsigned char* lds, const bf16* __restrict__ Q, int qp, const bf16* __restrict__ Kg, int kp, const bf16* __restrict__ Vg, int vp,
                                          bf16* __restrict__ O, int op, int ntile, int rg  , int wid_) {
    typedef Cfg<DK> C;
    constexpr int ND = DK / 16, CPR = DK / 8;
    int wid = wid_; asm volatile("" : "+s"(wid));
    const int lane = lane_id_v(), tid = wid * 64 + lane, r32 = lane & 31, hi = lane >> 5;
    const int kr0 = tid / CPR, kc0 = tid % CPR;
    const int kr1 = (tid + 512) / CPR, kc1 = (tid + 512) % CPR;
    const bool k2 = (DK == 96) && (tid < 256);
    const int vr = tid >> 3, vc = tid & 7;
    const int vlds = (vc >> 2) * 4096 + (vr >> 4) * 1024 + (vr & 15) * 64 + (vc & 3) * 16;
    const int kfo = r32 * C::KSTR + hi * 16;
    const int vfo = ((lane >> 4) & 1) * 32 + (lane & 3) * 8 + (4 * hi + ((lane & 15) >> 2)) * 64;
    bf16x8 qr[ND];
    { const bf16* qrow = Q + (size_t)(wid * 32 + r32) * qp + hi * 8;
#pragma unroll
      for (int d0 = 0; d0 < ND; ++d0) qr[d0] = *(const bf16x8*)(qrow + d0 * 16); }
    int t_lo = 0, t_hi = ntile, myrow = 0, qc = 0, cs = 0;
    if (MODE == 1) { myrow = rg + (wid >> 1); int rs = myrow - 4; rs = rs < 0 ? 0 : (rs > NROWS - 8 ? NROWS - 8 : rs); t_lo = rs; t_hi = rs + 8;
        qc = (wid & 1) * 32 + r32; cs = qc - 8; cs = cs < 0 ? 0 : (cs > GRIDW - 16 ? GRIDW - 16 : cs); }
    float mrun = -1e30f, lrun = 0.f; f32x16 o0 = {}, o1 = {};
    int T0 = 0, T1 = ntile;
    if (MODE == 1) { int a = rg - 4; a = a < 0 ? 0 : (a > NROWS - 8 ? NROWS - 8 : a); int b = rg + 3 - 4; b = b < 0 ? 0 : (b > NROWS - 8 ? NROWS - 8 : b); T0 = a; T1 = b + 8; }
    u32x4 kreg0, kreg1, vreg;
#define ATT_LOAD(t) do { const size_t rb = (size_t)(t) * 64; kreg0 = *(const u32x4*)(Kg + (rb + kr0) * kp + kc0 * 8); if (k2) kreg1 = *(const u32x4*)(Kg + (rb + kr1) * kp + kc1 * 8); \
        vreg = *(const u32x4*)(Vg + (rb + vr) * vp + vc * 8); } while (0)
#define ATT_STORE(buf) do { LAS unsigned char* bb = lds + (buf) * C::BUF; *(LAS u32x4*)(bb + kr0 * C::KSTR + kc0 * 16) = kreg0; if (k2) *(LAS u32x4*)(bb + kr1 * C::KSTR + kc1 * 16) = kreg1; \
        *(LAS u32x4*)(bb + C::KB + vlds) = vreg; } while (0)
    ATT_LOAD(T0); ATT_STORE(0);
    __syncthreads();
    for (int t = T0; t < T1; ++t) {
        const int buf = (t - T0) & 1;
        if (t + 1 < T1) ATT_LOAD(t + 1);
        if (MODE == 0 || (t >= t_lo && t < t_hi)) {
            const LAS unsigned char* kb_ = lds + buf * C::BUF; const LAS unsigned char* vb_ = kb_ + C::KB;
            f32x16 s0, s1;
            if (MODE == 1) {
                const LAS float* tab = (const LAS float*)(lds + RPB_OFF) + (t - myrow + 7) * 32;
#pragma unroll
                for (int r = 0; r < 16; ++r) { const int kc = crow(r, hi);
                    { int dc = kc - qc + 15; const bool ok = (kc >= cs) && (kc < cs + 16); dc = dc < 0 ? 0 : (dc > 30 ? 30 : dc); const float bv = tab[dc]; s0[r] = ok ? bv : -1e30f; }
                    { const int k2_ = kc + 32; int dc = k2_ - qc + 15; const bool ok = (k2_ >= cs) && (k2_ < cs + 16); dc = dc < 0 ? 0 : (dc > 30 ? 30 : dc); const float bv = tab[dc]; s1[r] = ok ? bv : -1e30f; } }
            } else { s0 = f32x16{}; s1 = f32x16{}; }
#pragma unroll
            for (int d0 = 0; d0 < ND; ++d0) {
                const bf16x8 k0 = *(const LAS bf16x8*)(kb_ + kfo + d0 * 32);
                const bf16x8 k1 = *(const LAS bf16x8*)(kb_ + kfo + 32 * C::KSTR + d0 * 32);
                s0 = __builtin_amdgcn_mfma_f32_32x32x16_bf16(k0, qr[d0], s0, 0, 0, 0);
                s1 = __builtin_amdgcn_mfma_f32_32x32x16_bf16(k1, qr[d0], s1, 0, 0, 0);
            }
            float mx = fmaxf(s0[0], s1[0]);
#pragma unroll
            for (int r = 1; r < 16; ++r) mx = fmaxf(mx, fmaxf(s0[r], s1[r]));
            mx = half_max(mx);
            const float mn = fmaxf(mrun, mx); const float al = __builtin_amdgcn_exp2f(mrun - mn); mrun = mn;
            float ls = 0.f;
#pragma unroll
            for (int r = 0; r < 16; ++r) { s0[r] = __builtin_amdgcn_exp2f(s0[r] - mn); s1[r] = __builtin_amdgcn_exp2f(s1[r] - mn); ls += s0[r] + s1[r]; }
            lrun = lrun * al + ls;
#pragma unroll
            for (int r = 0; r < 16; ++r) { o0[r] *= al; o1[r] *= al; }
            u32x4 pw[4];
#pragma unroll
            for (int j = 0; j < 4; ++j) { pw[0][j] = pk2(s0[2 * j], s0[2 * j + 1]); pw[1][j] = pk2(s0[8 + 2 * j], s0[9 + 2 * j]); pw[2][j] = pk2(s1[2 * j], s1[2 * j + 1]); pw[3][j] = pk2(s1[8 + 2 * j], s1[9 + 2 * j]); }
#pragma unroll
            for (int ks = 0; ks < 4; ++ks) {
                const s16x4 a0 = vtr(vb_ + vfo + ks * 1024), a1 = vtr(vb_ + vfo + ks * 1024 + 512);
                const s16x4 b0 = vtr(vb_ + vfo + 4096 + ks * 1024), b1 = vtr(vb_ + vfo + 4096 + ks * 1024 + 512);
                const bf16x8 va = (bf16x8){a0[0], a0[1], a0[2], a0[3], a1[0], a1[1], a1[2], a1[3]};
                const bf16x8 vb = (bf16x8){b0[0], b0[1], b0[2], b0[3], b1[0], b1[1], b1[2], b1[3]};
                const bf16x8 pf = __builtin_bit_cast(bf16x8, pw[ks]);
                o0 = __builtin_amdgcn_mfma_f32_32x32x16_bf16(va, pf, o0, 0, 0, 0);
                o1 = __builtin_amdgcn_mfma_f32_32x32x16_bf16(vb, pf, o1, 0, 0, 0);
            }
        }
        if (t + 1 < T1) ATT_STORE(buf ^ 1);
        __syncthreads();
    }
#undef ATT_LOAD
#undef ATT_STORE
    const float lt = half_sum(lrun); const float inv = 1.0f / lt;
    bf16* orow = O + (size_t)(wid * 32 + r32) * op + 4 * hi;
#pragma unroll
    for (int g = 0; g < 4; ++g) {
        u32x2 w0, w1;
        w0.x = pk2(o0[4 * g] * inv, o0[4 * g + 1] * inv); w0.y = pk2(o0[4 * g + 2] * inv, o0[4 * g + 3] * inv);
        w1.x = pk2(o1[4 * g] * inv, o1[4 * g + 1] * inv); w1.y = pk2(o1[4 * g + 2] * inv, o1[4 * g + 3] * inv);
        *(u32x2*)(orow + 8 * g) = w0; *(u32x2*)(orow + 32 + 8 * g) = w1;
    }
}
}

constexpr size_t MiB = 1u << 20;
constexpr size_t WS_CTL = 0, CTL_ZERO_BYTES = 256 * 1024;
constexpr size_t WS_ROPEA_C = 1 * MiB, WS_ROPEA_S = WS_ROPEA_C + 256 * 1024, WS_ROPEC_C = WS_ROPEA_S + 256 * 1024, WS_ROPEC_S = WS_ROPEC_C + 128 * 1024;
constexpr size_t WS_ROUTE = 2 * MiB;
constexpr size_t WS_SLOT = WS_ROUTE + 256 * 1024;
constexpr size_t WS_CNT = WS_SLOT + 128 * 1024;
constexpr size_t WS_META = WS_CNT + 8 * 1024;
constexpr size_t WS_XRES = 4 * MiB;
constexpr size_t WS_R = 68 * MiB;
constexpr size_t WS_WIN = WS_R;
constexpr size_t WS_WBR = WS_WIN + 25 * MiB;
constexpr size_t WS_WOUT = WS_WBR + 4 * MiB;
constexpr size_t WS_W13 = WS_WOUT + 4 * MiB;
constexpr size_t WS_W2 = WS_W13 + 11 * MiB;
constexpr size_t WS_WUQ = WS_W2 + 6 * MiB;
constexpr size_t WS_WUKV = WS_WUQ + MiB / 2;
constexpr size_t WS_XB = WS_R + 52 * MiB;
constexpr size_t WS_H = WS_XB + 32 * MiB;
constexpr size_t WS_T = WS_H;
constexpr size_t WS_G = WS_H + 64 * MiB;
constexpr size_t WS_HID0 = WS_G;
constexpr size_t WS_QA = WS_G + 128 * MiB;
constexpr size_t WS_KA = WS_QA + 8 * MiB;
constexpr size_t WS_CQN = WS_KA + 4 * MiB;
constexpr size_t WS_CKVN = WS_CQN + 8 * MiB;
constexpr size_t WS_QC = WS_CKVN + 8 * MiB;
constexpr size_t WS_KC = WS_QC + 12 * MiB;
constexpr size_t WS_VC = WS_KC + 12 * MiB;
constexpr size_t WS_MG = WS_QA;
constexpr size_t WS_YS = WS_VC + 8 * MiB;
constexpr size_t WS_DENSE_END = WS_YS + 32 * MiB;
constexpr size_t WS_MW13 = WS_R;
constexpr size_t WS_MW2 = WS_R;
constexpr size_t WS_MHID = WS_R + 112 * MiB;
constexpr size_t WS_XG = WS_MHID + 238 * MiB;
constexpr size_t WS_END = WS_XG + 68 * MiB;
static_assert(WS_DENSE_END <= WS_END && WS_WUKV + MiB / 2 <= WS_XB, "ws map");
static_assert((size_t)MAXSLOTS * D_FFE * 2 <= 238 * MiB && (size_t)MAXSLOTS * DM * 2 <= 68 * MiB, "ws map moe");
constexpr int CW_TMO = 0, CW_BAR = 4096;

constexpr int RING_BYTES = 131072;
constexpr int LDSCTL_OFF = RING_BYTES;
constexpr int LDS_BYTES = 147456;
constexpr int NWAVES = 8;

struct Frame { LAS unsigned char* lds; int tid, lane, wave, vcu, G; };

__device__ __forceinline__ void cvt_item(const float* W, int ldn, int n0, int k0, bool zero, bf16* WT, int ldk, int r0, LAS float* scr, int lane) {
    if (!zero) {
#pragma unroll 8
        for (int i = 0; i < 32; ++i) { const int kk = 2 * i + (lane >> 5); scr[kk * 33 + (lane & 31)] = W[(size_t)(k0 + kk) * ldn + n0 + (lane & 31)]; }
    }
    LDS_WAIT(); asm volatile("" ::: "memory");
    const int c = lane & 7;
#pragma unroll
    for (int j = 0; j < 4; ++j) { const int n = (lane >> 3) + 8 * j; const LAS float* s = scr + (8 * c) * 33 + n;
        u32x4 o;
        if (zero) { o = (u32x4){0u, 0u, 0u, 0u}; } else { o.x = pk2(s[0 * 33], s[1 * 33]); o.y = pk2(s[2 * 33], s[3 * 33]); o.z = pk2(s[4 * 33], s[5 * 33]); o.w = pk2(s[6 * 33], s[7 * 33]); }
        *(GAS u32x4*)(WT + (size_t)(r0 + n) * ldk + k0 + 8 * c) = o; }
    LDS_WAIT(); asm volatile("" ::: "memory");
}
__device__ __forceinline__ int win_src_col(int rb) {
    const int tile = rb >> 3, w = rb & 7;
    if (tile < 5) return rb * 32;
    if (tile == 5) return w < 6 ? OFF_CQ + 32 * w : -1;
    if (tile == 6) return w < 4 ? OFF_CKV + 32 * w : (w == 4 ? OFF_KPE : -1);
    if (tile < 9) return OFF_GLU + (w >> 2) * 256 + (tile - 7) * 128 + 32 * (w & 3);
    return OFF_GATE + (rb - 72) * 32;
}

__device__ __forceinline__ void ln_row(f32x4 (&v)[4], const float* g, const float* b, int lane) {
    float s = 0.f;
#pragma unroll
    for (int j = 0; j < 4; ++j) s += (v[j][0] + v[j][1]) + (v[j][2] + v[j][3]);
    const float mean = wave_sum(s) * (1.f / DM); float s2 = 0.f;
#pragma unroll
    for (int j = 0; j < 4; ++j) { v[j] = v[j] - mean; s2 += (v[j][0] * v[j][0] + v[j][1] * v[j][1]) + (v[j][2] * v[j][2] + v[j][3] * v[j][3]); }
    const float rstd = 1.0f / sqrtf(wave_sum(s2) * (1.f / DM) + LN_EPS);
#pragma unroll
    for (int j = 0; j < 4; ++j) { const f32x4 gg = *(const f32x4*)(g + 4 * lane + 256 * j), bb = *(const f32x4*)(b + 4 * lane + 256 * j); v[j] = v[j] * rstd * gg + bb; }
}
__device__ __forceinline__ void store_row_f32(float* p, const f32x4 (&v)[4], int lane) {
#pragma unroll
    for (int j = 0; j < 4; ++j) *(f32x4*)(p + 4 * lane + 256 * j) = v[j];
}
__device__ __forceinline__ void store_row_bf16(bf16* p, const f32x4 (&v)[4], int lane) {
#pragma unroll
    for (int j = 0; j < 4; ++j) { u32x2 w; w.x = pk2(v[j][0], v[j][1]); w.y = pk2(v[j][2], v[j][3]); *(u32x2*)(p + 4 * lane + 256 * j) = w; }
}
#ifndef DBG_REPORT
#define DBG_REPORT 0
#endif
#ifndef DBG_K0
#define DBG_K0 5
#endif
#ifndef DBG_CHK
#define DBG_CHK 0
#endif
#ifndef DBG_TOL
#define DBG_TOL 0.05f
#endif
#ifndef DBG_LDSFILL
#define DBG_LDSFILL 0
#endif
#ifndef DBG_LDSFILL_VAL
#define DBG_LDSFILL_VAL 0u
#endif
#ifndef DBG_ZERO_AC
#define DBG_ZERO_AC 0
#endif
#ifndef DBG_ZROWS
#define DBG_ZROWS 0
#endif
#ifndef DBG_ZCOND
#define DBG_ZCOND false
#endif
#ifndef DBG_ZERO_B
#define DBG_ZERO_B 0
#endif
#ifndef MK_ONE_LAUNCH
#define MK_ONE_LAUNCH 1
#endif
#ifndef PH_MASK
#define PH_MASK 0xFFFFFFFFu
#endif
__host__ __device__ constexpr bool EN(int k) { return ((PH_MASK) >> k) & 1u; }

#define WSP GAS unsigned char* wsp = (GAS unsigned char*)ws; int wave = F.wave, G_ = F.G, vcu = F.vcu, bid = blockIdx.x; asm volatile("" : "+s"(wsp), "+s"(wave), "+s"(G_), "+s"(vcu), "+s"(bid)); \
    const int lane = lane_id_v(), tid = wave * 64 + lane; const int gw = vcu * NWAVES + wave, NGW = G_ * NWAVES; (void)lane; (void)tid; (void)gw; (void)NGW; (void)bid
#define XRES ((float*)(wsp + WS_XRES))
#define XB ((bf16*)(wsp + WS_XB))
#define Hb ((bf16*)(wsp + WS_H))
#define Gt ((bf16*)(wsp + WS_G))
#define Tb ((float*)(wsp + WS_T))
#define QA ((bf16*)(wsp + WS_QA))
#define KA ((bf16*)(wsp + WS_KA))
#define CQN ((bf16*)(wsp + WS_CQN))
#define CKVN ((bf16*)(wsp + WS_CKVN))
#define QC ((bf16*)(wsp + WS_QC))
#define KC ((bf16*)(wsp + WS_KC))
#define VC ((bf16*)(wsp + WS_VC))
#define MG ((bf16*)(wsp + WS_MG))
#define YS ((bf16*)(wsp + WS_YS))
#define ropeA_c ((float*)(wsp + WS_ROPEA_C))
#define ropeA_s ((float*)(wsp + WS_ROPEA_S))
#define ropeC_c ((float*)(wsp + WS_ROPEC_C))
#define ropeC_s ((float*)(wsp + WS_ROPEC_S))
#define ROUTE ((unsigned*)(wsp + WS_ROUTE))
#define SLOT ((unsigned*)(wsp + WS_SLOT))
#define CNT ((unsigned*)(wsp + WS_CNT))
#define META ((unsigned*)(wsp + WS_META))
#define INP(i) ldptr(PTAB, (i))
__device__ __forceinline__ const float* ldptr(const LAS unsigned* tab, int i) { const unsigned lo = __builtin_amdgcn_readfirstlane(tab[2 * i]), hi = __builtin_amdgcn_readfirstlane(tab[2 * i + 1]); return (const float*)(const GAS float*)(((unsigned long long)hi << 32) | lo); }
struct Args {
    const float* in[28]; float* out; unsigned char* ws; int ph_lo, ph_hi;
};
constexpr int PH_PER_LAYER = 16, N_PHASES = 1 + 2 * PH_PER_LAYER;

__global__ void __launch_bounds__(NWAVES * 64, 2) fwd(Args args) {
    extern __shared__ __attribute__((aligned(16))) unsigned char lds_raw[];
    Frame F;
    F.lds = (LAS unsigned char*)lds_raw;
    F.tid = threadIdx.x; F.lane = F.tid & 63; F.wave = __builtin_amdgcn_readfirstlane(F.tid >> 6);
    F.G = gridDim.x; { const int bx = blockIdx.x; F.vcu = (F.G % 8 == 0) ? (bx % 8) * (F.G / 8) + bx / 8 : bx; }
    unsigned char* ws = args.ws;
    gu32* ctl = (gu32*)(ws + WS_CTL);
    volatile LAS unsigned* MISC = (volatile LAS unsigned*)(F.lds + LDSCTL_OFF);
    for (int u = F.tid; u < (LDS_BYTES - LDSCTL_OFF) / 4; u += NWAVES * 64) ((LAS unsigned*)(F.lds + LDSCTL_OFF))[u] = 0u;
    __syncthreads();
    if (F.tid < 29) { const unsigned long long pv = (F.tid < 28) ? (unsigned long long)args.in[F.tid] : (unsigned long long)args.out; LAS unsigned* pt = (LAS unsigned*)(F.lds + LDSCTL_OFF + 2048); pt[2 * F.tid] = (unsigned)pv; pt[2 * F.tid + 1] = (unsigned)(pv >> 32); }
    __syncthreads();
    const int lo = args.ph_lo, hi = args.ph_hi;
    const bool one_launch = (hi - lo) > 1;
    XcdBarrier bar; bar.bar = (unsigned*)(ctl + CW_BAR); bar.x = 0; bar.st = nullptr;
    if (one_launch) bar = xcd_barrier_post((unsigned*)(ctl + CW_BAR), MISC);
#define IN(k) (lo <= (k) && (k) < hi)
#define SEAM(k) do { if (IN(k) && IN((k) + 1)) { int w_ = F.wave; asm volatile("" : "+s"(w_)); xcd_barrier(bar, (w_ * 64 + lane_id_v()) == 0); } } while (0)

    const LAS unsigned* PTAB = (const LAS unsigned*)(F.lds + LDSCTL_OFF + 2048);

    if (IN(0) && EN(0)) { WSP;
        LAS float* scr = (LAS float*)(F.lds + wave * 16384);
        {
            const int nit = 2 * (NW_IN / 32) * 16;
            for (int it = gw; it < nit; it += NGW) { const int l = it / ((NW_IN / 32) * 16), r = it % ((NW_IN / 32) * 16), rb = r / 16, kb = r % 16; const int sc = win_src_col(rb);
                cvt_item(INP(3) + (size_t)l * 1024 * D_IN, D_IN, sc < 0 ? 0 : sc, kb * 64, sc < 0, (bf16*)(wsp + WS_WIN) + (size_t)l * NW_IN * 1024, 1024, rb * 32, scr, lane); }
        }
        {
            const int nit = 8 * 32 * 4;
            for (int it = gw; it < nit; it += NGW) { const int mat = it / 128, r = it % 128, rb = r / 4, kb = r % 4;
                cvt_item(INP(15) + (size_t)mat * 256 * 1024, 1024, rb * 32, kb * 64, false, (bf16*)(wsp + WS_WBR) + (size_t)mat * 1024 * 256, 256, rb * 32, scr, lane); }
        }
        {
            const int nit = 2 * 32 * 16;
            for (int it = gw; it < nit; it += NGW) { const int mat = it / 512, r = it % 512, rb = r / 16, kb = r % 16;
                cvt_item(INP(16) + (size_t)mat * 1024 * 1024, 1024, rb * 32, kb * 64, false, (bf16*)(wsp + WS_WOUT) + (size_t)mat * 1024 * 1024, 1024, rb * 32, scr, lane); }
        }
        {
            const int nit = (2 * D_FF / 32) * 16;
            for (int it = gw; it < nit; it += NGW) { const int rb = it / 16, kb = it % 16; const int tile = rb >> 3, w = rb & 7;
                cvt_item((w < 4) ? INP(19) : INP(20), D_FF, tile * 128 + (w & 3) * 32, kb * 64, false, (bf16*)(wsp + WS_W13), 1024, rb * 32, scr, lane); }
        }
        {
            const int nit = 32 * (D_FF / 64);
            for (int it = gw; it < nit; it += NGW) { const int rb = it / (D_FF / 64), kb = it % (D_FF / 64);
                cvt_item(INP(21), 1024, rb * 32, kb * 64, false, (bf16*)(wsp + WS_W2), D_FF, rb * 32, scr, lane); }
        }
        {
            const int nit = 2 * 2 * 16 * 4;
            for (int it = gw; it < nit; it += NGW) { const int which = it / 128, l = (it / 64) & 1, r = it % 64, rb = r / 4, kb = r % 4;
                if (which == 0) { const bool z = (rb >= 12) || (kb >= 3); cvt_item(INP(9) + (size_t)l * 192 * 384, 384, rb * 32, kb * 64, z, (bf16*)(wsp + WS_WUQ) + (size_t)l * 512 * 256, 256, rb * 32, scr, lane); }
                else { const bool z = (kb >= 2); cvt_item(INP(10) + (size_t)l * 128 * 512, 512, rb * 32, kb * 64, z, (bf16*)(wsp + WS_WUKV) + (size_t)l * 512 * 256, 256, rb * 32, scr, lane); } }
        }
        for (int i = bid * 512 + tid; i < SEQ * 32; i += G_ * 512) { const int s = i >> 5, f = i & 31; const float pos = (f < 16) ? (float)(s >> 6) : (float)(s & 63);
            const float inv = exp2f(-(float)(f & 15) * (13.287712379549449f / 16.0f)); const float a = pos * inv; ropeA_c[i] = cosf(a); ropeA_s[i] = sinf(a); }
        for (int i = bid * 512 + tid; i < SEQ * 16; i += G_ * 512) { const int s = i >> 4, f = i & 15; const float pos = (f < 8) ? (float)(s >> 6) : (float)(s & 63);
            const float inv = exp2f(-(float)(f & 7) * (13.287712379549449f / 8.0f)); const float a = pos * inv; ropeC_c[i] = cosf(a); ropeC_s[i] = sinf(a); }
        for (int m = gw; m < M; m += NGW) { f32x4 v[4];
#pragma unroll
            for (int j = 0; j < 4; ++j) v[j] = *(const f32x4*)(INP(0) + (size_t)m * DM + 4 * lane + 256 * j);
            ln_row(v, INP(1), INP(2), lane); store_row_f32(XRES + (size_t)m * DM, v, lane); store_row_bf16(XB + (size_t)m * DM, v, lane); }
    }
    SEAM(0);

    {
        constexpr int l = 0;
        const int pb = 1 + PH_PER_LAYER * l;
        const bool moe = (l & 1) != 0;
        if (IN(pb + 0) && EN(1)) { WSP;
            pg8::Gemm g{XB, (const bf16*)(wsp + WS_WIN) + (size_t)l * NW_IN * 1024, 1024}; pg8::SchedPlain S; S.init(M / 256, NW_IN / 256, 1024, G_, bid);
            pg8::EpiWin E{Hb, Gt};
            pg8::gemm_phase<pg8::EpiWin, pg8::SchedPlain, true, true>(F.lds, g, S, E, wave);
        }
        SEAM(pb + 0);
        if (IN(pb + 1) && EN(2)) { WSP;
            const float* aqn = INP(4) + l * 64; const float* akn = INP(5) + l * 64; const float* cqn = INP(7) + l * 192; const float* ckvn = INP(8) + l * 128;
            for (int t = gw; t < M; t += NGW) { const int s = t & (SEQ - 1); const bf16* hr = Hb + (size_t)t * HP;
                {
                    const u32x2 w = *(const u32x2*)(hr + 4 * lane); float v[4] = {pg8::bf_lo(w.x), pg8::bf_hi(w.x), pg8::bf_lo(w.y), pg8::bf_hi(w.y)};
                    float ss = v[0] * v[0] + v[1] * v[1] + v[2] * v[2] + v[3] * v[3]; ss = sum16(ss);
                    const float rs = 1.0f / sqrtf(ss * (1.f / 64.f) + RMS_EPS); const int d = 4 * (lane & 15); const f32x4 gg = *(const f32x4*)(aqn + d);
                    const f32x2 cs = *(const f32x2*)(ropeA_c + s * 32 + (d >> 1)), sn = *(const f32x2*)(ropeA_s + s * 32 + (d >> 1));
                    const float a0 = v[0] * rs * gg[0], a1 = v[1] * rs * gg[1], a2 = v[2] * rs * gg[2], a3 = v[3] * rs * gg[3];
                    u32x2 o; o.x = pk2((a0 * cs[0] - a1 * sn[0]) * QS64, (a0 * sn[0] + a1 * cs[0]) * QS64); o.y = pk2((a2 * cs[1] - a3 * sn[1]) * QS64, (a2 * sn[1] + a3 * cs[1]) * QS64);
                    *(u32x2*)(QA + (size_t)t * 256 + 4 * lane) = o; }
                if (lane < 32) {
                    const u32x2 w = *(const u32x2*)(hr + 256 + 4 * lane); float v[4] = {pg8::bf_lo(w.x), pg8::bf_hi(w.x), pg8::bf_lo(w.y), pg8::bf_hi(w.y)};
                    float ss = v[0] * v[0] + v[1] * v[1] + v[2] * v[2] + v[3] * v[3]; ss = sum16(ss);
                    const float rs = 1.0f / sqrtf(ss * (1.f / 64.f) + RMS_EPS); const int d = 4 * (lane & 15); const f32x4 gg = *(const f32x4*)(akn + d);
                    const f32x2 cs = *(const f32x2*)(ropeA_c + s * 32 + (d >> 1)), sn = *(const f32x2*)(ropeA_s + s * 32 + (d >> 1));
                    const float a0 = v[0] * rs * gg[0], a1 = v[1] * rs * gg[1], a2 = v[2] * rs * gg[2], a3 = v[3] * rs * gg[3];
                    u32x2 o; o.x = pk2(a0 * cs[0] - a1 * sn[0], a0 * sn[0] + a1 * cs[0]); o.y = pk2(a2 * cs[1] - a3 * sn[1], a2 * sn[1] + a3 * cs[1]);
                    *(u32x2*)(KA + (size_t)t * 128 + 4 * lane) = o; }
                {
                    float v[4] = {0.f, 0.f, 0.f, 0.f};
                    if (lane < 48) { const u32x2 w = *(const u32x2*)(hr + 1280 + 4 * lane); v[0] = pg8::bf_lo(w.x); v[1] = pg8::bf_hi(w.x); v[2] = pg8::bf_lo(w.y); v[3] = pg8::bf_hi(w.y); }
                    const float ss = wave_sum(v[0] * v[0] + v[1] * v[1] + v[2] * v[2] + v[3] * v[3]); const float rs = 1.0f / sqrtf(ss * (1.f / 192.f) + RMS_EPS);
                    u32x2 o = {0u, 0u};
                    if (lane < 48) { const f32x4 gg = *(const f32x4*)(cqn + 4 * lane); o.x = pk2(v[0] * rs * gg[0], v[1] * rs * gg[1]); o.y = pk2(v[2] * rs * gg[2], v[3] * rs * gg[3]); }
                    *(u32x2*)(CQN + (size_t)t * 256 + 4 * lane) = o; }
                {
                    float v[4] = {0.f, 0.f, 0.f, 0.f};
                    if (lane < 32) { const u32x2 w = *(const u32x2*)(hr + 1536 + 4 * lane); v[0] = pg8::bf_lo(w.x); v[1] = pg8::bf_hi(w.x); v[2] = pg8::bf_lo(w.y); v[3] = pg8::bf_hi(w.y); }
                    const float ss = wave_sum(v[0] * v[0] + v[1] * v[1] + v[2] * v[2] + v[3] * v[3]); const float rs = 1.0f / sqrtf(ss * (1.f / 128.f) + RMS_EPS);
                    u32x2 o = {0u, 0u};
                    if (lane < 32) { const f32x4 gg = *(const f32x4*)(ckvn + 4 * lane); o.x = pk2(v[0] * rs * gg[0], v[1] * rs * gg[1]); o.y = pk2(v[2] * rs * gg[2], v[3] * rs * gg[3]); }
                    *(u32x2*)(CKVN + (size_t)t * 256 + 4 * lane) = o; }
                if (lane < 32) {
                    const int j = lane & 7, hh = lane >> 3; const u32x2 w = *(const u32x2*)(hr + 1664 + 4 * j);
                    const float a0 = pg8::bf_lo(w.x), a1 = pg8::bf_hi(w.x), a2 = pg8::bf_lo(w.y), a3 = pg8::bf_hi(w.y);
                    const f32x2 cs = *(const f32x2*)(ropeC_c + s * 16 + 2 * j), sn = *(const f32x2*)(ropeC_s + s * 16 + 2 * j);
                    u32x2 o; o.x = pk2(a0 * cs[0] - a1 * sn[0], a0 * sn[0] + a1 * cs[0]); o.y = pk2(a2 * cs[1] - a3 * sn[1], a2 * sn[1] + a3 * cs[1]);
                    *(u32x2*)(KC + (size_t)t * 384 + hh * 96 + 64 + 4 * j) = o; }
            }
        }
        SEAM(pb + 1);
        if (IN(pb + 2) && EN(3)) { WSP;
            { pg8::Gemm g{CQN, (const bf16*)(wsp + WS_WUQ) + (size_t)l * 512 * 256, 256}; pg8::SchedPlain S; S.init(M / 256, 2, 256, G_, bid);
              pg8::EpiUq E{QC, ropeC_c, ropeC_s}; pg8::gemm_phase<pg8::EpiUq, pg8::SchedPlain, false, true>(F.lds, g, S, E, wave); }
            { pg8::Gemm g{CKVN, (const bf16*)(wsp + WS_WUKV) + (size_t)l * 512 * 256, 256}; pg8::SchedPlain S; S.init(M / 256, 2, 256, G_, bid);
              pg8::EpiUkv E{KC, VC}; pg8::gemm_phase<pg8::EpiUkv, pg8::SchedPlain, false, true>(F.lds, g, S, E, wave); }
        }
        SEAM(pb + 2);
        if (IN(pb + 3) && EN(4)) { WSP;
            for (int u = vcu; u < 256; u += G_) {
#if DBG_LDSFILL
                for (int i = tid; i < 49152 / 4; i += 512) ((LAS unsigned*)F.lds)[i] = DBG_LDSFILL_VAL; __syncthreads();
#endif
                const int b = u >> 5, hh = (u >> 3) & 3, qb = u & 7; const size_t r0 = (size_t)b * SEQ + qb * 256, b0 = (size_t)b * SEQ;
#if DBG_ZERO_AC
                for (int i = tid; i < 256 * 8; i += 512) { const int rr = i >> 3, c8 = i & 7; *(u32x4*)(YS + ((size_t)0 * M + r0 + rr) * 256 + hh * 64 + c8 * 8) = (u32x4){0u, 0u, 0u, 0u}; *(u32x4*)(YS + ((size_t)2 * M + r0 + rr) * 256 + hh * 64 + c8 * 8) = (u32x4){0u, 0u, 0u, 0u}; }
#else
                att::attn_unit<64, 0>(F.lds, QA + r0 * 256 + hh * 64, 256, KA + b0 * 128 + (hh >> 1) * 64, 128, Hb + b0 * HP + OFF_AV + (hh >> 1) * 64, HP, YS + r0 * 256 + hh * 64, 256, SEQ / 64, 0, wave);
                att::attn_unit<96, 0>(F.lds, QC + r0 * 384 + hh * 96, 384, KC + b0 * 384 + hh * 96, 384, VC + b0 * 256 + hh * 64, 256, YS + ((size_t)2 * M + r0) * 256 + hh * 64, 256, SEQ / 64, 0, wave);
#endif
                { const float* rpb = INP(6) + ((size_t)l * 4 + hh) * 15 * 31; LAS float* tab = (LAS float*)(F.lds + att::RPB_OFF);
                  if (tid < 480) { const int dr = tid >> 5, dc = tid & 31; tab[tid] = (dc < 31) ? rpb[dr * 31 + dc] * LOG2E : 0.f; }
                  __syncthreads(); }
#if DBG_ZERO_B
                for (int i = tid; i < 256 * 8; i += 512) { const int rr = i >> 3, c8 = i & 7; *(u32x4*)(YS + ((size_t)1 * M + r0 + rr) * 256 + hh * 64 + c8 * 8) = (u32x4){0u, 0u, 0u, 0u}; }
#else
                att::attn_unit<64, 1>(F.lds, Hb + r0 * HP + OFF_BQ + hh * 64, HP, Hb + b0 * HP + OFF_BK + hh * 64, HP, Hb + b0 * HP + OFF_BV + hh * 64, HP, YS + ((size_t)1 * M + r0) * 256 + hh * 64, 256, NROWS, qb * 4, wave);
#endif
                {
                    const int t0 = u * 64, s0 = t0 & (SEQ - 1); LAS bf16* tile = (LAS bf16*)F.lds;
                    for (int i = tid; i < 94 * 32; i += 512) { const int rr = i >> 5, c8 = i & 31; const int s = s0 - 15 + rr; u32x4 v = {0u, 0u, 0u, 0u};
                        if (s >= 0 && s < SEQ) v = *(const u32x4*)(Hb + (size_t)(t0 - 15 + rr) * HP + 1792 + c8 * 8);
                        *(LAS u32x4*)(tile + rr * 256 + c8 * 8) = v; }
                    __syncthreads();
                    const float* cw = INP(11) + (size_t)l * 31 * 256; const int c4 = 4 * lane;
                    f32x4 acc[8];
                    { const f32x4 bb = *(const f32x4*)(INP(12) + l * 256 + c4);
#pragma unroll
                      for (int j = 0; j < 8; ++j) acc[j] = bb; }
                    for (int k = 0; k < 31; ++k) { const f32x4 wk = *(const f32x4*)(cw + k * 256 + c4);
#pragma unroll
                        for (int j = 0; j < 8; ++j) { const u32x2 w = *(const LAS u32x2*)(tile + (wave * 8 + j + k) * 256 + c4);
                            acc[j][0] += wk[0] * pg8::bf_lo(w.x); acc[j][1] += wk[1] * pg8::bf_hi(w.x); acc[j][2] += wk[2] * pg8::bf_lo(w.y); acc[j][3] += wk[3] * pg8::bf_hi(w.y); } }
                    const f32x4 lg = *(const f32x4*)(INP(13) + l * 256 + c4), lb = *(const f32x4*)(INP(14) + l * 256 + c4);
#pragma unroll
                    for (int j = 0; j < 8; ++j) { f32x4 v = acc[j]; const float mean = wave_sum((v[0] + v[1]) + (v[2] + v[3])) * (1.f / 256.f); v = v - mean;
                        const float var = wave_sum((v[0] * v[0] + v[1] * v[1]) + (v[2] * v[2] + v[3] * v[3])) * (1.f / 256.f); const float rstd = 1.0f / sqrtf(var + LN_EPS);
                        v = v * rstd * lg + lb;
                        u32x2 o; o.x = pk2(v[0] * pg8::sigmoidf_(v[0]), v[1] * pg8::sigmoidf_(v[1])); o.y = pk2(v[2] * pg8::sigmoidf_(v[2]), v[3] * pg8::sigmoidf_(v[3]));
                        *(u32x2*)(YS + ((size_t)3 * M + t0 + wave * 8 + j) * 256 + c4) = o; }
                    __syncthreads();
                }
            }
        }
        SEAM(pb + 3);
        if (IN(pb + 4) && EN(5)) { WSP;
            pg8::Gemm g{YS, (const bf16*)(wsp + WS_WBR) + (size_t)l * 4 * 1024 * 256, 256}; pg8::SchedMerge S; S.init(G_, bid);
            pg8::EpiMerge E{Gt, MG}; pg8::gemm_phase<pg8::EpiMerge, pg8::SchedMerge, false, true>(F.lds, g, S, E, wave);
        }
        SEAM(pb + 4);
        if (IN(pb + 5) && EN(6)) { WSP;
            pg8::Gemm g{MG, (const bf16*)(wsp + WS_WOUT) + (size_t)l * 1024 * 1024, 1024}; pg8::SchedPlain S; S.init(M / 256, 4, 1024, G_, bid);
            pg8::EpiRes E{XRES, Tb}; pg8::gemm_phase<pg8::EpiRes, pg8::SchedPlain, false, true>(F.lds, g, S, E, wave);
        }
        SEAM(pb + 5);
        if (IN(pb + 6) && EN(7)) { WSP;
            const float* lg = INP(17) + l * DM; const float* lb = INP(18) + l * DM; const float* router = INP(22);
            LAS unsigned* lcnt = (LAS unsigned*)(F.lds + LDSCTL_OFF + 64);
            for (int blk = vcu; blk < 256; blk += G_) {
                if (moe) { if (tid < 8) lcnt[tid] = 0u; __syncthreads(); }
                for (int k = 0; k < 8; ++k) { const int t = blk * 64 + wave * 8 + k; f32x4 v[4];
#pragma unroll
                    for (int j = 0; j < 4; ++j) v[j] = *(const f32x4*)(Tb + (size_t)t * DM + 4 * lane + 256 * j);
                    ln_row(v, lg, lb, lane); store_row_f32(XRES + (size_t)t * DM, v, lane);
                    if (!moe) store_row_bf16(XB + (size_t)t * DM, v, lane);
                    else {
                        float lgt[8] = {0.f, 0.f, 0.f, 0.f, 0.f, 0.f, 0.f, 0.f};
#pragma unroll
                        for (int j = 0; j < 4; ++j)
#pragma unroll
                            for (int e4 = 0; e4 < 4; ++e4) { const float xv = v[j][e4]; const float* rr = router + (size_t)(4 * lane + 256 * j + e4) * 8; const f32x4 ra = *(const f32x4*)rr, rb = *(const f32x4*)(rr + 4);
                                lgt[0] += xv * ra[0]; lgt[1] += xv * ra[1]; lgt[2] += xv * ra[2]; lgt[3] += xv * ra[3]; lgt[4] += xv * rb[0]; lgt[5] += xv * rb[1]; lgt[6] += xv * rb[2]; lgt[7] += xv * rb[3]; }
#pragma unroll
                        for (int e = 0; e < 8; ++e) lgt[e] = wave_sum(lgt[e]);
                        int e0 = 0; float l0 = lgt[0];
#pragma unroll
                        for (int e = 1; e < 8; ++e) if (lgt[e] > l0) { l0 = lgt[e]; e0 = e; }
                        int e1 = -1; float l1 = -3.0e38f;
#pragma unroll
                        for (int e = 0; e < 8; ++e) if (e != e0 && lgt[e] > l1) { l1 = lgt[e]; e1 = e; }
                        const float ex = __expf(l1 - l0); const float w0 = 1.0f / (1.0f + ex), w1 = ex / (1.0f + ex);
                        if (lane == 0) { *(u32x4*)(ROUTE + (size_t)t * 4) = (u32x4){(unsigned)e0, (unsigned)e1, __float_as_uint(w0), __float_as_uint(w1)};
                            __hip_atomic_fetch_add(lcnt + e0, 1u, __ATOMIC_RELAXED, __HIP_MEMORY_SCOPE_WORKGROUP); __hip_atomic_fetch_add(lcnt + e1, 1u, __ATOMIC_RELAXED, __HIP_MEMORY_SCOPE_WORKGROUP); }
                    }
                }
                if (moe) { __syncthreads(); if (tid < 8) CNT[blk * 8 + tid] = lcnt[tid]; __syncthreads(); }
            }
        }
        SEAM(pb + 6);
        if (IN(pb + 7) && moe && EN(8)) { WSP;
            LAS float* scr = (LAS float*)(F.lds + wave * 16384);
            {
                const int per_e = (2 * D_FFE / 32) * 16, nit = NEXP * per_e;
                for (int it = gw; it < nit; it += NGW) { const int e = it / per_e, r = it % per_e, rb = r / 16, kb = r % 16; const int tile = rb >> 3, w = rb & 7;
                    cvt_item(((w < 4) ? INP(23) : INP(24)) + (size_t)e * 1024 * D_FFE, D_FFE, tile * 128 + (w & 3) * 32, kb * 64, false, (bf16*)(wsp + WS_MW13) + (size_t)e * 2 * D_FFE * 1024, 1024, rb * 32, scr, lane); }
            }
            __syncthreads();
            LAS unsigned* L = (LAS unsigned*)(F.lds + LDSCTL_OFF + 128);
            for (int blk = vcu; blk < 256; blk += G_) {
                if (tid < 16) L[tid] = 0u;
                __syncthreads();
                if (tid < 256) { const u32x4 c0 = *(const u32x4*)(CNT + tid * 8), c1 = *(const u32x4*)(CNT + tid * 8 + 4); const unsigned c[8] = {c0.x, c0.y, c0.z, c0.w, c1.x, c1.y, c1.z, c1.w};
#pragma unroll
                    for (int e = 0; e < 8; ++e) { __hip_atomic_fetch_add(L + e, c[e], __ATOMIC_RELAXED, __HIP_MEMORY_SCOPE_WORKGROUP); if (tid < blk) __hip_atomic_fetch_add(L + 8 + e, c[e], __ATOMIC_RELAXED, __HIP_MEMORY_SCOPE_WORKGROUP); } }
                __syncthreads();
                if (tid == 0) { unsigned off = 0; for (int e = 0; e < 8; ++e) { L[16 + e] = off; off += ((L[e] + 255u) >> 8) << 8; }
                    L[24] = off >> 8; }
                __syncthreads();
                if (blk == 0 && tid < MAXTILES) { unsigned e = 0;
#pragma unroll
                    for (unsigned k = 1; k < 8; ++k) if ((unsigned)tid >= (L[16 + k] >> 8) && L[k] > 0u) e = k;
                    ((unsigned char*)(META + 16))[tid] = (unsigned char)e; if (tid == 0) META[0] = L[24]; }
                if (wave == 0) { const int t = blk * 64 + lane; const u32x4 r = *(const u32x4*)(ROUTE + (size_t)t * 4); const int e0 = (int)r.x, e1 = (int)r.y; unsigned s0 = 0, s1 = 0;
                    const unsigned long long lt = (1ull << lane) - 1ull;
#pragma unroll
                    for (int e = 0; e < 8; ++e) { const unsigned long long m0 = __ballot(e0 == e), m1 = __ballot(e1 == e); const unsigned base = L[16 + e] + L[8 + e];
                        if (e0 == e) s0 = base + (unsigned)__popcll(m0 & lt); if (e1 == e) s1 = base + (unsigned)__popcll(m0) + (unsigned)__popcll(m1 & lt); }
                    L[32 + 2 * lane] = s0; L[33 + 2 * lane] = s1; *(u32x2*)(SLOT + (size_t)t * 2) = (u32x2){s0, s1}; }
                __syncthreads();
                for (int k = 0; k < 8; ++k) { const int tl = wave * 8 + k, t = blk * 64 + tl; const unsigned s0 = L[32 + 2 * tl], s1 = L[33 + 2 * tl];
                    bf16* d0 = (bf16*)(wsp + WS_XG) + (size_t)s0 * DM, *d1 = (bf16*)(wsp + WS_XG) + (size_t)s1 * DM;
#pragma unroll
                    for (int j = 0; j < 4; ++j) { const f32x4 v = *(const f32x4*)(XRES + (size_t)t * DM + 4 * lane + 256 * j); u32x2 w; w.x = pk2(v[0], v[1]); w.y = pk2(v[2], v[3]);
                        *(u32x2*)(d0 + 4 * lane + 256 * j) = w; *(u32x2*)(d1 + 4 * lane + 256 * j) = w; } }
                __syncthreads();
            }
        }
        if (moe) SEAM(pb + 7);
        if (IN(pb + 8) && EN(9)) { WSP;
            LAS unsigned char* te = F.lds + LDSCTL_OFF + 1024;
            int ntiles = M / 256;
            if (moe) { ntiles = (int)__hip_atomic_load(META, __ATOMIC_RELAXED, __HIP_MEMORY_SCOPE_AGENT); ntiles = ntiles > MAXTILES ? MAXTILES : ntiles; if (tid < MAXTILES) te[tid] = ((const unsigned char*)(META + 16))[tid]; }
            else { if (tid < MAXTILES) te[tid] = 0; }
            __syncthreads();
            ntiles = __builtin_amdgcn_readfirstlane(ntiles);
            if (!moe) { pg8::Gemm g{XB, (const bf16*)(wsp + WS_W13), 1024}; pg8::SchedGroup S; S.init(ntiles, 2 * D_FF / 256, 1024, G_, bid, te);
                pg8::EpiSwiGLU E{(bf16*)(wsp + WS_HID0), D_FF}; pg8::gemm_phase<pg8::EpiSwiGLU, pg8::SchedGroup, true, true>(F.lds, g, S, E, wave); }
            else { pg8::Gemm g{(const bf16*)(wsp + WS_XG), (const bf16*)(wsp + WS_MW13), 1024}; pg8::SchedGroup S; S.init(ntiles, 2 * D_FFE / 256, 1024, G_, bid, te);
                pg8::EpiSwiGLU E{(bf16*)(wsp + WS_MHID), D_FFE}; pg8::gemm_phase<pg8::EpiSwiGLU, pg8::SchedGroup, true, true>(F.lds, g, S, E, wave); }
        }
        SEAM(pb + 8);
        if (IN(pb + 9) && moe && EN(10)) { WSP;
            LAS float* scr = (LAS float*)(F.lds + wave * 16384);
            const int per_e = 32 * (D_FFE / 64), nit = NEXP * per_e;
            for (int it = gw; it < nit; it += NGW) { const int e = it / per_e, r = it % per_e, rb = r / (D_FFE / 64), kb = r % (D_FFE / 64);
                cvt_item(INP(25) + (size_t)e * D_FFE * 1024, 1024, rb * 32, kb * 64, false, (bf16*)(wsp + WS_MW2) + (size_t)e * 1024 * D_FFE, D_FFE, rb * 32, scr, lane); }
        }
        if (moe) SEAM(pb + 9);
        if (IN(pb + 10) && EN(11)) { WSP;
            LAS unsigned char* te = F.lds + LDSCTL_OFF + 1024;
            if (!moe) { pg8::Gemm g{(const bf16*)(wsp + WS_HID0), (const bf16*)(wsp + WS_W2), D_FF}; pg8::SchedPlain S; S.init(M / 256, 4, D_FF, G_, bid);
                pg8::EpiRes E{XRES, Tb}; pg8::gemm_phase<pg8::EpiRes, pg8::SchedPlain, false, true>(F.lds, g, S, E, wave); }
            else { int ntiles = (int)__hip_atomic_load(META, __ATOMIC_RELAXED, __HIP_MEMORY_SCOPE_AGENT); ntiles = ntiles > MAXTILES ? MAXTILES : ntiles; if (tid < MAXTILES) te[tid] = ((const unsigned char*)(META + 16))[tid];
                __syncthreads(); ntiles = __builtin_amdgcn_readfirstlane(ntiles);
                pg8::Gemm g{(const bf16*)(wsp + WS_MHID), (const bf16*)(wsp + WS_MW2), D_FFE}; pg8::SchedGroup S; S.init(ntiles, 4, D_FFE, G_, bid, te);
                pg8::EpiO E{(bf16*)(wsp + WS_XG)}; pg8::gemm_phase<pg8::EpiO, pg8::SchedGroup, true, true>(F.lds, g, S, E, wave); }
        }
        SEAM(pb + 10);
        if (IN(pb + 11) && EN(12)) { WSP;
            const float* lg = INP(26) + l * DM; const float* lb = INP(27) + l * DM; const bool last = (l == DEPTH - 1);
            const bf16* Ob = (const bf16*)(wsp + WS_XG);
            for (int t = gw; t < M; t += NGW) { f32x4 v[4];
                if (!moe) {
#pragma unroll
                    for (int j = 0; j < 4; ++j) v[j] = *(const f32x4*)(Tb + (size_t)t * DM + 4 * lane + 256 * j);
                } else { const u32x4 r = *(const u32x4*)(ROUTE + (size_t)t * 4); const u32x2 sl = *(const u32x2*)(SLOT + (size_t)t * 2); const float w0 = __uint_as_float(r.z), w1 = __uint_as_float(r.w);
#pragma unroll
                    for (int j = 0; j < 4; ++j) { const f32x4 xv = *(const f32x4*)(XRES + (size_t)t * DM + 4 * lane + 256 * j);
                        const u32x2 a = *(const u32x2*)(Ob + (size_t)sl.x * DM + 4 * lane + 256 * j), b = *(const u32x2*)(Ob + (size_t)sl.y * DM + 4 * lane + 256 * j);
                        v[j][0] = xv[0] * ALPHA + w0 * pg8::bf_lo(a.x) + w1 * pg8::bf_lo(b.x); v[j][1] = xv[1] * ALPHA + w0 * pg8::bf_hi(a.x) + w1 * pg8::bf_hi(b.x);
                        v[j][2] = xv[2] * ALPHA + w0 * pg8::bf_lo(a.y) + w1 * pg8::bf_lo(b.y); v[j][3] = xv[3] * ALPHA + w0 * pg8::bf_hi(a.y) + w1 * pg8::bf_hi(b.y); } }
                ln_row(v, lg, lb, lane);
#if DBG_ZROWS
                if (last && (DBG_ZCOND)) { v[0] = f32x4{}; v[1] = f32x4{}; v[2] = f32x4{}; v[3] = f32x4{}; }
#endif
                if (last) store_row_f32(((float*)INP(28)) + (size_t)t * DM, v, lane);
                else { store_row_f32(XRES + (size_t)t * DM, v, lane); store_row_bf16(XB + (size_t)t * DM, v, lane); } }
        }
        SEAM(pb + 11);
    }
    {
        constexpr int l = 1;
        const int pb = 1 + PH_PER_LAYER * l;
        const bool moe = (l & 1) != 0;
        if (IN(pb + 0) && EN(1)) { WSP;
            pg8::Gemm g{XB, (const bf16*)(wsp + WS_WIN) + (size_t)l * NW_IN * 1024, 1024}; pg8::SchedPlain S; S.init(M / 256, NW_IN / 256, 1024, G_, bid);
            pg8::EpiWin E{Hb, Gt};
            pg8::gemm_phase<pg8::EpiWin, pg8::SchedPlain, true, true>(F.lds, g, S, E, wave);
        }
        SEAM(pb + 0);
        if (IN(pb + 1) && EN(2)) { WSP;
            const float* aqn = INP(4) + l * 64; const float* akn = INP(5) + l * 64; const float* cqn = INP(7) + l * 192; const float* ckvn = INP(8) + l * 128;
            for (int t = gw; t < M; t += NGW) { const int s = t & (SEQ - 1); const bf16* hr = Hb + (size_t)t * HP;
                {
                    const u32x2 w = *(const u32x2*)(hr + 4 * lane); float v[4] = {pg8::bf_lo(w.x), pg8::bf_hi(w.x), pg8::bf_lo(w.y), pg8::bf_hi(w.y)};
                    float ss = v[0] * v[0] + v[1] * v[1] + v[2] * v[2] + v[3] * v[3]; ss = sum16(ss);
                    const float rs = 1.0f / sqrtf(ss * (1.f / 64.f) + RMS_EPS); const int d = 4 * (lane & 15); const f32x4 gg = *(const f32x4*)(aqn + d);
                    const f32x2 cs = *(const f32x2*)(ropeA_c + s * 32 + (d >> 1)), sn = *(const f32x2*)(ropeA_s + s * 32 + (d >> 1));
                    const float a0 = v[0] * rs * gg[0], a1 = v[1] * rs * gg[1], a2 = v[2] * rs * gg[2], a3 = v[3] * rs * gg[3];
                    u32x2 o; o.x = pk2((a0 * cs[0] - a1 * sn[0]) * QS64, (a0 * sn[0] + a1 * cs[0]) * QS64); o.y = pk2((a2 * cs[1] - a3 * sn[1]) * QS64, (a2 * sn[1] + a3 * cs[1]) * QS64);
                    *(u32x2*)(QA + (size_t)t * 256 + 4 * lane) = o; }
                if (lane < 32) {
                    const u32x2 w = *(const u32x2*)(hr + 256 + 4 * lane); float v[4] = {pg8::bf_lo(w.x), pg8::bf_hi(w.x), pg8::bf_lo(w.y), pg8::bf_hi(w.y)};
                    float ss = v[0] * v[0] + v[1] * v[1] + v[2] * v[2] + v[3] * v[3]; ss = sum16(ss);
                    const float rs = 1.0f / sqrtf(ss * (1.f / 64.f) + RMS_EPS); const int d = 4 * (lane & 15); const f32x4 gg = *(const f32x4*)(akn + d);
                    const f32x2 cs = *(const f32x2*)(ropeA_c + s * 32 + (d >> 1)), sn = *(const f32x2*)(ropeA_s + s * 32 + (d >> 1));
                    const float a0 = v[0] * rs * gg[0], a1 = v[1] * rs * gg[1], a2 = v[2] * rs * gg[2], a3 = v[3] * rs * gg[3];
                    u32x2 o; o.x = pk2(a0 * cs[0] - a1 * sn[0], a0 * sn[0] + a1 * cs[0]); o.y = pk2(a2 * cs[1] - a3 * sn[1], a2 * sn[1] + a3 * cs[1]);
                    *(u32x2*)(KA + (size_t)t * 128 + 4 * lane) = o; }
                {
                    float v[4] = {0.f, 0.f, 0.f, 0.f};
                    if (lane < 48) { const u32x2 w = *(const u32x2*)(hr + 1280 + 4 * lane); v[0] = pg8::bf_lo(w.x); v[1] = pg8::bf_hi(w.x); v[2] = pg8::bf_lo(w.y); v[3] = pg8::bf_hi(w.y); }
                    const float ss = wave_sum(v[0] * v[0] + v[1] * v[1] + v[2] * v[2] + v[3] * v[3]); const float rs = 1.0f / sqrtf(ss * (1.f / 192.f) + RMS_EPS);
                    u32x2 o = {0u, 0u};
                    if (lane < 48) { const f32x4 gg = *(const f32x4*)(cqn + 4 * lane); o.x = pk2(v[0] * rs * gg[0], v[1] * rs * gg[1]); o.y = pk2(v[2] * rs * gg[2], v[3] * rs * gg[3]); }
                    *(u32x2*)(CQN + (size_t)t * 256 + 4 * lane) = o; }
                {
                    float v[4] = {0.f, 0.f, 0.f, 0.f};
                    if (lane < 32) { const u32x2 w = *(const u32x2*)(hr + 1536 + 4 * lane); v[0] = pg8::bf_lo(w.x); v[1] = pg8::bf_hi(w.x); v[2] = pg8::bf_lo(w.y); v[3] = pg8::bf_hi(w.y); }
                    const float ss = wave_sum(v[0] * v[0] + v[1] * v[1] + v[2] * v[2] + v[3] * v[3]); const float rs = 1.0f / sqrtf(ss * (1.f / 128.f) + RMS_EPS);
                    u32x2 o = {0u, 0u};
                    if (lane < 32) { const f32x4 gg = *(const f32x4*)(ckvn + 4 * lane); o.x = pk2(v[0] * rs * gg[0], v[1] * rs * gg[1]); o.y = pk2(v[2] * rs * gg[2], v[3] * rs * gg[3]); }
                    *(u32x2*)(CKVN + (size_t)t * 256 + 4 * lane) = o; }
                if (lane < 32) {
                    const int j = lane & 7, hh = lane >> 3; const u32x2 w = *(const u32x2*)(hr + 1664 + 4 * j);
                    const float a0 = pg8::bf_lo(w.x), a1 = pg8::bf_hi(w.x), a2 = pg8::bf_lo(w.y), a3 = pg8::bf_hi(w.y);
                    const f32x2 cs = *(const f32x2*)(ropeC_c + s * 16 + 2 * j), sn = *(const f32x2*)(ropeC_s + s * 16 + 2 * j);
                    u32x2 o; o.x = pk2(a0 * cs[0] - a1 * sn[0], a0 * sn[0] + a1 * cs[0]); o.y = pk2(a2 * cs[1] - a3 * sn[1], a2 * sn[1] + a3 * cs[1]);
                    *(u32x2*)(KC + (size_t)t * 384 + hh * 96 + 64 + 4 * j) = o; }
            }
        }
        SEAM(pb + 1);
        if (IN(pb + 2) && EN(3)) { WSP;
            { pg8::Gemm g{CQN, (const bf16*)(wsp + WS_WUQ) + (size_t)l * 512 * 256, 256}; pg8::SchedPlain S; S.init(M / 256, 2, 256, G_, bid);
              pg8::EpiUq E{QC, ropeC_c, ropeC_s}; pg8::gemm_phase<pg8::EpiUq, pg8::SchedPlain, false, true>(F.lds, g, S, E, wave); }
            { pg8::Gemm g{CKVN, (const bf16*)(wsp + WS_WUKV) + (size_t)l * 512 * 256, 256}; pg8::SchedPlain S; S.init(M / 256, 2, 256, G_, bid);
              pg8::EpiUkv E{KC, VC}; pg8::gemm_phase<pg8::EpiUkv, pg8::SchedPlain, false, true>(F.lds, g, S, E, wave); }
        }
        SEAM(pb + 2);
        if (IN(pb + 3) && EN(4)) { WSP;
            for (int u = vcu; u < 256; u += G_) {
#if DBG_LDSFILL
                for (int i = tid; i < 49152 / 4; i += 512) ((LAS unsigned*)F.lds)[i] = DBG_LDSFILL_VAL; __syncthreads();
#endif
                const int b = u >> 5, hh = (u >> 3) & 3, qb = u & 7; const size_t r0 = (size_t)b * SEQ + qb * 256, b0 = (size_t)b * SEQ;
#if DBG_ZERO_AC
                for (int i = tid; i < 256 * 8; i += 512) { const int rr = i >> 3, c8 = i & 7; *(u32x4*)(YS + ((size_t)0 * M + r0 + rr) * 256 + hh * 64 + c8 * 8) = (u32x4){0u, 0u, 0u, 0u}; *(u32x4*)(YS + ((size_t)2 * M + r0 + rr) * 256 + hh * 64 + c8 * 8) = (u32x4){0u, 0u, 0u, 0u}; }
#else
                att::attn_unit<64, 0>(F.lds, QA + r0 * 256 + hh * 64, 256, KA + b0 * 128 + (hh >> 1) * 64, 128, Hb + b0 * HP + OFF_AV + (hh >> 1) * 64, HP, YS + r0 * 256 + hh * 64, 256, SEQ / 64, 0, wave);
                att::attn_unit<96, 0>(F.lds, QC + r0 * 384 + hh * 96, 384, KC + b0 * 384 + hh * 96, 384, VC + b0 * 256 + hh * 64, 256, YS + ((size_t)2 * M + r0) * 256 + hh * 64, 256, SEQ / 64, 0, wave);
#endif
                { const float* rpb = INP(6) + ((size_t)l * 4 + hh) * 15 * 31; LAS float* tab = (LAS float*)(F.lds + att::RPB_OFF);
                  if (tid < 480) { const int dr = tid >> 5, dc = tid & 31; tab[tid] = (dc < 31) ? rpb[dr * 31 + dc] * LOG2E : 0.f; }
                  __syncthreads(); }
#if DBG_ZERO_B
                for (int i = tid; i < 256 * 8; i += 512) { const int rr = i >> 3, c8 = i & 7; *(u32x4*)(YS + ((size_t)1 * M + r0 + rr) * 256 + hh * 64 + c8 * 8) = (u32x4){0u, 0u, 0u, 0u}; }
#else
                att::attn_unit<64, 1>(F.lds, Hb + r0 * HP + OFF_BQ + hh * 64, HP, Hb + b0 * HP + OFF_BK + hh * 64, HP, Hb + b0 * HP + OFF_BV + hh * 64, HP, YS + ((size_t)1 * M + r0) * 256 + hh * 64, 256, NROWS, qb * 4, wave);
#endif
                {
                    const int t0 = u * 64, s0 = t0 & (SEQ - 1); LAS bf16* tile = (LAS bf16*)F.lds;
                    for (int i = tid; i < 94 * 32; i += 512) { const int rr = i >> 5, c8 = i & 31; const int s = s0 - 15 + rr; u32x4 v = {0u, 0u, 0u, 0u};
                        if (s >= 0 && s < SEQ) v = *(const u32x4*)(Hb + (size_t)(t0 - 15 + rr) * HP + 1792 + c8 * 8);
                        *(LAS u32x4*)(tile + rr * 256 + c8 * 8) = v; }
                    __syncthreads();
                    const float* cw = INP(11) + (size_t)l * 31 * 256; const int c4 = 4 * lane;
                    f32x4 acc[8];
                    { const f32x4 bb = *(const f32x4*)(INP(12) + l * 256 + c4);
#pragma unroll
                      for (int j = 0; j < 8; ++j) acc[j] = bb; }
                    for (int k = 0; k < 31; ++k) { const f32x4 wk = *(const f32x4*)(cw + k * 256 + c4);
#pragma unroll
                        for (int j = 0; j < 8; ++j) { const u32x2 w = *(const LAS u32x2*)(tile + (wave * 8 + j + k) * 256 + c4);
                            acc[j][0] += wk[0] * pg8::bf_lo(w.x); acc[j][1] += wk[1] * pg8::bf_hi(w.x); acc[j][2] += wk[2] * pg8::bf_lo(w.y); acc[j][3] += wk[3] * pg8::bf_hi(w.y); } }
                    const f32x4 lg = *(const f32x4*)(INP(13) + l * 256 + c4), lb = *(const f32x4*)(INP(14) + l * 256 + c4);
#pragma unroll
                    for (int j = 0; j < 8; ++j) { f32x4 v = acc[j]; const float mean = wave_sum((v[0] + v[1]) + (v[2] + v[3])) * (1.f / 256.f); v = v - mean;
                        const float var = wave_sum((v[0] * v[0] + v[1] * v[1]) + (v[2] * v[2] + v[3] * v[3])) * (1.f / 256.f); const float rstd = 1.0f / sqrtf(var + LN_EPS);
                        v = v * rstd * lg + lb;
                        u32x2 o; o.x = pk2(v[0] * pg8::sigmoidf_(v[0]), v[1] * pg8::sigmoidf_(v[1])); o.y = pk2(v[2] * pg8::sigmoidf_(v[2]), v[3] * pg8::sigmoidf_(v[3]));
                        *(u32x2*)(YS + ((size_t)3 * M + t0 + wave * 8 + j) * 256 + c4) = o; }
                    __syncthreads();
                }
            }
        }
        SEAM(pb + 3);
        if (IN(pb + 4) && EN(5)) { WSP;
            pg8::Gemm g{YS, (const bf16*)(wsp + WS_WBR) + (size_t)l * 4 * 1024 * 256, 256}; pg8::SchedMerge S; S.init(G_, bid);
            pg8::EpiMerge E{Gt, MG}; pg8::gemm_phase<pg8::EpiMerge, pg8::SchedMerge, false, true>(F.lds, g, S, E, wave);
        }
        SEAM(pb + 4);
        if (IN(pb + 5) && EN(6)) { WSP;
            pg8::Gemm g{MG, (const bf16*)(wsp + WS_WOUT) + (size_t)l * 1024 * 1024, 1024}; pg8::SchedPlain S; S.init(M / 256, 4, 1024, G_, bid);
            pg8::EpiRes E{XRES, Tb}; pg8::gemm_phase<pg8::EpiRes, pg8::SchedPlain, false, true>(F.lds, g, S, E, wave);
        }
        SEAM(pb + 5);
        if (IN(pb + 6) && EN(7)) { WSP;
            const float* lg = INP(17) + l * DM; const float* lb = INP(18) + l * DM; const float* router = INP(22);
            LAS unsigned* lcnt = (LAS unsigned*)(F.lds + LDSCTL_OFF + 64);
            for (int blk = vcu; blk < 256; blk += G_) {
                if (moe) { if (tid < 8) lcnt[tid] = 0u; __syncthreads(); }
                for (int k = 0; k < 8; ++k) { const int t = blk * 64 + wave * 8 + k; f32x4 v[4];
#pragma unroll
                    for (int j = 0; j < 4; ++j) v[j] = *(const f32x4*)(Tb + (size_t)t * DM + 4 * lane + 256 * j);
                    ln_row(v, lg, lb, lane); store_row_f32(XRES + (size_t)t * DM, v, lane);
                    if (!moe) store_row_bf16(XB + (size_t)t * DM, v, lane);
                    else {
                        float lgt[8] = {0.f, 0.f, 0.f, 0.f, 0.f, 0.f, 0.f, 0.f};
#pragma unroll
                        for (int j = 0; j < 4; ++j)
#pragma unroll
                            for (int e4 = 0; e4 < 4; ++e4) { const float xv = v[j][e4]; const float* rr = router + (size_t)(4 * lane + 256 * j + e4) * 8; const f32x4 ra = *(const f32x4*)rr, rb = *(const f32x4*)(rr + 4);
                                lgt[0] += xv * ra[0]; lgt[1] += xv * ra[1]; lgt[2] += xv * ra[2]; lgt[3] += xv * ra[3]; lgt[4] += xv * rb[0]; lgt[5] += xv * rb[1]; lgt[6] += xv * rb[2]; lgt[7] += xv * rb[3]; }
#pragma unroll
                        for (int e = 0; e < 8; ++e) lgt[e] = wave_sum(lgt[e]);
                        int e0 = 0; float l0 = lgt[0];
#pragma unroll
                        for (int e = 1; e < 8; ++e) if (lgt[e] > l0) { l0 = lgt[e]; e0 = e; }
                        int e1 = -1; float l1 = -3.0e38f;
#pragma unroll
                        for (int e = 0; e < 8; ++e) if (e != e0 && lgt[e] > l1) { l1 = lgt[e]; e1 = e; }
                        const float ex = __expf(l1 - l0); const float w0 = 1.0f / (1.0f + ex), w1 = ex / (1.0f + ex);
                        if (lane == 0) { *(u32x4*)(ROUTE + (size_t)t * 4) = (u32x4){(unsigned)e0, (unsigned)e1, __float_as_uint(w0), __float_as_uint(w1)};
                            __hip_atomic_fetch_add(lcnt + e0, 1u, __ATOMIC_RELAXED, __HIP_MEMORY_SCOPE_WORKGROUP); __hip_atomic_fetch_add(lcnt + e1, 1u, __ATOMIC_RELAXED, __HIP_MEMORY_SCOPE_WORKGROUP); }
                    }
                }
                if (moe) { __syncthreads(); if (tid < 8) CNT[blk * 8 + tid] = lcnt[tid]; __syncthreads(); }
            }
        }
        SEAM(pb + 6);
        if (IN(pb + 7) && moe && EN(8)) { WSP;
            LAS float* scr = (LAS float*)(F.lds + wave * 16384);
            {
                const int per_e = (2 * D_FFE / 32) * 16, nit = NEXP * per_e;
                for (int it = gw; it < nit; it += NGW) { const int e = it / per_e, r = it % per_e, rb = r / 16, kb = r % 16; const int tile = rb >> 3, w = rb & 7;
                    cvt_item(((w < 4) ? INP(23) : INP(24)) + (size_t)e * 1024 * D_FFE, D_FFE, tile * 128 + (w & 3) * 32, kb * 64, false, (bf16*)(wsp + WS_MW13) + (size_t)e * 2 * D_FFE * 1024, 1024, rb * 32, scr, lane); }
            }
            __syncthreads();
            LAS unsigned* L = (LAS unsigned*)(F.lds + LDSCTL_OFF + 128);
            for (int blk = vcu; blk < 256; blk += G_) {
                if (tid < 16) L[tid] = 0u;
                __syncthreads();
                if (tid < 256) { const u32x4 c0 = *(const u32x4*)(CNT + tid * 8), c1 = *(const u32x4*)(CNT + tid * 8 + 4); const unsigned c[8] = {c0.x, c0.y, c0.z, c0.w, c1.x, c1.y, c1.z, c1.w};
#pragma unroll
                    for (int e = 0; e < 8; ++e) { __hip_atomic_fetch_add(L + e, c[e], __ATOMIC_RELAXED, __HIP_MEMORY_SCOPE_WORKGROUP); if (tid < blk) __hip_atomic_fetch_add(L + 8 + e, c[e], __ATOMIC_RELAXED, __HIP_MEMORY_SCOPE_WORKGROUP); } }
                __syncthreads();
                if (tid == 0) { unsigned off = 0; for (int e = 0; e < 8; ++e) { L[16 + e] = off; off += ((L[e] + 255u) >> 8) << 8; }
                    L[24] = off >> 8; }
                __syncthreads();
                if (blk == 0 && tid < MAXTILES) { unsigned e = 0;
#pragma unroll
                    for (unsigned k = 1; k < 8; ++k) if ((unsigned)tid >= (L[16 + k] >> 8) && L[k] > 0u) e = k;
                    ((unsigned char*)(META + 16))[tid] = (unsigned char)e; if (tid == 0) META[0] = L[24]; }
                if (wave == 0) { const int t = blk * 64 + lane; const u32x4 r = *(const u32x4*)(ROUTE + (size_t)t * 4); const int e0 = (int)r.x, e1 = (int)r.y; unsigned s0 = 0, s1 = 0;
                    const unsigned long long lt = (1ull << lane) - 1ull;
#pragma unroll
                    for (int e = 0; e < 8; ++e) { const unsigned long long m0 = __ballot(e0 == e), m1 = __ballot(e1 == e); const unsigned base = L[16 + e] + L[8 + e];
                        if (e0 == e) s0 = base + (unsigned)__popcll(m0 & lt); if (e1 == e) s1 = base + (unsigned)__popcll(m0) + (unsigned)__popcll(m1 & lt); }
                    L[32 + 2 * lane] = s0; L[33 + 2 * lane] = s1; *(u32x2*)(SLOT + (size_t)t * 2) = (u32x2){s0, s1}; }
                __syncthreads();
                for (int k = 0; k < 8; ++k) { const int tl = wave * 8 + k, t = blk * 64 + tl; const unsigned s0 = L[32 + 2 * tl], s1 = L[33 + 2 * tl];
                    bf16* d0 = (bf16*)(wsp + WS_XG) + (size_t)s0 * DM, *d1 = (bf16*)(wsp + WS_XG) + (size_t)s1 * DM;
#pragma unroll
                    for (int j = 0; j < 4; ++j) { const f32x4 v = *(const f32x4*)(XRES + (size_t)t * DM + 4 * lane + 256 * j); u32x2 w; w.x = pk2(v[0], v[1]); w.y = pk2(v[2], v[3]);
                        *(u32x2*)(d0 + 4 * lane + 256 * j) = w; *(u32x2*)(d1 + 4 * lane + 256 * j) = w; } }
                __syncthreads();
            }
        }
        if (moe) SEAM(pb + 7);
        if (IN(pb + 8) && EN(9)) { WSP;
            LAS unsigned char* te = F.lds + LDSCTL_OFF + 1024;
            int ntiles = M / 256;
            if (moe) { ntiles = (int)__hip_atomic_load(META, __ATOMIC_RELAXED, __HIP_MEMORY_SCOPE_AGENT); ntiles = ntiles > MAXTILES ? MAXTILES : ntiles; if (tid < MAXTILES) te[tid] = ((const unsigned char*)(META + 16))[tid]; }
            else { if (tid < MAXTILES) te[tid] = 0; }
            __syncthreads();
            ntiles = __builtin_amdgcn_readfirstlane(ntiles);
            if (!moe) { pg8::Gemm g{XB, (const bf16*)(wsp + WS_W13), 1024}; pg8::SchedGroup S; S.init(ntiles, 2 * D_FF / 256, 1024, G_, bid, te);
                pg8::EpiSwiGLU E{(bf16*)(wsp + WS_HID0), D_FF}; pg8::gemm_phase<pg8::EpiSwiGLU, pg8::SchedGroup, true, true>(F.lds, g, S, E, wave); }
            else { pg8::Gemm g{(const bf16*)(wsp + WS_XG), (const bf16*)(wsp + WS_MW13), 1024}; pg8::SchedGroup S; S.init(ntiles, 2 * D_FFE / 256, 1024, G_, bid, te);
                pg8::EpiSwiGLU E{(bf16*)(wsp + WS_MHID), D_FFE}; pg8::gemm_phase<pg8::EpiSwiGLU, pg8::SchedGroup, true, true>(F.lds, g, S, E, wave); }
        }
        SEAM(pb + 8);
        if (IN(pb + 9) && moe && EN(10)) { WSP;
            LAS float* scr = (LAS float*)(F.lds + wave * 16384);
            const int per_e = 32 * (D_FFE / 64), nit = NEXP * per_e;
            for (int it = gw; it < nit; it += NGW) { const int e = it / per_e, r = it % per_e, rb = r / (D_FFE / 64), kb = r % (D_FFE / 64);
                cvt_item(INP(25) + (size_t)e * D_FFE * 1024, 1024, rb * 32, kb * 64, false, (bf16*)(wsp + WS_MW2) + (size_t)e * 1024 * D_FFE, D_FFE, rb * 32, scr, lane); }
        }
        if (moe) SEAM(pb + 9);
        if (IN(pb + 10) && EN(11)) { WSP;
            LAS unsigned char* te = F.lds + LDSCTL_OFF + 1024;
            if (!moe) { pg8::Gemm g{(const bf16*)(wsp + WS_HID0), (const bf16*)(wsp + WS_W2), D_FF}; pg8::SchedPlain S; S.init(M / 256, 4, D_FF, G_, bid);
                pg8::EpiRes E{XRES, Tb}; pg8::gemm_phase<pg8::EpiRes, pg8::SchedPlain, false, true>(F.lds, g, S, E, wave); }
            else { int ntiles = (int)__hip_atomic_load(META, __ATOMIC_RELAXED, __HIP_MEMORY_SCOPE_AGENT); ntiles = ntiles > MAXTILES ? MAXTILES : ntiles; if (tid < MAXTILES) te[tid] = ((const unsigned char*)(META + 16))[tid];
                __syncthreads(); ntiles = __builtin_amdgcn_readfirstlane(ntiles);
                pg8::Gemm g{(const bf16*)(wsp + WS_MHID), (const bf16*)(wsp + WS_MW2), D_FFE}; pg8::SchedGroup S; S.init(ntiles, 4, D_FFE, G_, bid, te);
                pg8::EpiO E{(bf16*)(wsp + WS_XG)}; pg8::gemm_phase<pg8::EpiO, pg8::SchedGroup, true, true>(F.lds, g, S, E, wave); }
        }
        SEAM(pb + 10);
        if (IN(pb + 11) && EN(12)) { WSP;
            const float* lg = INP(26) + l * DM; const float* lb = INP(27) + l * DM; const bool last = (l == DEPTH - 1);
            const bf16* Ob = (const bf16*)(wsp + WS_XG);
            for (int t = gw; t < M; t += NGW) { f32x4 v[4];
                if (!moe) {
#pragma unroll
                    for (int j = 0; j < 4; ++j) v[j] = *(const f32x4*)(Tb + (size_t)t * DM + 4 * lane + 256 * j);
                } else { const u32x4 r = *(const u32x4*)(ROUTE + (size_t)t * 4); const u32x2 sl = *(const u32x2*)(SLOT + (size_t)t * 2); const float w0 = __uint_as_float(r.z), w1 = __uint_as_float(r.w);
#pragma unroll
                    for (int j = 0; j < 4; ++j) { const f32x4 xv = *(const f32x4*)(XRES + (size_t)t * DM + 4 * lane + 256 * j);
                        const u32x2 a = *(const u32x2*)(Ob + (size_t)sl.x * DM + 4 * lane + 256 * j), b = *(const u32x2*)(Ob + (size_t)sl.y * DM + 4 * lane + 256 * j);
                        v[j][0] = xv[0] * ALPHA + w0 * pg8::bf_lo(a.x) + w1 * pg8::bf_lo(b.x); v[j][1] = xv[1] * ALPHA + w0 * pg8::bf_hi(a.x) + w1 * pg8::bf_hi(b.x);
                        v[j][2] = xv[2] * ALPHA + w0 * pg8::bf_lo(a.y) + w1 * pg8::bf_lo(b.y); v[j][3] = xv[3] * ALPHA + w0 * pg8::bf_hi(a.y) + w1 * pg8::bf_hi(b.y); } }
                ln_row(v, lg, lb, lane);
#if DBG_ZROWS
                if (last && (DBG_ZCOND)) { v[0] = f32x4{}; v[1] = f32x4{}; v[2] = f32x4{}; v[3] = f32x4{}; }
#endif
                if (last) store_row_f32(((float*)INP(28)) + (size_t)t * DM, v, lane);
                else { store_row_f32(XRES + (size_t)t * DM, v, lane); store_row_bf16(XB + (size_t)t * DM, v, lane); } }
        }
        SEAM(pb + 11);
    }
#undef IN
#undef SEAM
}


#if DBG_CHK
#undef XRES
#undef XB
#undef Hb
#undef Gt
#undef Tb
#undef QA
#undef KA
#undef CQN
#undef CKVN
#undef QC
#undef KC
#undef VC
#undef MG
#undef YS
#undef ROUTE
#undef SLOT
#undef CNT
#undef META
namespace chk {
__device__ __forceinline__ float b2f(bf16 v) { return __uint_as_float(((unsigned)v) << 16); }
__device__ __forceinline__ float rbf(float f) { unsigned u = __float_as_uint(f); u = (u + 0x7fffu + ((u >> 16) & 1u)) & 0xffff0000u; return __uint_as_float(u); }
__device__ __forceinline__ float sg(float x) { return 1.0f / (1.0f + expf(-x)); }
__device__ __forceinline__ void rec(unsigned* met, int k, float err) { if (!(err == err)) err = 1e30f; atomicMax(met + k, __float_as_uint(fabsf(err))); }
__device__ __forceinline__ int srow(int i) { return 16 * i + ((i * 5) & 15); }
__device__ __forceinline__ float bsum(float v, float* sh) { const int t = threadIdx.x; __syncthreads(); sh[t] = v; __syncthreads(); for (int s = 128; s > 0; s >>= 1) { if (t < s) sh[t] += sh[t + s]; __syncthreads(); } const float r = sh[0]; __syncthreads(); return r; }
__device__ __forceinline__ float bmax(float v, float* sh) { const int t = threadIdx.x; __syncthreads(); sh[t] = v; __syncthreads(); for (int s = 128; s > 0; s >>= 1) { if (t < s) sh[t] = fmaxf(sh[t], sh[t + s]); __syncthreads(); } const float r = sh[0]; __syncthreads(); return r; }
}
__global__ void __launch_bounds__(256) chk_kernel(Args args, int l, int which) {
    using namespace chk;
    __shared__ float sh[256]; __shared__ float sc[2048]; __shared__ float rowbuf[1024];
    unsigned char* ws = args.ws; unsigned* met = (unsigned*)(ws + WS_CTL) + 1024;
    const int tid = threadIdx.x, t = srow(blockIdx.x), s = t & (SEQ - 1), b0 = t - s;
    const bf16* XB = (const bf16*)(ws + WS_XB); const float* XRES = (const float*)(ws + WS_XRES); const bf16* H = (const bf16*)(ws + WS_H); const bf16* G = (const bf16*)(ws + WS_G);
    const float* T = (const float*)(ws + WS_T); const bf16* QA = (const bf16*)(ws + WS_QA); const bf16* KA = (const bf16*)(ws + WS_KA); const bf16* CQN = (const bf16*)(ws + WS_CQN); const bf16* CKVN = (const bf16*)(ws + WS_CKVN);
    const bf16* QC = (const bf16*)(ws + WS_QC); const bf16* KC = (const bf16*)(ws + WS_KC); const bf16* VC = (const bf16*)(ws + WS_VC); const bf16* MG = (const bf16*)(ws + WS_MG); const bf16* YS = (const bf16*)(ws + WS_YS);
    const bf16* HID0 = (const bf16*)(ws + WS_HID0);
#define in args.in
    float worst = 0.f;
    if (which == 2) {
        const float* w = in[3] + (size_t)l * 1024 * D_IN;
        for (int i = tid; i < 1024; i += 256) rowbuf[i] = b2f(XB[(size_t)t * DM + i]);
        __syncthreads();
        for (int c = tid; c < D_IN; c += 256) {
            if (c >= OFF_GLU + 256 && c < OFF_GATE) continue;
            float h = 0.f; for (int k = 0; k < 1024; ++k) h += rowbuf[k] * rbf(w[(size_t)k * D_IN + c]);
            float ref, got;
            if (c < 1280) { ref = (c >= 512 && c < 768) ? h * QS64 : h; got = b2f(H[(size_t)t * HP + c]); }
            else if (c < OFF_CKV) { ref = h; got = b2f(H[(size_t)t * HP + 1280 + (c - OFF_CQ)]); }
            else if (c < OFF_KPE) { ref = h; got = b2f(H[(size_t)t * HP + 1536 + (c - OFF_CKV)]); }
            else if (c < OFF_GLU) { ref = h; got = b2f(H[(size_t)t * HP + 1664 + (c - OFF_KPE)]); }
            else if (c < OFF_GLU + 256) { float g2 = 0.f; for (int k = 0; k < 1024; ++k) g2 += rowbuf[k] * rbf(w[(size_t)k * D_IN + c + 256]); ref = h * sg(g2); got = b2f(H[(size_t)t * HP + 1792 + (c - OFF_GLU)]); }
            else { ref = sg(h); got = b2f(G[(size_t)t * 4096 + (c - OFF_GATE)]); }
            const float er_ = fabsf(ref - got) / (0.05f + fabsf(ref)); worst = fmaxf(worst, er_);
            if (l == 0 && er_ > DBG_TOL) atomicMax(met + 100, 0xFFFFFFFFu - ((unsigned)blockIdx.x * 8192u + (unsigned)c));
            if (l == 0 && er_ > DBG_TOL) { atomicMax(met + 103, (unsigned)c); atomicAdd(met + (c < OFF_GATE ? 104 : 105), 1u); }
        }
        { const float wm = bmax(worst, sh); if (l == 0 && tid == 0 && wm > DBG_TOL) { atomicAdd(met + 101, 1u); atomicMax(met + 102, (unsigned)blockIdx.x); } rec(met + 32 * l, 2, wm); }
    } else if (which == 3) {
        const float* aqn = in[4] + l * 64; const float* akn = in[5] + l * 64; const float* cqn = in[7] + l * 192; const float* ckvn = in[8] + l * 128;
        const float row = (float)(s / GRIDW), col = (float)(s % GRIDW);
        for (int i = tid; i < 256 + 128; i += 256) { const bool isq = i < 256; const int hd = isq ? i / 64 : (i - 256) / 64, d = i % 64; const bf16* src = H + (size_t)t * HP + (isq ? 0 : 256) + hd * 64;
            float ss = 0.f; for (int k = 0; k < 64; ++k) { const float v = b2f(src[k]); ss += v * v; } const float rs = 1.0f / sqrtf(ss / 64.f + 1e-6f); const float* gn = isq ? aqn : akn;
            const int p = d >> 1; const float inv = powf(10000.f, -(float)(p & 15) / 16.f); const float ang = (p < 16 ? row : col) * inv; const float c_ = cosf(ang), s_ = sinf(ang);
            const float x1 = b2f(src[2 * p]) * rs * gn[2 * p], x2 = b2f(src[2 * p + 1]) * rs * gn[2 * p + 1]; float ref = (d & 1) ? (x1 * s_ + x2 * c_) : (x1 * c_ - x2 * s_); if (isq) ref *= QS64;
            const float got = isq ? b2f(QA[(size_t)t * 256 + i]) : b2f(KA[(size_t)t * 128 + (i - 256)]); worst = fmaxf(worst, fabsf(ref - got) / (0.05f + fabsf(ref))); }
        for (int i = tid; i < 256; i += 256) { float ss = 0.f; for (int k = 0; k < 192; ++k) { const float v = b2f(H[(size_t)t * HP + 1280 + k]); ss += v * v; } const float rs = 1.0f / sqrtf(ss / 192.f + 1e-6f);
            const float ref = i < 192 ? b2f(H[(size_t)t * HP + 1280 + i]) * rs * cqn[i] : 0.f; worst = fmaxf(worst, fabsf(ref - b2f(CQN[(size_t)t * 256 + i])) / (0.05f + fabsf(ref)));
            float s2 = 0.f; for (int k = 0; k < 128; ++k) { const float v = b2f(H[(size_t)t * HP + 1536 + k]); s2 += v * v; } const float r2 = 1.0f / sqrtf(s2 / 128.f + 1e-6f);
            const float ref2 = i < 128 ? b2f(H[(size_t)t * HP + 1536 + i]) * r2 * ckvn[i] : 0.f; worst = fmaxf(worst, fabsf(ref2 - b2f(CKVN[(size_t)t * 256 + i])) / (0.05f + fabsf(ref2))); }
        for (int i = tid; i < 128; i += 256) { const int hh = i / 32, d = i % 32, p = d >> 1; const float inv = powf(10000.f, -(float)(p & 7) / 8.f); const float ang = (p < 8 ? row : col) * inv; const float c_ = cosf(ang), s_ = sinf(ang);
            const float x1 = b2f(H[(size_t)t * HP + 1664 + 2 * p]), x2 = b2f(H[(size_t)t * HP + 1664 + 2 * p + 1]); const float ref = (d & 1) ? (x1 * s_ + x2 * c_) : (x1 * c_ - x2 * s_);
            worst = fmaxf(worst, fabsf(ref - b2f(KC[(size_t)t * 384 + hh * 96 + 64 + d])) / (0.05f + fabsf(ref))); }
        rec(met + 32 * l, 3, bmax(worst, sh));
    } else if (which == 4) {
        const float* wq = in[9] + (size_t)l * 192 * 384; const float* wkv = in[10] + (size_t)l * 128 * 512; const float row = (float)(s / GRIDW), col = (float)(s % GRIDW);
        for (int i = tid; i < 384; i += 256) sc[i] = 0.f; __syncthreads();
        for (int c = tid; c < 384; c += 256) { float a = 0.f; for (int k = 0; k < 192; ++k) a += b2f(CQN[(size_t)t * 256 + k]) * rbf(wq[(size_t)k * 384 + c]); sc[c] = a; }
        __syncthreads();
        for (int c = tid; c < 384; c += 256) { const int j = c % 96; float ref;
            if (j < 64) ref = sc[c]; else { const int d = j - 64, p = d >> 1; const float inv = powf(10000.f, -(float)(p & 7) / 8.f); const float ang = (p < 8 ? row : col) * inv; const float c_ = cosf(ang), s_ = sinf(ang);
                const float x1 = sc[c - d + 2 * p], x2 = sc[c - d + 2 * p + 1]; ref = (d & 1) ? (x1 * s_ + x2 * c_) : (x1 * c_ - x2 * s_); }
            ref *= QS96; worst = fmaxf(worst, fabsf(ref - b2f(QC[(size_t)t * 384 + c])) / (0.05f + fabsf(ref))); }
        for (int c = tid; c < 512; c += 256) { float a = 0.f; for (int k = 0; k < 128; ++k) a += b2f(CKVN[(size_t)t * 256 + k]) * rbf(wkv[(size_t)k * 512 + c]); const int hh = c / 128, j = c % 128;
            const float got = j < 64 ? b2f(KC[(size_t)t * 384 + hh * 96 + j]) : b2f(VC[(size_t)t * 256 + hh * 64 + (j - 64)]); worst = fmaxf(worst, fabsf(a - got) / (0.05f + fabsf(a))); }
        rec(met + 32 * l, 4, bmax(worst, sh));
    } else if (which == 5 || which == 6) {
        const bool isA = which == 5; const int DK = isA ? 64 : 96;
        for (int hh = 0; hh < 4; ++hh) {
            const bf16* q = isA ? QA + (size_t)t * 256 + hh * 64 : QC + (size_t)t * 384 + hh * 96;
            for (int k = tid; k < SEQ; k += 256) { const bf16* kp = isA ? KA + (size_t)(b0 + k) * 128 + (hh >> 1) * 64 : KC + (size_t)(b0 + k) * 384 + hh * 96; float a = 0.f; for (int d = 0; d < DK; ++d) a += b2f(q[d]) * b2f(kp[d]); sc[k] = a; }
            __syncthreads();
            float mx = -1e30f; for (int k = tid; k < SEQ; k += 256) mx = fmaxf(mx, sc[k]); mx = bmax(mx, sh);
            float sm = 0.f; for (int k = tid; k < SEQ; k += 256) { sc[k] = exp2f(sc[k] - mx); sm += sc[k]; } sm = bsum(sm, sh);
            if (tid < 64) { float o = 0.f; for (int k = 0; k < SEQ; ++k) { const float v = isA ? b2f(H[(size_t)(b0 + k) * HP + OFF_AV + (hh >> 1) * 64 + tid]) : b2f(VC[(size_t)(b0 + k) * 256 + hh * 64 + tid]); o += sc[k] * v; } o /= sm;
                const float got = b2f(YS[((size_t)(isA ? 0 : 2) * M + t) * 256 + hh * 64 + tid]); worst = fmaxf(worst, fabsf(o - got) / (0.01f + fabsf(o))); }
            __syncthreads();
        }
        rec(met + 32 * l, which, bmax(worst, sh));
    } else if (which == 7) {
        const int r = s / GRIDW, c = s % GRIDW; int rs = r - 4; rs = rs < 0 ? 0 : (rs > NROWS - 8 ? NROWS - 8 : rs); int cs = c - 8; cs = cs < 0 ? 0 : (cs > GRIDW - 16 ? GRIDW - 16 : cs);
        for (int hh = 0; hh < 4; ++hh) { const float* rpb = in[6] + ((size_t)l * 4 + hh) * 15 * 31; const bf16* q = H + (size_t)t * HP + OFF_BQ + hh * 64;
            if (tid < 128) { const int kr = rs + tid / 16, kc = cs + tid % 16; const bf16* kp = H + (size_t)(b0 + kr * GRIDW + kc) * HP + OFF_BK + hh * 64; float a = 0.f; for (int d = 0; d < 64; ++d) a += b2f(q[d]) * b2f(kp[d]);
                int dc = kc - c + 15; dc = dc < 0 ? 0 : (dc > 30 ? 30 : dc); sc[tid] = a + rpb[(kr - r + 7) * 31 + dc] * LOG2E; }
            __syncthreads();
            float mx = -1e30f; if (tid < 128) mx = sc[tid]; mx = bmax(mx, sh); float sm = 0.f; if (tid < 128) { sc[tid] = exp2f(sc[tid] - mx); sm = sc[tid]; } sm = bsum(sm, sh);
            if (tid < 64) { float o = 0.f; for (int k = 0; k < 128; ++k) { const int kr = rs + k / 16, kc = cs + k % 16; o += sc[k] * b2f(H[(size_t)(b0 + kr * GRIDW + kc) * HP + OFF_BV + hh * 64 + tid]); } o /= sm;
                const float got = b2f(YS[((size_t)1 * M + t) * 256 + hh * 64 + tid]); worst = fmaxf(worst, fabsf(o - got) / (0.05f + fabsf(o))); }
            __syncthreads(); }
        rec(met + 32 * l, 7, bmax(worst, sh));
    } else if (which == 8) {
        const float* cw = in[11] + (size_t)l * 31 * 256; float a = in[12][l * 256 + tid];
        for (int k = 0; k < 31; ++k) { const int s2 = s + k - 15; if (s2 >= 0 && s2 < SEQ) a += cw[k * 256 + tid] * b2f(H[(size_t)(b0 + s2) * HP + 1792 + tid]); }
        const float mean = bsum(a, sh) / 256.f; const float dv = a - mean; const float var = bsum(dv * dv, sh) / 256.f; const float y = dv / sqrtf(var + 1e-5f) * in[13][l * 256 + tid] + in[14][l * 256 + tid]; const float ref = y * sg(y);
        worst = fabsf(ref - b2f(YS[((size_t)3 * M + t) * 256 + tid])) / (0.05f + fabsf(ref)); rec(met + 32 * l, 8, bmax(worst, sh));
    } else if (which == 9) {
        const float* wb = in[15] + (size_t)l * 4 * 256 * 1024;
        for (int d = tid; d < 1024; d += 256) { float m = 0.f; for (int n = 0; n < 4; ++n) { float a = 0.f; for (int c = 0; c < 256; ++c) a += b2f(YS[((size_t)n * M + t) * 256 + c]) * rbf(wb[((size_t)n * 256 + c) * 1024 + d]); m += b2f(G[(size_t)t * 4096 + n * 1024 + d]) * a; }
            worst = fmaxf(worst, fabsf(m - b2f(MG[(size_t)t * DM + d])) / (0.02f + fabsf(m))); }
        rec(met + 32 * l, 9, bmax(worst, sh));
    } else if (which == 10) {
        const float* wo = in[16] + (size_t)l * 1024 * 1024;
        for (int d = tid; d < 1024; d += 256) { float a = 0.f; for (int k = 0; k < 1024; ++k) a += b2f(MG[(size_t)t * DM + k]) * rbf(wo[(size_t)k * 1024 + d]); const float ref = ALPHA * XRES[(size_t)t * DM + d] + a;
            worst = fmaxf(worst, fabsf(ref - T[(size_t)t * DM + d]) / (0.05f + fabsf(ref))); }
        rec(met + 32 * l, 10, bmax(worst, sh));
    } else if (which == 11 || which == 14) {
        const float* g = (which == 11 ? in[17] : in[26]) + l * DM; const float* bb = (which == 11 ? in[18] : in[27]) + l * DM;
        float sm = 0.f; for (int d = tid; d < 1024; d += 256) sm += T[(size_t)t * DM + d]; const float mean = bsum(sm, sh) / 1024.f; float vq = 0.f; for (int d = tid; d < 1024; d += 256) { const float dv = T[(size_t)t * DM + d] - mean; vq += dv * dv; }
        const float rstd = 1.0f / sqrtf(bsum(vq, sh) / 1024.f + 1e-5f);
        for (int d = tid; d < 1024; d += 256) { const float ref = (T[(size_t)t * DM + d] - mean) * rstd * g[d] + bb[d]; worst = fmaxf(worst, fabsf(ref - XRES[(size_t)t * DM + d]) / (0.05f + fabsf(ref))); }
        rec(met + 32 * l, which, bmax(worst, sh));
    } else if (which == 12) {
        for (int j = tid; j < D_FF; j += 256) { float a = 0.f, b = 0.f; for (int k = 0; k < 1024; ++k) { const float xv = b2f(XB[(size_t)t * DM + k]); a += xv * rbf(in[19][(size_t)k * D_FF + j]); b += xv * rbf(in[20][(size_t)k * D_FF + j]); }
            const float ref = a * sg(a) * b; worst = fmaxf(worst, fabsf(ref - b2f(HID0[(size_t)t * D_FF + j])) / (0.05f + fabsf(ref))); }
        rec(met + 32 * l, 12, bmax(worst, sh));
    } else if (which == 13) {
        for (int d = tid; d < 1024; d += 256) { float a = 0.f; for (int j = 0; j < D_FF; ++j) a += b2f(HID0[(size_t)t * D_FF + j]) * rbf(in[21][(size_t)j * 1024 + d]); const float ref = ALPHA * XRES[(size_t)t * DM + d] + a;
            worst = fmaxf(worst, fabsf(ref - T[(size_t)t * DM + d]) / (0.05f + fabsf(ref))); }
        rec(met + 32 * l, 13, bmax(worst, sh));
    } else if (which == 1) {
        const float* x = in[0] + (size_t)t * DM; float sm = 0.f; for (int d = tid; d < 1024; d += 256) sm += x[d]; const float mean = bsum(sm, sh) / 1024.f; float vq = 0.f; for (int d = tid; d < 1024; d += 256) { const float dv = x[d] - mean; vq += dv * dv; }
        const float rstd = 1.0f / sqrtf(bsum(vq, sh) / 1024.f + 1e-5f);
        for (int d = tid; d < 1024; d += 256) { const float ref = (x[d] - mean) * rstd * in[1][d] + in[2][d]; worst = fmaxf(worst, fabsf(ref - XRES[(size_t)t * DM + d]) / (0.05f + fabsf(ref))); worst = fmaxf(worst, fabsf(ref - b2f(XB[(size_t)t * DM + d])) / (0.05f + fabsf(ref))); }
        rec(met + 32 * l, 1, bmax(worst, sh));
    } else if (which >= 20) {
        const unsigned* ROUTE = (const unsigned*)(ws + WS_ROUTE); const unsigned* SLOT = (const unsigned*)(ws + WS_SLOT); const unsigned* META = (const unsigned*)(ws + WS_META);
        const int e0 = (int)ROUTE[t * 4], e1 = (int)ROUTE[t * 4 + 1]; const float w0 = __uint_as_float(ROUTE[t * 4 + 2]), w1 = __uint_as_float(ROUTE[t * 4 + 3]); const unsigned s0 = SLOT[t * 2], s1 = SLOT[t * 2 + 1];
        const bf16* XG = (const bf16*)(ws + WS_XG); const bf16* MH = (const bf16*)(ws + WS_MHID);
        if (which == 20) { __shared__ float lg[8]; for (int e = 0; e < 8; ++e) { float a = 0.f; for (int d = tid; d < 1024; d += 256) a += XRES[(size_t)t * DM + d] * in[22][(size_t)d * 8 + e]; a = bsum(a, sh); if (tid == 0) lg[e] = a; }
            __syncthreads(); if (tid == 0) { int b0_ = 0; for (int e = 1; e < 8; ++e) if (lg[e] > lg[b0_]) b0_ = e; int b1_ = -1; for (int e = 0; e < 8; ++e) if (e != b0_ && (b1_ < 0 || lg[e] > lg[b1_])) b1_ = e;
                const float m0 = expf(lg[b0_] - lg[b0_]), m1 = expf(lg[b1_] - lg[b0_]); float er = (b0_ != e0 || b1_ != e1) ? 1.0f : 0.f; er = fmaxf(er, fabsf(m0 / (m0 + m1) - w0)); er = fmaxf(er, fabsf(m1 / (m0 + m1) - w1));
                const unsigned te0 = ((const unsigned char*)(META + 16))[s0 >> 8], te1 = ((const unsigned char*)(META + 16))[s1 >> 8]; if ((int)te0 != e0 || (int)te1 != e1 || s0 >= META[0] * 256 || s1 >= META[0] * 256) er = 2.0f; worst = er; } }
        else if (which == 21) { for (int d = tid; d < 1024; d += 256) { const float ref = rbf(XRES[(size_t)t * DM + d]); worst = fmaxf(worst, fabsf(ref - b2f(XG[(size_t)s0 * DM + d]))); worst = fmaxf(worst, fabsf(ref - b2f(XG[(size_t)s1 * DM + d]))); } }
        else if (which == 22) { for (int q = 0; q < 2; ++q) { const int e = q ? e1 : e0; const unsigned sl = q ? s1 : s0; const float* w1p = in[23] + (size_t)e * 1024 * D_FFE; const float* w3p = in[24] + (size_t)e * 1024 * D_FFE;
                for (int j = tid; j < D_FFE; j += 256) { float a = 0.f, b = 0.f; for (int k = 0; k < 1024; ++k) { const float xv = b2f(XG[(size_t)sl * DM + k]); a += xv * rbf(w1p[(size_t)k * D_FFE + j]); b += xv * rbf(w3p[(size_t)k * D_FFE + j]); }
                    const float ref = a * sg(a) * b; worst = fmaxf(worst, fabsf(ref - b2f(MH[(size_t)sl * D_FFE + j])) / (0.05f + fabsf(ref))); } } }
        else if (which == 23) { for (int q = 0; q < 2; ++q) { const int e = q ? e1 : e0; const unsigned sl = q ? s1 : s0; const float* w2p = in[25] + (size_t)e * D_FFE * 1024;
                for (int d = tid; d < 1024; d += 256) { float a = 0.f; for (int j = 0; j < D_FFE; ++j) a += b2f(MH[(size_t)sl * D_FFE + j]) * rbf(w2p[(size_t)j * 1024 + d]); worst = fmaxf(worst, fabsf(a - b2f(XG[(size_t)sl * DM + d])) / (0.02f + fabsf(a))); } } }
        else if (which == 24) { for (int d = tid; d < 1024; d += 256) rowbuf[d] = ALPHA * XRES[(size_t)t * DM + d] + w0 * b2f(XG[(size_t)s0 * DM + d]) + w1 * b2f(XG[(size_t)s1 * DM + d]); __syncthreads();
            float sm = 0.f; for (int d = tid; d < 1024; d += 256) sm += rowbuf[d]; const float mean = bsum(sm, sh) / 1024.f; float vq = 0.f; for (int d = tid; d < 1024; d += 256) { const float dv = rowbuf[d] - mean; vq += dv * dv; } const float rstd = 1.0f / sqrtf(bsum(vq, sh) / 1024.f + 1e-5f);
            for (int d = tid; d < 1024; d += 256) { const float ref = (rowbuf[d] - mean) * rstd * in[26][l * DM + d] + in[27][l * DM + d]; worst = fmaxf(worst, fabsf(ref - args.out[(size_t)t * DM + d]) / (0.05f + fabsf(ref))); } }
        rec(met + 32 * l, which, bmax(worst, sh));
    }
}
#undef in
__global__ void chk_report(Args args) {
    const unsigned* met = (const unsigned*)(args.ws + WS_CTL) + 1024;
#if DBG_REPORT == 0
    int bad = -1;
    for (int k = 0; k < 64; ++k) { const float v = __uint_as_float(met[k]); if (v > DBG_TOL) { bad = k; break; } }
    if (bad >= 0) args.out[0] = 100.0f + 10.0f * (float)bad;
#elif DBG_REPORT == 1
    int mask = 0; for (int k = 0; k < 4; ++k) if (__uint_as_float(met[DBG_K0 + k]) > DBG_TOL) mask |= 1 << k;
    args.out[0] = 100.0f + 10.0f * (float)mask;
#elif DBG_REPORT == 7
    args.out[0] = 100.0f + 10.0f * (float)(met[101] >> 4);
#elif DBG_REPORT == 8
    args.out[0] = 100.0f + 10.0f * (float)(met[102] >> 5);
#elif DBG_REPORT == 9
    args.out[0] = 100.0f + 10.0f * (float)(met[102] & 31u);
#elif DBG_REPORT == 10
    args.out[0] = 100.0f + 10.0f * (float)(met[103] >> 8);
#elif DBG_REPORT == 11
    args.out[0] = 100.0f + 10.0f * (float)(met[104] > 60u ? 60u : met[104]);
#elif DBG_REPORT == 12
    { unsigned v = met[105] >> 8; args.out[0] = 100.0f + 10.0f * (float)(v > 80u ? 80u : v); }
#elif DBG_REPORT == 13
    { const unsigned key = 0xFFFFFFFFu - met[100]; args.out[0] = 100.0f + 10.0f * (float)(key & 7u); }
#elif DBG_REPORT == 3
    { const unsigned key = 0xFFFFFFFFu - met[100]; args.out[0] = 100.0f + 10.0f * (float)((key >> 13) >> 5); }
#elif DBG_REPORT == 4
    { const unsigned key = 0xFFFFFFFFu - met[100]; args.out[0] = 100.0f + 10.0f * (float)((key >> 13) & 31u); }
#elif DBG_REPORT == 5
    { const unsigned key = 0xFFFFFFFFu - met[100]; args.out[0] = 100.0f + 10.0f * (float)((key & 8191u) >> 8); }
#elif DBG_REPORT == 6
    { const unsigned key = 0xFFFFFFFFu - met[100]; args.out[0] = 100.0f + 10.0f * (float)(((key & 8191u) >> 3) & 31u); }
#else
    float v = __uint_as_float(met[DBG_K0]) * 100.0f; v = v > 9000.f ? 9000.f : v; args.out[0] = 10.0f + v;
#endif
}
#endif

extern "C" void kernel_launch(void* const* d_in, const int* in_sizes, int n_in, void* d_out, int out_size, void* d_ws, size_t ws_size, hipStream_t stream) {
    static int grid = 0;
    if (grid == 0) {
        if (n_in != 28 || in_sizes[0] != M * DM || out_size != M * DM || ws_size < WS_END) { fprintf(stderr, "kernel_launch: unexpected shapes (n_in %d, in0 %d, out %d, ws %zu, need %zu); nothing launched\n", n_in, n_in > 0 ? in_sizes[0] : -1, out_size, ws_size, (size_t)WS_END); grid = -1; return; }
        int dev = 0, cus = 0, per_cu = 0;
        if (hipGetDevice(&dev) != hipSuccess || hipDeviceGetAttribute(&cus, hipDeviceAttributeMultiprocessorCount, dev) != hipSuccess) { grid = -1; return; }
        if (hipFuncSetAttribute((const void*)fwd, hipFuncAttributeMaxDynamicSharedMemorySize, LDS_BYTES) != hipSuccess) { fprintf(stderr, "kernel_launch: hipFuncSetAttribute failed\n"); grid = -1; return; }
        if (hipOccupancyMaxActiveBlocksPerMultiprocessor(&per_cu, (const void*)fwd, NWAVES * 64, LDS_BYTES) != hipSuccess || per_cu < 1) fprintf(stderr, "kernel_launch: occupancy query reports %d\n", per_cu);
        (void)hipGetLastError();
        grid = cus;
    }
    if (grid < 0) return;
    (void)hipMemsetAsync((char*)d_ws + WS_CTL, 0, CTL_ZERO_BYTES, stream);
    Args a{};
    for (int i = 0; i < 28; ++i) a.in[i] = (const float*)d_in[i];
    a.out = (float*)d_out; a.ws = (unsigned char*)d_ws;
#if MK_ONE_LAUNCH
    a.ph_lo = 0; a.ph_hi = 1 + PH_PER_LAYER + 12;
    hipLaunchKernelGGL(fwd, dim3(grid), dim3(NWAVES * 64), LDS_BYTES, stream, a);
#else
    for (int p = 0; p < N_PHASES; ++p) {
        const int r = (p - 1) % PH_PER_LAYER, l = (p - 1) / PH_PER_LAYER;
        if (p > 0 && (r > 11 || ((l & 1) == 0 && (r == 7 || r == 9)))) continue;
        a.ph_lo = p; a.ph_hi = p + 1;
        hipLaunchKernelGGL(fwd, dim3(grid), dim3(NWAVES * 64), LDS_BYTES, stream, a);
#if DBG_CHK
        {   const bool moe_ = (l & 1) != 0;
#define CHK(w) hipLaunchKernelGGL(chk_kernel, dim3(1024), dim3(256), 0, stream, a, l, (w))
            if (p == 0) { const int l = 0; CHK(1); }
            else if (r == 0) CHK(2); else if (r == 1) CHK(3); else if (r == 2) CHK(4); else if (r == 3) { CHK(5); CHK(6); CHK(7); CHK(8); } else if (r == 4) CHK(9); else if (r == 5) CHK(10); else if (r == 6) CHK(11);
            else if (r == 7 && moe_) { CHK(20); CHK(21); } else if (r == 8) { if (moe_) CHK(22); else CHK(12); } else if (r == 10) { if (moe_) CHK(23); else CHK(13); } else if (r == 11) { if (moe_) CHK(24); else CHK(14); }
#undef CHK
        }
#endif
    }
#if DBG_CHK
    hipLaunchKernelGGL(chk_report, dim3(1), dim3(1), 0, stream, a);
#endif
#endif
}
```

```cpp
#include <hip/hip_runtime.h>
#include <cstdio>
#include <cstdint>

#define LAS __attribute__((address_space(3)))
#define GAS __attribute__((address_space(1)))
typedef unsigned short bf16;
typedef short bf16x8 __attribute__((ext_vector_type(8)));
typedef short s16x4 __attribute__((ext_vector_type(4)));
typedef float f32x2 __attribute__((ext_vector_type(2)));
typedef float f32x4 __attribute__((ext_vector_type(4)));
typedef float f32x16 __attribute__((ext_vector_type(16)));
typedef unsigned u32x2 __attribute__((ext_vector_type(2)));
typedef unsigned u32x4 __attribute__((ext_vector_type(4)));
typedef GAS unsigned gu32;

__device__ __forceinline__ int lane_id_v() { int l; asm volatile("v_mbcnt_lo_u32_b32 %0, -1, 0\n\tv_mbcnt_hi_u32_b32 %0, -1, %0" : "=v"(l)); return l; }

constexpr int BATCH = 8, SEQ = 2048, DM = 1024, M = BATCH * SEQ, DEPTH = 2;
constexpr int GRIDW = 64, NROWS = SEQ / GRIDW;
constexpr int D_IN = 6240, NW_IN = 6400;
constexpr int HP = 2048;
constexpr int D_FF = 2816, D_FFE = 3584, NEXP = 8;
constexpr int OFF_AQ = 0, OFF_AK = 256, OFF_AV = 384, OFF_BQ = 512, OFF_BK = 768, OFF_BV = 1024, OFF_CQ = 1280, OFF_CKV = 1472, OFF_KPE = 1600, OFF_GLU = 1632, OFF_GATE = 2144;
constexpr float LOG2E = 1.4426950408889634f;
constexpr float ALPHA = 1.4142135623730951f;
constexpr float LN_EPS = 1e-5f, RMS_EPS = 1e-6f;
constexpr float QS64 = 0.125f * LOG2E;
constexpr float QS96 = 0.10206207261596575f * LOG2E;
constexpr int MAXTILES = 136, MAXSLOTS = MAXTILES * 256;

namespace pg8 {
constexpr int BM = 256, BK = 64, HALF = 128, HTB = HALF * BK * 2, STAGE_BYTES = 8 * HTB, NXCD = 8, WGM = 8;
__host__ __device__ __forceinline__ int lds_byte(int r, int c) { const int st = (r >> 4) * 2 + (c >> 5), rr = r & 15, cc = c & 31, ob = rr * 64 + cc * 2; return st * 1024 + (ob ^ (((ob >> 9) & 1) << 5)); }
__host__ __device__ __forceinline__ void stage_rc(int b, int& R, int& C) { const int st = b / 1024, sb = b % 1024, swz = sb ^ (((sb >> 9) & 1) << 5); R = (st >> 1) * 16 + swz / 64; C = (st & 1) * 32 + (swz % 64) / 2; }
__host__ __device__ __forceinline__ int perm32(int rho) { const int n = rho >> 4, i = rho & 15; return 8 * (i >> 2) + 4 * n + (i & 3); }

struct Unit { int pm, pn, aux; size_t ao, bo; };
struct Gemm { const bf16* A; const bf16* Bt; int K; };

__device__ __forceinline__ bool tile_of(long L, int nM, int nN, int& pm, int& pn) {
    const int nwg = nM * nN; if (L >= nwg) return false;
    int wgid = (int)L; { const int q = nwg / NXCD, r = nwg % NXCD, xcd = wgid % NXCD, off = wgid / NXCD; wgid = (xcd < r ? xcd * (q + 1) : r * (q + 1) + (xcd - r) * q) + off; }
    const int nig = WGM * nN, gid = wgid / nig, fm = gid * WGM, gsz = (nM - fm) < WGM ? (nM - fm) : WGM;
    pm = fm + ((wgid % nig) % gsz); pn = (wgid % nig) / gsz; return true;
}
struct SchedPlain {
    int nM, nN, G, c; size_t ts;
    __device__ __forceinline__ void init(int nM_, int nN_, int K, int G_, int c_) { nM = nM_; nN = nN_; G = G_; c = c_; ts = (size_t)BM * K * 2; }
    __device__ __forceinline__ bool next(int i, Unit& u) const { if (!tile_of((long)i * G + c, nM, nN, u.pm, u.pn)) return false; u.aux = 0; u.ao = (size_t)u.pm * ts; u.bo = (size_t)u.pn * ts; return true; }
};
struct SchedGroup {
    int nM, nN, G, c; size_t ts; const LAS unsigned char* tile_e;
    __device__ __forceinline__ void init(int nM_, int nN_, int K, int G_, int c_, const LAS unsigned char* te) { nM = nM_; nN = nN_; G = G_; c = c_; ts = (size_t)BM * K * 2; tile_e = te; }
    __device__ __forceinline__ bool next(int i, Unit& u) const { if (!tile_of((long)i * G + c, nM, nN, u.pm, u.pn)) return false;
        const int e = __builtin_amdgcn_readfirstlane((int)tile_e[u.pm]); u.aux = e; u.ao = (size_t)u.pm * ts; u.bo = ((size_t)e * nN + u.pn) * ts; return true; }
};
struct SchedMerge {
    int G, c;
    __device__ __forceinline__ void init(int G_, int c_) { G = G_; c = c_; }
    __device__ __forceinline__ bool next(int i, Unit& u) const { if (!tile_of((long)(i >> 2) * G + c, M / BM, DM / BM, u.pm, u.pn)) return false;
        const int n = i & 3; u.aux = n; u.ao = ((size_t)n * M + (size_t)u.pm * BM) * 256 * 2; u.bo = ((size_t)n * DM + (size_t)u.pn * BM) * 256 * 2; return true; }
};

typedef __bf16 bf16x2_t __attribute__((ext_vector_type(2)));
__device__ __forceinline__ unsigned cvt_pk_bf16(float lo, float hi) { const f32x2 v = {lo, hi}; const bf16x2_t b = __builtin_convertvector(v, bf16x2_t); return __builtin_bit_cast(unsigned, b); }
__device__ __forceinline__ float bf_lo(unsigned w) { return __uint_as_float(w << 16); }
__device__ __forceinline__ float bf_hi(unsigned w) { return __uint_as_float(w & 0xffff0000u); }
__device__ __forceinline__ float sigmoidf_(float x) { return __builtin_amdgcn_rcpf(1.0f + __builtin_amdgcn_exp2f(-LOG2E * x)); }

typedef f32x4 Acc[2][2][4][2];

struct EpiWin {
    static constexpr bool PERM = true;
    bf16* H; bf16* Gt;
    __device__ __forceinline__ bool operator()(Acc& acc, const Unit& u, int wr, int wc, int fr, int fq) const {
        const int row0 = u.pm * BM + wr * 64 + fr, pn = u.pn, cw = wc * 32 + 8 * fq;
        if (pn < 7) {
            const float sc = (pn == 2) ? QS64 : 1.0f;
#pragma unroll
            for (int ai = 0; ai < 2; ++ai)
#pragma unroll
                for (int m = 0; m < 4; ++m) { bf16* rowp = H + (size_t)(row0 + ai * HALF + m * 16) * HP + pn * BM + cw;
#pragma unroll
                    for (int bj = 0; bj < 2; ++bj) { const f32x4 v0 = acc[ai][bj][m][0] * sc, v1 = acc[ai][bj][m][1] * sc;
                        u32x4 w; w.x = cvt_pk_bf16(v0[0], v0[1]); w.y = cvt_pk_bf16(v0[2], v0[3]); w.z = cvt_pk_bf16(v1[0], v1[1]); w.w = cvt_pk_bf16(v1[2], v1[3]);
                        *(u32x4*)(rowp + bj * HALF) = w; } }
        } else if (pn < 9) {
#pragma unroll
            for (int ai = 0; ai < 2; ++ai)
#pragma unroll
                for (int m = 0; m < 4; ++m) { bf16* rowp = H + (size_t)(row0 + ai * HALF + m * 16) * HP + 1792 + (pn - 7) * HALF + cw;
                    float o[8];
#pragma unroll
                    for (int n = 0; n < 2; ++n)
#pragma unroll
                        for (int e = 0; e < 4; ++e) o[n * 4 + e] = acc[ai][0][m][n][e] * sigmoidf_(acc[ai][1][m][n][e]);
                    u32x4 w; w.x = cvt_pk_bf16(o[0], o[1]); w.y = cvt_pk_bf16(o[2], o[3]); w.z = cvt_pk_bf16(o[4], o[5]); w.w = cvt_pk_bf16(o[6], o[7]);
                    *(u32x4*)rowp = w; }
        } else {
#pragma unroll
            for (int ai = 0; ai < 2; ++ai)
#pragma unroll
                for (int m = 0; m < 4; ++m) { bf16* rowp = Gt + ((size_t)((pn - 9) >> 2) * M + (size_t)(row0 + ai * HALF + m * 16)) * DM + ((pn - 9) & 3) * BM + cw;
#pragma unroll
                    for (int bj = 0; bj < 2; ++bj) { float o[8];
#pragma unroll
                        for (int n = 0; n < 2; ++n)
#pragma unroll
                            for (int e = 0; e < 4; ++e) o[n * 4 + e] = sigmoidf_(acc[ai][bj][m][n][e]);
                        u32x4 w; w.x = cvt_pk_bf16(o[0], o[1]); w.y = cvt_pk_bf16(o[2], o[3]); w.z = cvt_pk_bf16(o[4], o[5]); w.w = cvt_pk_bf16(o[6], o[7]);
                        *(u32x4*)(rowp + bj * HALF) = w; } }
        }
        return false;
    }
};
struct EpiUq {
    static constexpr bool PERM = true;
    bf16* QC; const float* cosC; const float* sinC;
    __device__ __forceinline__ bool operator()(Acc& acc, const Unit& u, int wr, int wc, int fr, int fq) const {
        const int row0 = u.pm * BM + wr * 64 + fr;
#pragma unroll
        for (int bj = 0; bj < 2; ++bj) { const int cb = u.pn * BM + bj * HALF + wc * 32; if (cb >= 384) continue;
            const int hh = cb / 96, jb = cb - hh * 96; const bool rot = (jb == 64); const int i0 = 4 * fq, c0 = cb + 8 * fq; (void)hh;
#pragma unroll
            for (int ai = 0; ai < 2; ++ai)
#pragma unroll
                for (int m = 0; m < 4; ++m) { const int row = row0 + ai * HALF + m * 16; f32x4 v0 = acc[ai][bj][m][0], v1 = acc[ai][bj][m][1];
                    if (rot) { const int s = row & (SEQ - 1); const f32x4 cs = *(const f32x4*)(cosC + s * 16 + i0), sn = *(const f32x4*)(sinC + s * 16 + i0);
                        const f32x4 a0 = v0, a1 = v1;
                        v0[0] = a0[0] * cs[0] - a0[1] * sn[0]; v0[1] = a0[0] * sn[0] + a0[1] * cs[0]; v0[2] = a0[2] * cs[1] - a0[3] * sn[1]; v0[3] = a0[2] * sn[1] + a0[3] * cs[1];
                        v1[0] = a1[0] * cs[2] - a1[1] * sn[2]; v1[1] = a1[0] * sn[2] + a1[1] * cs[2]; v1[2] = a1[2] * cs[3] - a1[3] * sn[3]; v1[3] = a1[2] * sn[3] + a1[3] * cs[3]; }
                    v0 = v0 * QS96; v1 = v1 * QS96;
                    u32x4 w; w.x = cvt_pk_bf16(v0[0], v0[1]); w.y = cvt_pk_bf16(v0[2], v0[3]); w.z = cvt_pk_bf16(v1[0], v1[1]); w.w = cvt_pk_bf16(v1[2], v1[3]);
                    *(u32x4*)(QC + (size_t)row * 384 + c0) = w; asm volatile("" ::: "memory"); } }
        return false;
    }
};
struct EpiUkv {
    static constexpr bool PERM = true;
    bf16* KC; bf16* VC;
    __device__ __forceinline__ bool operator()(Acc& acc, const Unit& u, int wr, int wc, int fr, int fq) const {
        const int row0 = u.pm * BM + wr * 64 + fr;
#pragma unroll
        for (int bj = 0; bj < 2; ++bj) { const int c0 = u.pn * BM + bj * HALF + wc * 32 + 8 * fq; const int hh = c0 >> 7, j = c0 & 127;
#pragma unroll
            for (int ai = 0; ai < 2; ++ai)
#pragma unroll
                for (int m = 0; m < 4; ++m) { const int row = row0 + ai * HALF + m * 16; const f32x4 v0 = acc[ai][bj][m][0], v1 = acc[ai][bj][m][1];
                    u32x4 w; w.x = cvt_pk_bf16(v0[0], v0[1]); w.y = cvt_pk_bf16(v0[2], v0[3]); w.z = cvt_pk_bf16(v1[0], v1[1]); w.w = cvt_pk_bf16(v1[2], v1[3]);
                    bf16* p = (j < 64) ? (KC + (size_t)row * 384 + hh * 96 + j) : (VC + (size_t)row * 256 + hh * 64 + (j - 64));
                    *(u32x4*)p = w; asm volatile("" ::: "memory"); } }
        return false;
    }
};
struct EpiMerge {
    static constexpr bool PERM = true;
    const bf16* Gt; bf16* MG;
    __device__ __forceinline__ bool operator()(Acc& acc, const Unit& u, int wr, int wc, int fr, int fq) const {
        const int row0 = u.pm * BM + wr * 64 + fr, n = u.aux, d0 = u.pn * BM + wc * 32 + 8 * fq;
        const float GMIN = 1e-18f;
#pragma unroll
        for (int ai = 0; ai < 2; ++ai)
#pragma unroll
            for (int m = 0; m < 4; ++m) { const int row = row0 + ai * HALF + m * 16; const bf16* gp = Gt + ((size_t)n * M + row) * DM + d0;
#pragma unroll
                for (int bj = 0; bj < 2; ++bj) { const u32x4 ga = *(const u32x4*)(gp + bj * HALF);
                    float g[8] = {bf_lo(ga.x), bf_hi(ga.x), bf_lo(ga.y), bf_hi(ga.y), bf_lo(ga.z), bf_hi(ga.z), bf_lo(ga.w), bf_hi(ga.w)};
                    if (n < 3) { const u32x4 gb = *(const u32x4*)(gp + (size_t)M * DM + bj * HALF);
                        const float h[8] = {bf_lo(gb.x), bf_hi(gb.x), bf_lo(gb.y), bf_hi(gb.y), bf_lo(gb.z), bf_hi(gb.z), bf_lo(gb.w), bf_hi(gb.w)};
#pragma unroll
                        for (int e = 0; e < 8; ++e) g[e] = fmaxf(g[e], GMIN) * __builtin_amdgcn_rcpf(fmaxf(h[e], GMIN));
#pragma unroll
                        for (int e = 0; e < 4; ++e) { acc[ai][bj][m][0][e] *= g[e]; acc[ai][bj][m][1][e] *= g[4 + e]; }
                    } else {
                        float o[8];
#pragma unroll
                        for (int e = 0; e < 4; ++e) { o[e] = acc[ai][bj][m][0][e] * fmaxf(g[e], GMIN); o[4 + e] = acc[ai][bj][m][1][e] * fmaxf(g[4 + e], GMIN); }
                        u32x4 w; w.x = cvt_pk_bf16(o[0], o[1]); w.y = cvt_pk_bf16(o[2], o[3]); w.z = cvt_pk_bf16(o[4], o[5]); w.w = cvt_pk_bf16(o[6], o[7]);
                        *(u32x4*)(MG + (size_t)row * DM + d0 + bj * HALF) = w; } }
                if (m & 1) asm volatile("" ::: "memory"); }
        return n < 3;
    }
};
struct EpiRes {
    static constexpr bool PERM = false;
    const float* X; float* T;
    __device__ __forceinline__ bool operator()(Acc& acc, const Unit& u, int wr, int wc, int fr, int fq) const {
        const int row0 = u.pm * BM + wr * 64 + fr, col0 = u.pn * BM + wc * 32 + 4 * fq;
#pragma unroll
        for (int ai = 0; ai < 2; ++ai)
#pragma unroll
            for (int m = 0; m < 4; ++m) { const size_t off = (size_t)(row0 + ai * HALF + m * 16) * DM + col0;
#pragma unroll
                for (int bj = 0; bj < 2; ++bj)
#pragma unroll
                    for (int n = 0; n < 2; ++n) { const f32x4 x = *(const f32x4*)(X + off + bj * HALF + n * 16); *(f32x4*)(T + off + bj * HALF + n * 16) = x * ALPHA + acc[ai][bj][m][n]; }
                if (m & 1) asm volatile("" ::: "memory"); }
        return false;
    }
};
struct EpiSwiGLU {
    static constexpr bool PERM = true;
    bf16* HID; int ld;
    __device__ __forceinline__ bool operator()(Acc& acc, const Unit& u, int wr, int wc, int fr, int fq) const {
        const int row0 = u.pm * BM + wr * 64 + fr, c0 = u.pn * HALF + wc * 32 + 8 * fq;
#pragma unroll
        for (int ai = 0; ai < 2; ++ai)
#pragma unroll
            for (int m = 0; m < 4; ++m) { float o[8];
#pragma unroll
                for (int n = 0; n < 2; ++n)
#pragma unroll
                    for (int e = 0; e < 4; ++e) { const float a = acc[ai][0][m][n][e]; o[n * 4 + e] = a * sigmoidf_(a) * acc[ai][1][m][n][e]; }
                u32x4 w; w.x = cvt_pk_bf16(o[0], o[1]); w.y = cvt_pk_bf16(o[2], o[3]); w.z = cvt_pk_bf16(o[4], o[5]); w.w = cvt_pk_bf16(o[6], o[7]);
                *(u32x4*)(HID + (size_t)(row0 + ai * HALF + m * 16) * ld + c0) = w; }
        return false;
    }
};
struct EpiO {
    static constexpr bool PERM = true;
    bf16* O;
    __device__ __forceinline__ bool operator()(Acc& acc, const Unit& u, int wr, int wc, int fr, int fq) const {
        const int row0 = u.pm * BM + wr * 64 + fr, c0 = u.pn * BM + wc * 32 + 8 * fq;
#pragma unroll
        for (int ai = 0; ai < 2; ++ai)
#pragma unroll
            for (int m = 0; m < 4; ++m) { bf16* rowp = O + (size_t)(row0 + ai * HALF + m * 16) * DM + c0;
#pragma unroll
                for (int bj = 0; bj < 2; ++bj) { const f32x4 v0 = acc[ai][bj][m][0], v1 = acc[ai][bj][m][1];
                    u32x4 w; w.x = cvt_pk_bf16(v0[0], v0[1]); w.y = cvt_pk_bf16(v0[2], v0[3]); w.z = cvt_pk_bf16(v1[0], v1[1]); w.w = cvt_pk_bf16(v1[2], v1[3]);
                    *(u32x4*)(rowp + bj * HALF) = w; } }
        return false;
    }
};
template <class Epi, class Sched, bool ALIGN_EPI = false, bool SP2 = false>
__device__ __forceinline__ void gemm_phase(LAS unsigned char* lds, const Gemm g, const Sched& S, const Epi& E, int wid_) {
    int wid = wid_; asm volatile("" : "+s"(wid));
    const int lane = lane_id_v(), tid = wid * 64 + lane, wr = wid >> 2, wc = wid & 3, fr = lane & 15, fq = lane >> 4;
    const int K = g.K, nt = K / BK;
    unsigned voffA[2], voffB[2];
#pragma unroll
    for (int i = 0; i < 2; ++i) { int R, C; stage_rc(tid * 16 + i * 8192, R, C); const int Rb = Epi::PERM ? ((R & ~31) + perm32(R & 31)) : R;
        voffA[i] = (unsigned)(R * K + C) * 2u; voffB[i] = (unsigned)(Rb * K + C) * 2u; }
    const size_t kstep = (size_t)(BK * 2);
    const size_t hstep = (size_t)HALF * K * 2;
    const unsigned ldsw = (unsigned)wid * 1024u;
    const int aoff = lds_byte(wr * 64 + fr, fq * 8), boff = lds_byte(wc * 32 + fr, fq * 8);
#define PG8_SA(b, h) (((b) * 2 + (h)) * HTB)
#define PG8_SB(b, h) ((4 + (b) * 2 + (h)) * HTB)
#define PG8_STAGE(bufoff, gbase, voff) do { _Pragma("unroll") for (int _i = 0; _i < 2; ++_i) \
        __builtin_amdgcn_global_load_lds((const unsigned*)((const char*)(gbase) + (voff)[_i]), (LAS unsigned*)(lds + (bufoff) + ldsw + _i * 8192), 16, 0, 0); } while (0)
#define PG8_LDA(dst, b, h) do { _Pragma("unroll") for (int m = 0; m < 4; ++m) _Pragma("unroll") for (int k = 0; k < 2; ++k) dst[m][k] = *(const LAS bf16x8*)(lds + PG8_SA(b, h) + aoff + m * 2048 + k * 1024); } while (0)
#define PG8_LDB(dst, b, h) do { _Pragma("unroll") for (int n = 0; n < 2; ++n) _Pragma("unroll") for (int k = 0; k < 2; ++k) dst[n][k] = *(const LAS bf16x8*)(lds + PG8_SB(b, h) + boff + n * 2048 + k * 1024); } while (0)
#define PG8_MMA(ai, bj, At, Bt) do { __builtin_amdgcn_s_setprio(1); _Pragma("unroll") for (int m = 0; m < 4; ++m) _Pragma("unroll") for (int n = 0; n < 2; ++n) _Pragma("unroll") for (int k = 0; k < 2; ++k) \
        acc[ai][bj][m][n] = __builtin_amdgcn_mfma_f32_16x16x32_bf16(Bt[n][k], At[m][k], acc[ai][bj][m][n], 0, 0, 0); __builtin_amdgcn_s_setprio(0); } while (0)
#define PG8_WAIT_V(n) asm volatile("s_waitcnt vmcnt(" #n ")" ::: "memory")
#define PG8_WAIT_L(n) asm volatile("s_waitcnt lgkmcnt(" #n ")" ::: "memory")
#define PG8_BAR __builtin_amdgcn_s_barrier()
#define PG8_SCHED __builtin_amdgcn_sched_barrier(0)
    Unit cur, nxt; int ui = 0;
    if (!S.next(0, cur)) return;
    Acc acc;
#pragma unroll
    for (int a = 0; a < 2; ++a)
#pragma unroll
        for (int b = 0; b < 2; ++b)
#pragma unroll
            for (int m = 0; m < 4; ++m)
#pragma unroll
                for (int n = 0; n < 2; ++n) acc[a][b][m][n] = (f32x4){0.f, 0.f, 0.f, 0.f};
    bf16x8 At[4][2], B0[2][2], B1[2][2];
    const char* cA = (const char*)g.A + cur.ao; const char* cB = (const char*)g.Bt + cur.bo;
    if constexpr (SP2) {
        PG8_STAGE(PG8_SB(0, 0), cB, voffB); PG8_STAGE(PG8_SB(0, 1), cB + hstep, voffB); PG8_STAGE(PG8_SA(0, 0), cA, voffA); PG8_STAGE(PG8_SA(0, 1), cA + hstep, voffA);
        if (wr == 1) PG8_BAR;
        PG8_WAIT_V(2); PG8_BAR;
        PG8_STAGE(PG8_SB(1, 0), cB + kstep, voffB); PG8_STAGE(PG8_SA(1, 0), cA + kstep, voffA); PG8_STAGE(PG8_SB(1, 1), cB + hstep + kstep, voffB);
        PG8_WAIT_V(6); PG8_BAR;
    } else {
        PG8_STAGE(PG8_SB(0, 0), cB, voffB); PG8_STAGE(PG8_SA(0, 0), cA, voffA); PG8_STAGE(PG8_SB(0, 1), cB + hstep, voffB); PG8_STAGE(PG8_SA(0, 1), cA + hstep, voffA);
        if (wr == 1) PG8_BAR;
        PG8_WAIT_V(4); PG8_BAR;
        PG8_STAGE(PG8_SB(1, 0), cB + kstep, voffB); PG8_STAGE(PG8_SA(1, 0), cA + kstep, voffA); PG8_STAGE(PG8_SB(1, 1), cB + hstep + kstep, voffB);
        PG8_WAIT_V(6); PG8_BAR;
    }
    for (;;) {
        const bool has_next = S.next(ui + 1, nxt);
        const char* nA = has_next ? (const char*)g.A + nxt.ao : cA; const char* nB = has_next ? (const char*)g.Bt + nxt.bo : cB;
        for (int t = 0; t < nt; t += 2) {
            const bool last = (t == nt - 2);
            const char* a1 = cA + (size_t)(t + 1) * kstep;
            const char* a2 = last ? nA : cA + (size_t)(t + 2) * kstep; const char* b2 = last ? nB : cB + (size_t)(t + 2) * kstep;
            const char* a3 = a2 + kstep; const char* b3 = b2 + kstep;
            if constexpr (SP2) {
            PG8_LDB(B0, 0, 0); PG8_LDB(B1, 0, 1); PG8_SCHED; PG8_LDA(At, 0, 0); PG8_STAGE(PG8_SA(1, 1), a1 + hstep, voffA);
            PG8_WAIT_V(8); PG8_WAIT_L(0); PG8_BAR; PG8_MMA(0, 0, At, B0); PG8_MMA(0, 1, At, B1); PG8_BAR; PG8_SCHED;
            PG8_LDA(At, 0, 1); PG8_STAGE(PG8_SB(0, 0), b2, voffB); PG8_STAGE(PG8_SB(0, 1), b2 + hstep, voffB); PG8_STAGE(PG8_SA(0, 0), a2, voffA);
            PG8_WAIT_V(8); PG8_WAIT_L(0); PG8_BAR; PG8_MMA(1, 0, At, B0); PG8_MMA(1, 1, At, B1); PG8_BAR; PG8_SCHED;
            PG8_LDB(B0, 1, 0); PG8_LDB(B1, 1, 1); PG8_SCHED; PG8_LDA(At, 1, 0); PG8_STAGE(PG8_SA(0, 1), a2 + hstep, voffA);
            PG8_WAIT_V(8); PG8_WAIT_L(0); PG8_BAR; PG8_MMA(0, 0, At, B0); PG8_MMA(0, 1, At, B1); PG8_BAR; PG8_SCHED;
            PG8_LDA(At, 1, 1); PG8_STAGE(PG8_SB(1, 0), b3, voffB); PG8_STAGE(PG8_SB(1, 1), b3 + hstep, voffB); PG8_STAGE(PG8_SA(1, 0), a3, voffA);
            PG8_WAIT_V(8); PG8_WAIT_L(0); PG8_BAR; PG8_MMA(1, 0, At, B0); PG8_MMA(1, 1, At, B1); PG8_BAR; PG8_SCHED;
            } else {
            PG8_LDB(B0, 0, 0); PG8_SCHED; PG8_LDA(At, 0, 0); PG8_STAGE(PG8_SA(1, 1), a1 + hstep, voffA);
            PG8_WAIT_L(8); PG8_BAR; PG8_WAIT_L(0); PG8_MMA(0, 0, At, B0); PG8_BAR; PG8_SCHED;
            PG8_LDB(B1, 0, 1); PG8_STAGE(PG8_SB(0, 0), b2, voffB);
            PG8_BAR; PG8_WAIT_L(0); PG8_MMA(0, 1, At, B1); PG8_BAR;
            PG8_LDA(At, 0, 1); PG8_STAGE(PG8_SA(0, 0), a2, voffA);
            PG8_BAR; PG8_WAIT_L(0); PG8_MMA(1, 0, At, B0); PG8_BAR; PG8_SCHED;
            PG8_STAGE(PG8_SB(0, 1), b2 + hstep, voffB);
            PG8_WAIT_V(6); PG8_BAR; PG8_MMA(1, 1, At, B1); PG8_BAR;
            PG8_LDB(B0, 1, 0); PG8_SCHED; PG8_LDA(At, 1, 0); PG8_STAGE(PG8_SA(0, 1), a2 + hstep, voffA);
            PG8_WAIT_L(8); PG8_BAR; PG8_WAIT_L(0); PG8_MMA(0, 0, At, B0); PG8_BAR; PG8_SCHED;
            PG8_LDB(B1, 1, 1); PG8_STAGE(PG8_SB(1, 0), b3, voffB);
            PG8_BAR; PG8_WAIT_L(0); PG8_MMA(0, 1, At, B1); PG8_BAR;
            PG8_LDA(At, 1, 1); PG8_STAGE(PG8_SA(1, 0), a3, voffA);
            PG8_BAR; PG8_WAIT_L(0); PG8_MMA(1, 0, At, B0); PG8_BAR; PG8_SCHED;
            PG8_STAGE(PG8_SB(1, 1), b3 + hstep, voffB);
            PG8_WAIT_V(6); PG8_BAR; PG8_MMA(1, 1, At, B1); PG8_BAR;
            }
        }
        if constexpr (ALIGN_EPI) { if (wr == 0) PG8_BAR; }
        bool keep; { const int le = lane_id_v(); keep = E(acc, cur, wr, wc, le & 15, le >> 4); }
        if (!has_next) break;
        if (!keep) {
#pragma unroll
        for (int a = 0; a < 2; ++a)
#pragma unroll
            for (int b = 0; b < 2; ++b)
#pragma unroll
                for (int m = 0; m < 4; ++m)
#pragma unroll
                    for (int n = 0; n < 2; ++n) acc[a][b][m][n] = (f32x4){0.f, 0.f, 0.f, 0.f};
        }
        cur = nxt; cA = nA; cB = nB; ++ui;
        if constexpr (ALIGN_EPI) { if (wr == 1) PG8_BAR; }
    }
    PG8_WAIT_V(0);
    if constexpr (!ALIGN_EPI) { if (wr == 0) PG8_BAR; }
    PG8_BAR;
#undef PG8_SA
#undef PG8_SB
#undef PG8_STAGE
#undef PG8_LDA
#undef PG8_LDB
#undef PG8_MMA
#undef PG8_WAIT_V
#undef PG8_WAIT_L
#undef PG8_BAR
#undef PG8_SCHED
}
}

#define RLX_AGENT __ATOMIC_RELAXED, __HIP_MEMORY_SCOPE_AGENT
#define LDS_WAIT() asm volatile("s_waitcnt lgkmcnt(0)" ::: "memory")
#define VM_WAIT() asm volatile("s_waitcnt vmcnt(0)" ::: "memory")
__device__ __forceinline__ unsigned pk2(float lo, float hi) { return pg8::cvt_pk_bf16(lo, hi); }
template <int X> __device__ __forceinline__ float swz_xor(float v) { return __int_as_float(__builtin_amdgcn_ds_swizzle(__float_as_int(v), (X << 10) | 0x1f)); }
__device__ __forceinline__ float half_sum(float v) { auto r = __builtin_amdgcn_permlane32_swap(__float_as_uint(v), __float_as_uint(v), false, false); return __uint_as_float(r[0]) + __uint_as_float(r[1]); }
__device__ __forceinline__ float half_max(float v) { auto r = __builtin_amdgcn_permlane32_swap(__float_as_uint(v), __float_as_uint(v), false, false); return fmaxf(__uint_as_float(r[0]), __uint_as_float(r[1])); }
__device__ __forceinline__ float sum16(float v) { v += swz_xor<1>(v); v += swz_xor<2>(v); v += swz_xor<4>(v); v += swz_xor<8>(v); return v; }
__device__ __forceinline__ float wave_sum(float v) { v = sum16(v); v += swz_xor<16>(v); return half_sum(v); }

#define XB_TMO      128
#define XB_XCNT(j)  (256  + 64 * (j))
#define XB_XSUB(j)  (1280 + 64 * (j))
#define XB_XGEN(j)  (2304 + 64 * (j))
#define XB_TOP      3328
#define XB_TOPGEN   3392
#define XCD_BAR_WORDS 3456
#define XB_SPIN_CAP (1u << 18)
__device__ __forceinline__ unsigned xb_ld(unsigned* p)              { return __hip_atomic_load(p, __ATOMIC_RELAXED, __HIP_MEMORY_SCOPE_AGENT); }
__device__ __forceinline__ unsigned xb_add(unsigned* p, unsigned v) { return __hip_atomic_fetch_add(p, v, __ATOMIC_RELAXED, __HIP_MEMORY_SCOPE_AGENT); }
__device__ __forceinline__ unsigned xb_xcc_id() { return (unsigned)__builtin_amdgcn_s_getreg((3 << 11) | 20) & 0xFu; }
#define XB_SPIN(cond, bar) do { unsigned _sp = 0; while (cond) { __builtin_amdgcn_s_sleep(1); \
    if ((++_sp & 255u) == 0u) { if (xb_ld(&(bar)[XB_TMO])) break; if (_sp > XB_SPIN_CAP) { atomicAdd(&(bar)[XB_TMO], 1u); break; } } } } while (0)
struct XcdBarrier { unsigned* bar; unsigned x; volatile LAS unsigned* st; };
__device__ __forceinline__ XcdBarrier xcd_barrier_post(unsigned* bar, volatile LAS unsigned* st) {
    XcdBarrier b; b.bar = bar; b.x = xb_xcc_id(); b.st = st;
    if (threadIdx.x == 0) (void)xb_add(&bar[XB_XCNT(b.x)], 1u);
    return b;
}
__device__ __forceinline__ void xcd_barrier_complete(unsigned* bar, unsigned x, unsigned& nloc, unsigned& nx) {
    const unsigned G = gridDim.x * gridDim.y * gridDim.z;
    unsigned sum, cnt, mine, sp = 0u;
    for (;;) {
        sum = 0u; cnt = 0u; mine = 0u;
#pragma unroll
        for (unsigned j = 0; j < 16; ++j) { const unsigned c = xb_ld(&bar[XB_XCNT(j)]); sum += c; cnt += (c > 0u) ? 1u : 0u; mine = (j == x) ? c : mine; }
        if (sum == G) break;
        __builtin_amdgcn_s_sleep(1);
        if ((++sp & 255u) == 0u) { if (xb_ld(&bar[XB_TMO])) break; if (sp > XB_SPIN_CAP) { atomicAdd(&bar[XB_TMO], 1u); break; } }
    }
    nloc = mine > 0u ? mine : 1u; nx = cnt > 0u ? cnt : 1u;
}
__device__ __forceinline__ void xcd_barrier(const XcdBarrier& b, const bool lead  ) {
    asm volatile("s_waitcnt vmcnt(0)" ::: "memory");
    __syncthreads();
    if (lead) {
        unsigned* bar = b.bar;
        __builtin_amdgcn_s_waitcnt(0);
        unsigned nloc = b.st[0], nx = b.st[1];
        if (nloc == 0u) { xcd_barrier_complete(bar, b.x, nloc, nx); b.st[0] = nloc; b.st[1] = nx; }
        const unsigned old = xb_add(&bar[XB_XSUB(b.x)], 1u);
        const unsigned gen = old / nloc;
        if (old + 1u == (gen + 1u) * nloc) {
            __builtin_amdgcn_fence(__ATOMIC_RELEASE, "agent");
            asm volatile("s_waitcnt vmcnt(0)" ::: "memory");
            const unsigned og = xb_add(&bar[XB_TOP], 1u);
            const unsigned tg = og / nx;
            if (og + 1u == (tg + 1u) * nx) xb_add(&bar[XB_TOPGEN], 1u);
            else XB_SPIN(xb_ld(&bar[XB_TOPGEN]) == tg, bar);
            __builtin_amdgcn_fence(__ATOMIC_ACQUIRE, "agent");
            xb_add(&bar[XB_XGEN(b.x)], 1u);
            asm volatile("s_waitcnt vmcnt(0)" ::: "memory");
        } else {
            XB_SPIN(xb_ld(&bar[XB_XGEN(b.x)]) == gen, bar);
            __builtin_amdgcn_fence(__ATOMIC_ACQUIRE, "agent");
            asm volatile("s_waitcnt vmcnt(0)" ::: "memory");
        }
    }
    __syncthreads();
}

namespace att {
typedef short v4i16_t __attribute__((ext_vector_type(4)));
__device__ __forceinline__ int crow(int r, int hi) { return (r & 3) + 8 * (r >> 2) + 4 * hi; }
__device__ __forceinline__ s16x4 vtr(const LAS unsigned char* p) { return __builtin_bit_cast(s16x4, __builtin_amdgcn_ds_read_tr16_b64_v4i16((LAS v4i16_t*)p)); }
constexpr int VBYTES = 8192;
template <int DK> struct Cfg { static constexpr int KSTR = DK * 2 + 16, KB = 64 * KSTR, BUF = KB + VBYTES; };
constexpr int RPB_OFF = 2 * (64 * 208 + VBYTES);
constexpr int LDS_NEED = RPB_OFF + 15 * 32 * 4;

template <int DK, int MODE>
__device__ __forceinline__ void attn_unit(LAS unsigned char* lds, const bf16* __restrict__ Q, int qp, const bf16* __restrict__ Kg, int kp, const bf16* __restrict__ Vg, int vp,
                                          bf16* __restrict__ O, int op, int ntile, int rg  , int wid_) {
    typedef Cfg<DK> C;
    constexpr int ND = DK / 16, CPR = DK / 8;
    int wid = wid_; asm volatile("" : "+s"(wid));
    const int lane = lane_id_v(), tid = wid * 64 + lane, r32 = lane & 31, hi = lane >> 5;
    const int kr0 = tid / CPR, kc0 = tid % CPR;
    const int kr1 = (tid + 512) / CPR, kc1 = (tid + 512) % CPR;
    const bool k2 = (DK == 96) && (tid < 256);
    const int vr = tid >> 3, vc = tid & 7;
    const int vlds = (vc >> 2) * 4096 + (vr >> 4) * 1024 + (vr & 15) * 64 + (vc & 3) * 16;
    const int kfo = r32 * C::KSTR + hi * 16;
    const int vfo = ((lane >> 4) & 1) * 32 + (lane & 3) * 8 + (4 * hi + ((lane & 15) >> 2)) * 64;
    bf16x8 qr[ND];
    { const bf16* qrow = Q + (size_t)(wid * 32 + r32) * qp + hi * 8;
#pragma unroll
      for (int d0 = 0; d0 < ND; ++d0) qr[d0] = *(const bf16x8*)(qrow + d0 * 16); }
    int t_lo = 0, t_hi = ntile, myrow = 0, qc = 0, cs = 0;
    if (MODE == 1) { myrow = rg + (wid >> 1); int rs = myrow - 4; rs = rs < 0 ? 0 : (rs > NROWS - 8 ? NROWS - 8 : rs); t_lo = rs; t_hi = rs + 8;
        qc = (wid & 1) * 32 + r32; cs = qc - 8; cs = cs < 0 ? 0 : (cs > GRIDW - 16 ? GRIDW - 16 : cs); }
    float mrun = -1e30f, lrun = 0.f; f32x16 o0 = {}, o1 = {};
    int T0 = 0, T1 = ntile;
    if (MODE == 1) { int a = rg - 4; a = a < 0 ? 0 : (a > NROWS - 8 ? NROWS - 8 : a); int b = rg + 3 - 4; b = b < 0 ? 0 : (b > NROWS - 8 ? NROWS - 8 : b); T0 = a; T1 = b + 8; }
    u32x4 ka0, ka1, va_, kb0, kb1, vb_;
#define ATT_LOAD(K0, K1, V, t) do { const size_t rb = (size_t)(t) * 64; K0 = *(const u32x4*)(Kg + (rb + kr0) * kp + kc0 * 8); if (k2) K1 = *(const u32x4*)(Kg + (rb + kr1) * kp + kc1 * 8); \
        V = *(const u32x4*)(Vg + (rb + vr) * vp + vc * 8); } while (0)
#define ATT_STORE(K0, K1, V, buf) do { LAS unsigned char* bb = lds + (buf) * C::BUF; *(LAS u32x4*)(bb + kr0 * C::KSTR + kc0 * 16) = K0; if (k2) *(LAS u32x4*)(bb + kr1 * C::KSTR + kc1 * 16) = K1; \
        *(LAS u32x4*)(bb + C::KB + vlds) = V; } while (0)
#define ATT_COMPUTE(t, buf) do { \
        if (MODE == 0 || ((t) >= t_lo && (t) < t_hi)) { \
            const LAS unsigned char* kb_ = lds + (buf) * C::BUF; const LAS unsigned char* vb__ = kb_ + C::KB; \
            f32x16 s0, s1; \
            if (MODE == 1) { \
                const LAS float* tab = (const LAS float*)(lds + RPB_OFF) + ((t) - myrow + 7) * 32; \
                _Pragma("unroll") for (int r = 0; r < 16; ++r) { const int kc = crow(r, hi); \
                    { int dc = kc - qc + 15; const bool ok = (kc >= cs) && (kc < cs + 16); dc = dc < 0 ? 0 : (dc > 30 ? 30 : dc); const float bv = tab[dc]; s0[r] = ok ? bv : -1e30f; } \
                    { const int k2_ = kc + 32; int dc = k2_ - qc + 15; const bool ok = (k2_ >= cs) && (k2_ < cs + 16); dc = dc < 0 ? 0 : (dc > 30 ? 30 : dc); const float bv = tab[dc]; s1[r] = ok ? bv : -1e30f; } } \
            } else { s0 = f32x16{}; s1 = f32x16{}; } \
            _Pragma("unroll") for (int d0 = 0; d0 < ND; ++d0) { \
                const bf16x8 k0 = *(const LAS bf16x8*)(kb_ + kfo + d0 * 32); \
                const bf16x8 k1 = *(const LAS bf16x8*)(kb_ + kfo + 32 * C::KSTR + d0 * 32); \
                s0 = __builtin_amdgcn_mfma_f32_32x32x16_bf16(k0, qr[d0], s0, 0, 0, 0); \
                s1 = __builtin_amdgcn_mfma_f32_32x32x16_bf16(k1, qr[d0], s1, 0, 0, 0); } \
            float mx = fmaxf(s0[0], s1[0]); \
            _Pragma("unroll") for (int r = 1; r < 16; ++r) mx = fmaxf(mx, fmaxf(s0[r], s1[r])); \
            mx = half_max(mx); \
            const float mn = fmaxf(mrun, mx); const float al = __builtin_amdgcn_exp2f(mrun - mn); mrun = mn; \
            float ls = 0.f; \
            _Pragma("unroll") for (int r = 0; r < 16; ++r) { s0[r] = __builtin_amdgcn_exp2f(s0[r] - mn); s1[r] = __builtin_amdgcn_exp2f(s1[r] - mn); ls += s0[r] + s1[r]; } \
            lrun = lrun * al + ls; \
            _Pragma("unroll") for (int r = 0; r < 16; ++r) { o0[r] *= al; o1[r] *= al; } \
            u32x4 pw[4]; \
            _Pragma("unroll") for (int j = 0; j < 4; ++j) { pw[0][j] = pk2(s0[2 * j], s0[2 * j + 1]); pw[1][j] = pk2(s0[8 + 2 * j], s0[9 + 2 * j]); pw[2][j] = pk2(s1[2 * j], s1[2 * j + 1]); pw[3][j] = pk2(s1[8 + 2 * j], s1[9 + 2 * j]); } \
            _Pragma("unroll") for (int ks = 0; ks < 4; ++ks) { \
                const s16x4 a0 = vtr(vb__ + vfo + ks * 1024), a1 = vtr(vb__ + vfo + ks * 1024 + 512); \
                const s16x4 b0 = vtr(vb__ + vfo + 4096 + ks * 1024), b1 = vtr(vb__ + vfo + 4096 + ks * 1024 + 512); \
                const bf16x8 va = (bf16x8){a0[0], a0[1], a0[2], a0[3], a1[0], a1[1], a1[2], a1[3]}; \
                const bf16x8 vb = (bf16x8){b0[0], b0[1], b0[2], b0[3], b1[0], b1[1], b1[2], b1[3]}; \
                const bf16x8 pf = __builtin_bit_cast(bf16x8, pw[ks]); \
                o0 = __builtin_amdgcn_mfma_f32_32x32x16_bf16(va, pf, o0, 0, 0, 0); \
                o1 = __builtin_amdgcn_mfma_f32_32x32x16_bf16(vb, pf, o1, 0, 0, 0); } \
        } } while (0)
    ATT_LOAD(ka0, ka1, va_, T0); ATT_STORE(ka0, ka1, va_, 0);
    if (T0 + 1 < T1) ATT_LOAD(ka0, ka1, va_, T0 + 1);
    __syncthreads();
    for (int t = T0; t < T1; t += 2) {
        if (t + 2 < T1) ATT_LOAD(kb0, kb1, vb_, t + 2);
        ATT_COMPUTE(t, 0);
        if (t + 1 < T1) ATT_STORE(ka0, ka1, va_, 1);
        __syncthreads();
        if (t + 1 >= T1) break;
        if (t + 3 < T1) ATT_LOAD(ka0, ka1, va_, t + 3);
        ATT_COMPUTE(t + 1, 1);
        if (t + 2 < T1) ATT_STORE(kb0, kb1, vb_, 0);
        __syncthreads();
    }
#undef ATT_LOAD
#undef ATT_STORE
#undef ATT_COMPUTE
    const float lt = half_sum(lrun); const float inv = 1.0f / lt;
    bf16* orow = O + (size_t)(wid * 32 + r32) * op + 4 * hi;
#pragma unroll
    for (int g = 0; g < 4; ++g) {
        u32x2 w0, w1;
        w0.x = pk2(o0[4 * g] * inv, o0[4 * g + 1] * inv); w0.y = pk2(o0[4 * g + 2] * inv, o0[4 * g + 3] * inv);
        w1.x = pk2(o1[4 * g] * inv, o1[4 * g + 1] * inv); w1.y = pk2(o1[4 * g + 2] * inv, o1[4 * g + 3] * inv);
        *(u32x2*)(orow + 8 * g) = w0; *(u32x2*)(orow + 32 + 8 * g) = w1;
    }
}
}

constexpr size_t MiB = 1u << 20;
constexpr size_t WS_CTL = 0, CTL_ZERO_BYTES = 256 * 1024;
constexpr size_t WS_ROPEA_C = 1 * MiB, WS_ROPEA_S = WS_ROPEA_C + 256 * 1024, WS_ROPEC_C = WS_ROPEA_S + 256 * 1024, WS_ROPEC_S = WS_ROPEC_C + 128 * 1024;
constexpr size_t WS_ROUTE = 2 * MiB;
constexpr size_t WS_SLOT = WS_ROUTE + 256 * 1024;
constexpr size_t WS_CNT = WS_SLOT + 128 * 1024;
constexpr size_t WS_META = WS_CNT + 8 * 1024;
constexpr size_t WS_XRES = 4 * MiB;
constexpr size_t WS_R = 68 * MiB;
constexpr size_t WS_WIN = WS_R;
constexpr size_t WS_WBR = WS_WIN + 25 * MiB;
constexpr size_t WS_WOUT = WS_WBR + 4 * MiB;
constexpr size_t WS_W13 = WS_WOUT + 4 * MiB;
constexpr size_t WS_W2 = WS_W13 + 11 * MiB;
constexpr size_t WS_WUQ = WS_W2 + 6 * MiB;
constexpr size_t WS_WUKV = WS_WUQ + MiB / 2;
constexpr size_t WS_XB = WS_R + 52 * MiB;
constexpr size_t WS_H = WS_XB + 32 * MiB;
constexpr size_t WS_T = WS_H;
constexpr size_t WS_G = WS_H + 64 * MiB;
constexpr size_t WS_HID0 = WS_G;
constexpr size_t WS_QA = WS_G + 128 * MiB;
constexpr size_t WS_KA = WS_QA + 8 * MiB;
constexpr size_t WS_CQN = WS_KA + 4 * MiB;
constexpr size_t WS_CKVN = WS_CQN + 8 * MiB;
constexpr size_t WS_QC = WS_CKVN + 8 * MiB;
constexpr size_t WS_KC = WS_QC + 12 * MiB;
constexpr size_t WS_VC = WS_KC + 12 * MiB;
constexpr size_t WS_MG = WS_QA;
constexpr size_t WS_YS = WS_VC + 8 * MiB;
constexpr size_t WS_DENSE_END = WS_YS + 32 * MiB;
constexpr size_t WS_MW13 = WS_R;
constexpr size_t WS_MW2 = WS_R;
constexpr size_t WS_MHID = WS_R + 112 * MiB;
constexpr size_t WS_XG = WS_MHID + 238 * MiB;
constexpr size_t WS_END = WS_XG + 68 * MiB;
static_assert(WS_DENSE_END <= WS_END && WS_WUKV + MiB / 2 <= WS_XB, "ws map");
static_assert((size_t)MAXSLOTS * D_FFE * 2 <= 238 * MiB && (size_t)MAXSLOTS * DM * 2 <= 68 * MiB, "ws map moe");
constexpr int CW_TMO = 0, CW_BAR = 4096;

constexpr int RING_BYTES = 131072;
constexpr int LDSCTL_OFF = RING_BYTES;
constexpr int LDS_BYTES = 147456;
constexpr int NWAVES = 8;

struct Frame { LAS unsigned char* lds; int tid, lane, wave, vcu, G; };

__device__ __forceinline__ void cvt_item(const float* W, int ldn, int n0, int k0, bool zero, bf16* WT, int ldk, int r0, LAS float* scr, int lane) {
    if (!zero) {
#pragma unroll
        for (int i = 0; i < 8; ++i) { const int kk = 8 * i + (lane >> 3), c4 = 4 * (lane & 7); const f32x4 v = *(const f32x4*)(W + (size_t)(k0 + kk) * ldn + n0 + c4);
            LAS float* d = scr + kk * 33 + c4; d[0] = v[0]; d[1] = v[1]; d[2] = v[2]; d[3] = v[3]; }
    }
    LDS_WAIT(); asm volatile("" ::: "memory");
    const int c = lane & 7;
#pragma unroll
    for (int j = 0; j < 4; ++j) { const int n = (lane >> 3) + 8 * j; const LAS float* s = scr + (8 * c) * 33 + n;
        u32x4 o;
        if (zero) { o = (u32x4){0u, 0u, 0u, 0u}; } else { o.x = pk2(s[0 * 33], s[1 * 33]); o.y = pk2(s[2 * 33], s[3 * 33]); o.z = pk2(s[4 * 33], s[5 * 33]); o.w = pk2(s[6 * 33], s[7 * 33]); }
        *(GAS u32x4*)(WT + (size_t)(r0 + n) * ldk + k0 + 8 * c) = o; }
    LDS_WAIT(); asm volatile("" ::: "memory");
}
__device__ __forceinline__ int win_src_col(int rb) {
    const int tile = rb >> 3, w = rb & 7;
    if (tile < 5) return rb * 32;
    if (tile == 5) return w < 6 ? OFF_CQ + 32 * w : -1;
    if (tile == 6) return w < 4 ? OFF_CKV + 32 * w : (w == 4 ? OFF_KPE : -1);
    if (tile < 9) return OFF_GLU + (w >> 2) * 256 + (tile - 7) * 128 + 32 * (w & 3);
    return OFF_GATE + (rb - 72) * 32;
}

__device__ __forceinline__ void ln_row(f32x4 (&v)[4], const float* g, const float* b, int lane) {
    float s = 0.f;
#pragma unroll
    for (int j = 0; j < 4; ++j) s += (v[j][0] + v[j][1]) + (v[j][2] + v[j][3]);
    const float mean = wave_sum(s) * (1.f / DM); float s2 = 0.f;
#pragma unroll
    for (int j = 0; j < 4; ++j) { v[j] = v[j] - mean; s2 += (v[j][0] * v[j][0] + v[j][1] * v[j][1]) + (v[j][2] * v[j][2] + v[j][3] * v[j][3]); }
    const float rstd = 1.0f / sqrtf(wave_sum(s2) * (1.f / DM) + LN_EPS);
#pragma unroll
    for (int j = 0; j < 4; ++j) { const f32x4 gg = *(const f32x4*)(g + 4 * lane + 256 * j), bb = *(const f32x4*)(b + 4 * lane + 256 * j); v[j] = v[j] * rstd * gg + bb; }
}
__device__ __forceinline__ void store_row_f32(float* p, const f32x4 (&v)[4], int lane) {
#pragma unroll
    for (int j = 0; j < 4; ++j) *(f32x4*)(p + 4 * lane + 256 * j) = v[j];
}
__device__ __forceinline__ void store_row_bf16(bf16* p, const f32x4 (&v)[4], int lane) {
#pragma unroll
    for (int j = 0; j < 4; ++j) { u32x2 w; w.x = pk2(v[j][0], v[j][1]); w.y = pk2(v[j][2], v[j][3]); *(u32x2*)(p + 4 * lane + 256 * j) = w; }
}
#ifndef REP_MASK
#define REP_MASK 0u
#endif
#ifndef DBG_REPORT
#define DBG_REPORT 0
#endif
#ifndef DBG_K0
#define DBG_K0 5
#endif
#ifndef DBG_CHK
#define DBG_CHK 0
#endif
#ifndef DBG_TOL
#define DBG_TOL 0.05f
#endif
#ifndef DBG_LDSFILL
#define DBG_LDSFILL 0
#endif
#ifndef DBG_LDSFILL_VAL
#define DBG_LDSFILL_VAL 0u
#endif
#ifndef DBG_ZERO_AC
#define DBG_ZERO_AC 0
#endif
#ifndef DBG_ZROWS
#define DBG_ZROWS 0
#endif
#ifndef DBG_ZCOND
#define DBG_ZCOND false
#endif
#ifndef DBG_ZERO_B
#define DBG_ZERO_B 0
#endif
#ifndef MK_ONE_LAUNCH
#define MK_ONE_LAUNCH 1
#endif
#ifndef PH_MASK
#define PH_MASK 0xFFFFFFFFu
#endif
__host__ __device__ constexpr bool EN(int k) { return ((PH_MASK) >> k) & 1u; }

#define WSP GAS unsigned char* wsp = (GAS unsigned char*)ws; int wave = F.wave, G_ = F.G, vcu = F.vcu, bid = blockIdx.x; asm volatile("" : "+s"(wsp), "+s"(wave), "+s"(G_), "+s"(vcu), "+s"(bid)); \
    const int lane = lane_id_v(), tid = wave * 64 + lane; const int gw = vcu * NWAVES + wave, NGW = G_ * NWAVES; (void)lane; (void)tid; (void)gw; (void)NGW; (void)bid
#define XRES ((float*)(wsp + WS_XRES))
#define XB ((bf16*)(wsp + WS_XB))
#define Hb ((bf16*)(wsp + WS_H))
#define Gt ((bf16*)(wsp + WS_G))
#define Tb ((float*)(wsp + WS_T))
#define QA ((bf16*)(wsp + WS_QA))
#define KA ((bf16*)(wsp + WS_KA))
#define CQN ((bf16*)(wsp + WS_CQN))
#define CKVN ((bf16*)(wsp + WS_CKVN))
#define QC ((bf16*)(wsp + WS_QC))
#define KC ((bf16*)(wsp + WS_KC))
#define VC ((bf16*)(wsp + WS_VC))
#define MG ((bf16*)(wsp + WS_MG))
#define YS ((bf16*)(wsp + WS_YS))
#define ropeA_c ((float*)(wsp + WS_ROPEA_C))
#define ropeA_s ((float*)(wsp + WS_ROPEA_S))
#define ropeC_c ((float*)(wsp + WS_ROPEC_C))
#define ropeC_s ((float*)(wsp + WS_ROPEC_S))
#define ROUTE ((unsigned*)(wsp + WS_ROUTE))
#define SLOT ((unsigned*)(wsp + WS_SLOT))
#define CNT ((unsigned*)(wsp + WS_CNT))
#define META ((unsigned*)(wsp + WS_META))
#define INP(i) ldptr(PTAB, (i))
__device__ __forceinline__ const float* ldptr(const LAS unsigned* tab, int i) { const unsigned lo = __builtin_amdgcn_readfirstlane(tab[2 * i]), hi = __builtin_amdgcn_readfirstlane(tab[2 * i + 1]); return (const float*)(const GAS float*)(((unsigned long long)hi << 32) | lo); }
struct Args {
    const float* in[28]; float* out; unsigned char* ws; int ph_lo, ph_hi;
};
constexpr int PH_PER_LAYER = 16, N_PHASES = 1 + 2 * PH_PER_LAYER;

__global__ void __launch_bounds__(NWAVES * 64, 2) fwd(Args args) {
    extern __shared__ __attribute__((aligned(16))) unsigned char lds_raw[];
    Frame F;
    F.lds = (LAS unsigned char*)lds_raw;
    F.tid = threadIdx.x; F.lane = F.tid & 63; F.wave = __builtin_amdgcn_readfirstlane(F.tid >> 6);
    F.G = gridDim.x; { const int bx = blockIdx.x; F.vcu = (F.G % 8 == 0) ? (bx % 8) * (F.G / 8) + bx / 8 : bx; }
    unsigned char* ws = args.ws;
    gu32* ctl = (gu32*)(ws + WS_CTL);
    volatile LAS unsigned* MISC = (volatile LAS unsigned*)(F.lds + LDSCTL_OFF);
    for (int u = F.tid; u < (LDS_BYTES - LDSCTL_OFF) / 4; u += NWAVES * 64) ((LAS unsigned*)(F.lds + LDSCTL_OFF))[u] = 0u;
    __syncthreads();
    if (F.tid < 29) { const unsigned long long pv = (F.tid < 28) ? (unsigned long long)args.in[F.tid] : (unsigned long long)args.out; LAS unsigned* pt = (LAS unsigned*)(F.lds + LDSCTL_OFF + 2048); pt[2 * F.tid] = (unsigned)pv; pt[2 * F.tid + 1] = (unsigned)(pv >> 32); }
    __syncthreads();
    const int lo = args.ph_lo, hi = args.ph_hi;
    const bool one_launch = (hi - lo) > 1;
    XcdBarrier bar; bar.bar = (unsigned*)(ctl + CW_BAR); bar.x = 0; bar.st = nullptr;
    if (one_launch) bar = xcd_barrier_post((unsigned*)(ctl + CW_BAR), MISC);
#define IN(k) (lo <= (k) && (k) < hi)
#define SEAM(k) do { if (IN(k) && IN((k) + 1)) { int w_ = F.wave; asm volatile("" : "+s"(w_)); xcd_barrier(bar, (w_ * 64 + lane_id_v()) == 0); } } while (0)

    const LAS unsigned* PTAB = (const LAS unsigned*)(F.lds + LDSCTL_OFF + 2048);

    if (IN(0) && EN(0)) { WSP;
        LAS float* scr = (LAS float*)(F.lds + wave * 16384);
        {
            const int nit = 2 * (NW_IN / 32) * 16;
            for (int it = gw; it < nit; it += NGW) { const int l = it / ((NW_IN / 32) * 16), r = it % ((NW_IN / 32) * 16), rb = r / 16, kb = r % 16; const int sc = win_src_col(rb);
                cvt_item(INP(3) + (size_t)l * 1024 * D_IN, D_IN, sc < 0 ? 0 : sc, kb * 64, sc < 0, (bf16*)(wsp + WS_WIN) + (size_t)l * NW_IN * 1024, 1024, rb * 32, scr, lane); }
        }
        {
            const int nit = 8 * 32 * 4;
            for (int it = gw; it < nit; it += NGW) { const int mat = it / 128, r = it % 128, rb = r / 4, kb = r % 4;
                cvt_item(INP(15) + (size_t)mat * 256 * 1024, 1024, rb * 32, kb * 64, false, (bf16*)(wsp + WS_WBR) + (size_t)mat * 1024 * 256, 256, rb * 32, scr, lane); }
        }
        {
            const int nit = 2 * 32 * 16;
            for (int it = gw; it < nit; it += NGW) { const int mat = it / 512, r = it % 512, rb = r / 16, kb = r % 16;
                cvt_item(INP(16) + (size_t)mat * 1024 * 1024, 1024, rb * 32, kb * 64, false, (bf16*)(wsp + WS_WOUT) + (size_t)mat * 1024 * 1024, 1024, rb * 32, scr, lane); }
        }
        {
            const int nit = (2 * D_FF / 32) * 16;
            for (int it = gw; it < nit; it += NGW) { const int rb = it / 16, kb = it % 16; const int tile = rb >> 3, w = rb & 7;
                cvt_item((w < 4) ? INP(19) : INP(20), D_FF, tile * 128 + (w & 3) * 32, kb * 64, false, (bf16*)(wsp + WS_W13), 1024, rb * 32, scr, lane); }
        }
        {
            const int nit = 32 * (D_FF / 64);
            for (int it = gw; it < nit; it += NGW) { const int rb = it / (D_FF / 64), kb = it % (D_FF / 64);
                cvt_item(INP(21), 1024, rb * 32, kb * 64, false, (bf16*)(wsp + WS_W2), D_FF, rb * 32, scr, lane); }
        }
        {
            const int nit = 2 * 2 * 16 * 4;
            for (int it = gw; it < nit; it += NGW) { const int which = it / 128, l = (it / 64) & 1, r = it % 64, rb = r / 4, kb = r % 4;
                if (which == 0) { const bool z = (rb >= 12) || (kb >= 3); cvt_item(INP(9) + (size_t)l * 192 * 384, 384, rb * 32, kb * 64, z, (bf16*)(wsp + WS_WUQ) + (size_t)l * 512 * 256, 256, rb * 32, scr, lane); }
                else { const bool z = (kb >= 2); cvt_item(INP(10) + (size_t)l * 128 * 512, 512, rb * 32, kb * 64, z, (bf16*)(wsp + WS_WUKV) + (size_t)l * 512 * 256, 256, rb * 32, scr, lane); } }
        }
        for (int i = bid * 512 + tid; i < SEQ * 32; i += G_ * 512) { const int s = i >> 5, f = i & 31; const float pos = (f < 16) ? (float)(s >> 6) : (float)(s & 63);
            const float inv = exp2f(-(float)(f & 15) * (13.287712379549449f / 16.0f)); const float a = pos * inv; ropeA_c[i] = cosf(a); ropeA_s[i] = sinf(a); }
        for (int i = bid * 512 + tid; i < SEQ * 16; i += G_ * 512) { const int s = i >> 4, f = i & 15; const float pos = (f < 8) ? (float)(s >> 6) : (float)(s & 63);
            const float inv = exp2f(-(float)(f & 7) * (13.287712379549449f / 8.0f)); const float a = pos * inv; ropeC_c[i] = cosf(a); ropeC_s[i] = sinf(a); }
        for (int m = gw; m < M; m += NGW) { f32x4 v[4];
#pragma unroll
            for (int j = 0; j < 4; ++j) v[j] = *(const f32x4*)(INP(0) + (size_t)m * DM + 4 * lane + 256 * j);
            ln_row(v, INP(1), INP(2), lane); store_row_f32(XRES + (size_t)m * DM, v, lane); store_row_bf16(XB + (size_t)m * DM, v, lane); }
    }
    SEAM(0);

    {
        constexpr int l = 0;
        const int pb = 1 + PH_PER_LAYER * l;
        const bool moe = (l & 1) != 0;
        if (IN(pb + 0) && EN(1)) { WSP;
            pg8::Gemm g{XB, (const bf16*)(wsp + WS_WIN) + (size_t)l * NW_IN * 1024, 1024}; pg8::SchedPlain S; S.init(M / 256, NW_IN / 256, 1024, G_, bid);
            pg8::EpiWin E{Hb, Gt};
            pg8::gemm_phase<pg8::EpiWin, pg8::SchedPlain, true, true>(F.lds, g, S, E, wave);
        }
        SEAM(pb + 0);
        if (IN(pb + 1) && EN(2)) { WSP;
            const float* aqn = INP(4) + l * 64; const float* akn = INP(5) + l * 64; const float* cqn = INP(7) + l * 192; const float* ckvn = INP(8) + l * 128;
            for (int t = gw; t < M; t += NGW) { const int s = t & (SEQ - 1); const bf16* hr = Hb + (size_t)t * HP;
                {
                    const u32x2 w = *(const u32x2*)(hr + 4 * lane); float v[4] = {pg8::bf_lo(w.x), pg8::bf_hi(w.x), pg8::bf_lo(w.y), pg8::bf_hi(w.y)};
                    float ss = v[0] * v[0] + v[1] * v[1] + v[2] * v[2] + v[3] * v[3]; ss = sum16(ss);
                    const float rs = 1.0f / sqrtf(ss * (1.f / 64.f) + RMS_EPS); const int d = 4 * (lane & 15); const f32x4 gg = *(const f32x4*)(aqn + d);
                    const f32x2 cs = *(const f32x2*)(ropeA_c + s * 32 + (d >> 1)), sn = *(const f32x2*)(ropeA_s + s * 32 + (d >> 1));
                    const float a0 = v[0] * rs * gg[0], a1 = v[1] * rs * gg[1], a2 = v[2] * rs * gg[2], a3 = v[3] * rs * gg[3];
                    u32x2 o; o.x = pk2((a0 * cs[0] - a1 * sn[0]) * QS64, (a0 * sn[0] + a1 * cs[0]) * QS64); o.y = pk2((a2 * cs[1] - a3 * sn[1]) * QS64, (a2 * sn[1] + a3 * cs[1]) * QS64);
                    *(u32x2*)(QA + (size_t)t * 256 + 4 * lane) = o; }
                if (lane < 32) {
                    const u32x2 w = *(const u32x2*)(hr + 256 + 4 * lane); float v[4] = {pg8::bf_lo(w.x), pg8::bf_hi(w.x), pg8::bf_lo(w.y), pg8::bf_hi(w.y)};
                    float ss = v[0] * v[0] + v[1] * v[1] + v[2] * v[2] + v[3] * v[3]; ss = sum16(ss);
                    const float rs = 1.0f / sqrtf(ss * (1.f / 64.f) + RMS_EPS); const int d = 4 * (lane & 15); const f32x4 gg = *(const f32x4*)(akn + d);
                    const f32x2 cs = *(const f32x2*)(ropeA_c + s * 32 + (d >> 1)), sn = *(const f32x2*)(ropeA_s + s * 32 + (d >> 1));
                    const float a0 = v[0] * rs * gg[0], a1 = v[1] * rs * gg[1], a2 = v[2] * rs * gg[2], a3 = v[3] * rs * gg[3];
                    u32x2 o; o.x = pk2(a0 * cs[0] - a1 * sn[0], a0 * sn[0] + a1 * cs[0]); o.y = pk2(a2 * cs[1] - a3 * sn[1], a2 * sn[1] + a3 * cs[1]);
                    *(u32x2*)(KA + (size_t)t * 128 + 4 * lane) = o; }
                {
                    float v[4] = {0.f, 0.f, 0.f, 0.f};
                    if (lane < 48) { const u32x2 w = *(const u32x2*)(hr + 1280 + 4 * lane); v[0] = pg8::bf_lo(w.x); v[1] = pg8::bf_hi(w.x); v[2] = pg8::bf_lo(w.y); v[3] = pg8::bf_hi(w.y); }
                    const float ss = wave_sum(v[0] * v[0] + v[1] * v[1] + v[2] * v[2] + v[3] * v[3]); const float rs = 1.0f / sqrtf(ss * (1.f / 192.f) + RMS_EPS);
                    u32x2 o = {0u, 0u};
                    if (lane < 48) { const f32x4 gg = *(const f32x4*)(cqn + 4 * lane); o.x = pk2(v[0] * rs * gg[0], v[1] * rs * gg[1]); o.y = pk2(v[2] * rs * gg[2], v[3] * rs * gg[3]); }
                    *(u32x2*)(CQN + (size_t)t * 256 + 4 * lane) = o; }
                {
                    float v[4] = {0.f, 0.f, 0.f, 0.f};
                    if (lane < 32) { const u32x2 w = *(const u32x2*)(hr + 1536 + 4 * lane); v[0] = pg8::bf_lo(w.x); v[1] = pg8::bf_hi(w.x); v[2] = pg8::bf_lo(w.y); v[3] = pg8::bf_hi(w.y); }
                    const float ss = wave_sum(v[0] * v[0] + v[1] * v[1] + v[2] * v[2] + v[3] * v[3]); const float rs = 1.0f / sqrtf(ss * (1.f / 128.f) + RMS_EPS);
                    u32x2 o = {0u, 0u};
                    if (lane < 32) { const f32x4 gg = *(const f32x4*)(ckvn + 4 * lane); o.x = pk2(v[0] * rs * gg[0], v[1] * rs * gg[1]); o.y = pk2(v[2] * rs * gg[2], v[3] * rs * gg[3]); }
                    *(u32x2*)(CKVN + (size_t)t * 256 + 4 * lane) = o; }
                if (lane < 32) {
                    const int j = lane & 7, hh = lane >> 3; const u32x2 w = *(const u32x2*)(hr + 1664 + 4 * j);
                    const float a0 = pg8::bf_lo(w.x), a1 = pg8::bf_hi(w.x), a2 = pg8::bf_lo(w.y), a3 = pg8::bf_hi(w.y);
                    const f32x2 cs = *(const f32x2*)(ropeC_c + s * 16 + 2 * j), sn = *(const f32x2*)(ropeC_s + s * 16 + 2 * j);
                    u32x2 o; o.x = pk2(a0 * cs[0] - a1 * sn[0], a0 * sn[0] + a1 * cs[0]); o.y = pk2(a2 * cs[1] - a3 * sn[1], a2 * sn[1] + a3 * cs[1]);
                    *(u32x2*)(KC + (size_t)t * 384 + hh * 96 + 64 + 4 * j) = o; }
            }
        }
        SEAM(pb + 1);
        if (IN(pb + 2) && EN(3)) { WSP;
            { pg8::Gemm g{CQN, (const bf16*)(wsp + WS_WUQ) + (size_t)l * 512 * 256, 256}; pg8::SchedPlain S; S.init(M / 256, 2, 256, G_, bid);
              pg8::EpiUq E{QC, ropeC_c, ropeC_s}; pg8::gemm_phase<pg8::EpiUq, pg8::SchedPlain, true, true>(F.lds, g, S, E, wave); }
            { pg8::Gemm g{CKVN, (const bf16*)(wsp + WS_WUKV) + (size_t)l * 512 * 256, 256}; pg8::SchedPlain S; S.init(M / 256, 2, 256, G_, bid);
              pg8::EpiUkv E{KC, VC}; pg8::gemm_phase<pg8::EpiUkv, pg8::SchedPlain, true, true>(F.lds, g, S, E, wave); }
        }
        SEAM(pb + 2);
        if (IN(pb + 3) && EN(4)) { WSP;
            for (int u = vcu; u < 256; u += G_) {
#if DBG_LDSFILL
                for (int i = tid; i < 49152 / 4; i += 512) ((LAS unsigned*)F.lds)[i] = DBG_LDSFILL_VAL; __syncthreads();
#endif
                const int b = u >> 5, hh = (u >> 3) & 3, qb = u & 7; const size_t r0 = (size_t)b * SEQ + qb * 256, b0 = (size_t)b * SEQ;
#if DBG_ZERO_AC
                for (int i = tid; i < 256 * 8; i += 512) { const int rr = i >> 3, c8 = i & 7; *(u32x4*)(YS + ((size_t)0 * M + r0 + rr) * 256 + hh * 64 + c8 * 8) = (u32x4){0u, 0u, 0u, 0u}; *(u32x4*)(YS + ((size_t)2 * M + r0 + rr) * 256 + hh * 64 + c8 * 8) = (u32x4){0u, 0u, 0u, 0u}; }
#else
                att::attn_unit<64, 0>(F.lds, QA + r0 * 256 + hh * 64, 256, KA + b0 * 128 + (hh >> 1) * 64, 128, Hb + b0 * HP + OFF_AV + (hh >> 1) * 64, HP, YS + r0 * 256 + hh * 64, 256, SEQ / 64, 0, wave);
                att::attn_unit<96, 0>(F.lds, QC + r0 * 384 + hh * 96, 384, KC + b0 * 384 + hh * 96, 384, VC + b0 * 256 + hh * 64, 256, YS + ((size_t)2 * M + r0) * 256 + hh * 64, 256, SEQ / 64, 0, wave);
#endif
                { const float* rpb = INP(6) + ((size_t)l * 4 + hh) * 15 * 31; LAS float* tab = (LAS float*)(F.lds + att::RPB_OFF);
                  if (tid < 480) { const int dr = tid >> 5, dc = tid & 31; tab[tid] = (dc < 31) ? rpb[dr * 31 + dc] * LOG2E : 0.f; }
                  __syncthreads(); }
#if DBG_ZERO_B
                for (int i = tid; i < 256 * 8; i += 512) { const int rr = i >> 3, c8 = i & 7; *(u32x4*)(YS + ((size_t)1 * M + r0 + rr) * 256 + hh * 64 + c8 * 8) = (u32x4){0u, 0u, 0u, 0u}; }
#else
                att::attn_unit<64, 1>(F.lds, Hb + r0 * HP + OFF_BQ + hh * 64, HP, Hb + b0 * HP + OFF_BK + hh * 64, HP, Hb + b0 * HP + OFF_BV + hh * 64, HP, YS + ((size_t)1 * M + r0) * 256 + hh * 64, 256, NROWS, qb * 4, wave);
#endif
                {
                    const int t0 = u * 64, s0 = t0 & (SEQ - 1); LAS bf16* tile = (LAS bf16*)F.lds;
                    for (int i = tid; i < 94 * 32; i += 512) { const int rr = i >> 5, c8 = i & 31; const int s = s0 - 15 + rr; u32x4 v = {0u, 0u, 0u, 0u};
                        if (s >= 0 && s < SEQ) v = *(const u32x4*)(Hb + (size_t)(t0 - 15 + rr) * HP + 1792 + c8 * 8);
                        *(LAS u32x4*)(tile + rr * 256 + c8 * 8) = v; }
                    __syncthreads();
                    const float* cw = INP(11) + (size_t)l * 31 * 256; const int c4 = 4 * lane;
                    f32x4 acc[8];
                    { const f32x4 bb = *(const f32x4*)(INP(12) + l * 256 + c4);
#pragma unroll
                      for (int j = 0; j < 8; ++j) acc[j] = bb; }
                    for (int k = 0; k < 31; ++k) { const f32x4 wk = *(const f32x4*)(cw + k * 256 + c4);
#pragma unroll
                        for (int j = 0; j < 8; ++j) { const u32x2 w = *(const LAS u32x2*)(tile + (wave * 8 + j + k) * 256 + c4);
                            acc[j][0] += wk[0] * pg8::bf_lo(w.x); acc[j][1] += wk[1] * pg8::bf_hi(w.x); acc[j][2] += wk[2] * pg8::bf_lo(w.y); acc[j][3] += wk[3] * pg8::bf_hi(w.y); } }
                    const f32x4 lg = *(const f32x4*)(INP(13) + l * 256 + c4), lb = *(const f32x4*)(INP(14) + l * 256 + c4);
#pragma unroll
                    for (int j = 0; j < 8; ++j) { f32x4 v = acc[j]; const float mean = wave_sum((v[0] + v[1]) + (v[2] + v[3])) * (1.f / 256.f); v = v - mean;
                        const float var = wave_sum((v[0] * v[0] + v[1] * v[1]) + (v[2] * v[2] + v[3] * v[3])) * (1.f / 256.f); const float rstd = 1.0f / sqrtf(var + LN_EPS);
                        v = v * rstd * lg + lb;
                        u32x2 o; o.x = pk2(v[0] * pg8::sigmoidf_(v[0]), v[1] * pg8::sigmoidf_(v[1])); o.y = pk2(v[2] * pg8::sigmoidf_(v[2]), v[3] * pg8::sigmoidf_(v[3]));
                        *(u32x2*)(YS + ((size_t)3 * M + t0 + wave * 8 + j) * 256 + c4) = o; }
                    __syncthreads();
                }
            }
        }
        SEAM(pb + 3);
        if (IN(pb + 4) && EN(5)) { WSP;
            pg8::Gemm g{YS, (const bf16*)(wsp + WS_WBR) + (size_t)l * 4 * 1024 * 256, 256}; pg8::SchedMerge S; S.init(G_, bid);
            pg8::EpiMerge E{Gt, MG}; pg8::gemm_phase<pg8::EpiMerge, pg8::SchedMerge, true, true>(F.lds, g, S, E, wave);
        }
        SEAM(pb + 4);
        if (IN(pb + 5) && EN(6)) { WSP;
            pg8::Gemm g{MG, (const bf16*)(wsp + WS_WOUT) + (size_t)l * 1024 * 1024, 1024}; pg8::SchedPlain S; S.init(M / 256, 4, 1024, G_, bid);
            pg8::EpiRes E{XRES, Tb}; pg8::gemm_phase<pg8::EpiRes, pg8::SchedPlain, true, true>(F.lds, g, S, E, wave);
        }
        SEAM(pb + 5);
        if (IN(pb + 6) && EN(7)) { WSP;
            const float* lg = INP(17) + l * DM; const float* lb = INP(18) + l * DM; const float* router = INP(22);
            LAS unsigned* lcnt = (LAS unsigned*)(F.lds + LDSCTL_OFF + 64);
            for (int blk = vcu; blk < 256; blk += G_) {
                if (moe) { if (tid < 8) lcnt[tid] = 0u; __syncthreads(); }
                for (int k = 0; k < 8; ++k) { const int t = blk * 64 + wave * 8 + k; f32x4 v[4];
#pragma unroll
                    for (int j = 0; j < 4; ++j) v[j] = *(const f32x4*)(Tb + (size_t)t * DM + 4 * lane + 256 * j);
                    ln_row(v, lg, lb, lane); store_row_f32(XRES + (size_t)t * DM, v, lane);
                    if (!moe) store_row_bf16(XB + (size_t)t * DM, v, lane);
                    else {
                        float lgt[8] = {0.f, 0.f, 0.f, 0.f, 0.f, 0.f, 0.f, 0.f};
#pragma unroll
                        for (int j = 0; j < 4; ++j)
#pragma unroll
                            for (int e4 = 0; e4 < 4; ++e4) { const float xv = v[j][e4]; const float* rr = router + (size_t)(4 * lane + 256 * j + e4) * 8; const f32x4 ra = *(const f32x4*)rr, rb = *(const f32x4*)(rr + 4);
                                lgt[0] += xv * ra[0]; lgt[1] += xv * ra[1]; lgt[2] += xv * ra[2]; lgt[3] += xv * ra[3]; lgt[4] += xv * rb[0]; lgt[5] += xv * rb[1]; lgt[6] += xv * rb[2]; lgt[7] += xv * rb[3]; }
#pragma unroll
                        for (int e = 0; e < 8; ++e) lgt[e] = wave_sum(lgt[e]);
                        int e0 = 0; float l0 = lgt[0];
#pragma unroll
                        for (int e = 1; e < 8; ++e) if (lgt[e] > l0) { l0 = lgt[e]; e0 = e; }
                        int e1 = -1; float l1 = -3.0e38f;
#pragma unroll
                        for (int e = 0; e < 8; ++e) if (e != e0 && lgt[e] > l1) { l1 = lgt[e]; e1 = e; }
                        const float ex = __expf(l1 - l0); const float w0 = 1.0f / (1.0f + ex), w1 = ex / (1.0f + ex);
                        if (lane == 0) { *(u32x4*)(ROUTE + (size_t)t * 4) = (u32x4){(unsigned)e0, (unsigned)e1, __float_as_uint(w0), __float_as_uint(w1)};
                            __hip_atomic_fetch_add(lcnt + e0, 1u, __ATOMIC_RELAXED, __HIP_MEMORY_SCOPE_WORKGROUP); __hip_atomic_fetch_add(lcnt + e1, 1u, __ATOMIC_RELAXED, __HIP_MEMORY_SCOPE_WORKGROUP); }
                    }
                }
                if (moe) { __syncthreads(); if (tid < 8) CNT[blk * 8 + tid] = lcnt[tid]; __syncthreads(); }
            }
        }
        SEAM(pb + 6);
        if (IN(pb + 7) && moe && EN(8)) { WSP;
            LAS float* scr = (LAS float*)(F.lds + wave * 16384);
            {
                const int per_e = (2 * D_FFE / 32) * 16, nit = NEXP * per_e;
                for (int it = gw; it < nit; it += NGW) { const int e = it / per_e, r = it % per_e, rb = r / 16, kb = r % 16; const int tile = rb >> 3, w = rb & 7;
                    cvt_item(((w < 4) ? INP(23) : INP(24)) + (size_t)e * 1024 * D_FFE, D_FFE, tile * 128 + (w & 3) * 32, kb * 64, false, (bf16*)(wsp + WS_MW13) + (size_t)e * 2 * D_FFE * 1024, 1024, rb * 32, scr, lane); }
            }
            __syncthreads();
            LAS unsigned* L = (LAS unsigned*)(F.lds + LDSCTL_OFF + 128);
            for (int blk = vcu; blk < 256; blk += G_) {
                if (tid < 16) L[tid] = 0u;
                __syncthreads();
                if (tid < 256) { const u32x4 c0 = *(const u32x4*)(CNT + tid * 8), c1 = *(const u32x4*)(CNT + tid * 8 + 4); const unsigned c[8] = {c0.x, c0.y, c0.z, c0.w, c1.x, c1.y, c1.z, c1.w};
#pragma unroll
                    for (int e = 0; e < 8; ++e) { __hip_atomic_fetch_add(L + e, c[e], __ATOMIC_RELAXED, __HIP_MEMORY_SCOPE_WORKGROUP); if (tid < blk) __hip_atomic_fetch_add(L + 8 + e, c[e], __ATOMIC_RELAXED, __HIP_MEMORY_SCOPE_WORKGROUP); } }
                __syncthreads();
                if (tid == 0) { unsigned off = 0; for (int e = 0; e < 8; ++e) { L[16 + e] = off; off += ((L[e] + 255u) >> 8) << 8; }
                    L[24] = off >> 8; }
                __syncthreads();
                if (blk == 0 && tid < MAXTILES) { unsigned e = 0;
#pragma unroll
                    for (unsigned k = 1; k < 8; ++k) if ((unsigned)tid >= (L[16 + k] >> 8) && L[k] > 0u) e = k;
                    ((unsigned char*)(META + 16))[tid] = (unsigned char)e; if (tid == 0) META[0] = L[24]; }
                if (wave == 0) { const int t = blk * 64 + lane; const u32x4 r = *(const u32x4*)(ROUTE + (size_t)t * 4); const int e0 = (int)r.x, e1 = (int)r.y; unsigned s0 = 0, s1 = 0;
                    const unsigned long long lt = (1ull << lane) - 1ull;
#pragma unroll
                    for (int e = 0; e < 8; ++e) { const unsigned long long m0 = __ballot(e0 == e), m1 = __ballot(e1 == e); const unsigned base = L[16 + e] + L[8 + e];
                        if (e0 == e) s0 = base + (unsigned)__popcll(m0 & lt); if (e1 == e) s1 = base + (unsigned)__popcll(m0) + (unsigned)__popcll(m1 & lt); }
                    L[32 + 2 * lane] = s0; L[33 + 2 * lane] = s1; *(u32x2*)(SLOT + (size_t)t * 2) = (u32x2){s0, s1}; }
                __syncthreads();
                for (int k = 0; k < 8; ++k) { const int tl = wave * 8 + k, t = blk * 64 + tl; const unsigned s0 = L[32 + 2 * tl], s1 = L[33 + 2 * tl];
                    bf16* d0 = (bf16*)(wsp + WS_XG) + (size_t)s0 * DM, *d1 = (bf16*)(wsp + WS_XG) + (size_t)s1 * DM;
#pragma unroll
                    for (int j = 0; j < 4; ++j) { const f32x4 v = *(const f32x4*)(XRES + (size_t)t * DM + 4 * lane + 256 * j); u32x2 w; w.x = pk2(v[0], v[1]); w.y = pk2(v[2], v[3]);
                        *(u32x2*)(d0 + 4 * lane + 256 * j) = w; *(u32x2*)(d1 + 4 * lane + 256 * j) = w; } }
                __syncthreads();
            }
        }
        if (moe) SEAM(pb + 7);
        if (IN(pb + 8) && EN(9)) { WSP;
            LAS unsigned char* te = F.lds + LDSCTL_OFF + 1024;
            int ntiles = M / 256;
            if (moe) { ntiles = (int)__hip_atomic_load(META, __ATOMIC_RELAXED, __HIP_MEMORY_SCOPE_AGENT); ntiles = ntiles > MAXTILES ? MAXTILES : ntiles; if (tid < MAXTILES) te[tid] = ((const unsigned char*)(META + 16))[tid]; }
            else { if (tid < MAXTILES) te[tid] = 0; }
            __syncthreads();
            ntiles = __builtin_amdgcn_readfirstlane(ntiles);
            if (!moe) { pg8::Gemm g{XB, (const bf16*)(wsp + WS_W13), 1024}; pg8::SchedGroup S; S.init(ntiles, 2 * D_FF / 256, 1024, G_, bid, te);
                pg8::EpiSwiGLU E{(bf16*)(wsp + WS_HID0), D_FF}; pg8::gemm_phase<pg8::EpiSwiGLU, pg8::SchedGroup, true, true>(F.lds, g, S, E, wave); }
            else { pg8::Gemm g{(const bf16*)(wsp + WS_XG), (const bf16*)(wsp + WS_MW13), 1024}; pg8::SchedGroup S; S.init(ntiles, 2 * D_FFE / 256, 1024, G_, bid, te);
                pg8::EpiSwiGLU E{(bf16*)(wsp + WS_MHID), D_FFE}; pg8::gemm_phase<pg8::EpiSwiGLU, pg8::SchedGroup, true, true>(F.lds, g, S, E, wave); }
        }
        SEAM(pb + 8);
        if (IN(pb + 9) && moe && EN(10)) { WSP;
            LAS float* scr = (LAS float*)(F.lds + wave * 16384);
            const int per_e = 32 * (D_FFE / 64), nit = NEXP * per_e;
            for (int it = gw; it < nit; it += NGW) { const int e = it / per_e, r = it % per_e, rb = r / (D_FFE / 64), kb = r % (D_FFE / 64);
                cvt_item(INP(25) + (size_t)e * D_FFE * 1024, 1024, rb * 32, kb * 64, false, (bf16*)(wsp + WS_MW2) + (size_t)e * 1024 * D_FFE, D_FFE, rb * 32, scr, lane); }
        }
        if (moe) SEAM(pb + 9);
        if (IN(pb + 10) && EN(11)) { WSP;
            LAS unsigned char* te = F.lds + LDSCTL_OFF + 1024;
            if (!moe) { pg8::Gemm g{(const bf16*)(wsp + WS_HID0), (const bf16*)(wsp + WS_W2), D_FF}; pg8::SchedPlain S; S.init(M / 256, 4, D_FF, G_, bid);
                pg8::EpiRes E{XRES, Tb}; pg8::gemm_phase<pg8::EpiRes, pg8::SchedPlain, true, true>(F.lds, g, S, E, wave); }
            else { int ntiles = (int)__hip_atomic_load(META, __ATOMIC_RELAXED, __HIP_MEMORY_SCOPE_AGENT); ntiles = ntiles > MAXTILES ? MAXTILES : ntiles; if (tid < MAXTILES) te[tid] = ((const unsigned char*)(META + 16))[tid];
                __syncthreads(); ntiles = __builtin_amdgcn_readfirstlane(ntiles);
                pg8::Gemm g{(const bf16*)(wsp + WS_MHID), (const bf16*)(wsp + WS_MW2), D_FFE}; pg8::SchedGroup S; S.init(ntiles, 4, D_FFE, G_, bid, te);
                pg8::EpiO E{(bf16*)(wsp + WS_XG)}; pg8::gemm_phase<pg8::EpiO, pg8::SchedGroup, true, true>(F.lds, g, S, E, wave); }
        }
        SEAM(pb + 10);
        if (IN(pb + 11) && EN(12)) { WSP;
            const float* lg = INP(26) + l * DM; const float* lb = INP(27) + l * DM; const bool last = (l == DEPTH - 1);
            const bf16* Ob = (const bf16*)(wsp + WS_XG);
            for (int t = gw; t < M; t += NGW) { f32x4 v[4];
                if (!moe) {
#pragma unroll
                    for (int j = 0; j < 4; ++j) v[j] = *(const f32x4*)(Tb + (size_t)t * DM + 4 * lane + 256 * j);
                } else { const u32x4 r = *(const u32x4*)(ROUTE + (size_t)t * 4); const u32x2 sl = *(const u32x2*)(SLOT + (size_t)t * 2); const float w0 = __uint_as_float(r.z), w1 = __uint_as_float(r.w);
#pragma unroll
                    for (int j = 0; j < 4; ++j) { const f32x4 xv = *(const f32x4*)(XRES + (size_t)t * DM + 4 * lane + 256 * j);
                        const u32x2 a = *(const u32x2*)(Ob + (size_t)sl.x * DM + 4 * lane + 256 * j), b = *(const u32x2*)(Ob + (size_t)sl.y * DM + 4 * lane + 256 * j);
                        v[j][0] = xv[0] * ALPHA + w0 * pg8::bf_lo(a.x) + w1 * pg8::bf_lo(b.x); v[j][1] = xv[1] * ALPHA + w0 * pg8::bf_hi(a.x) + w1 * pg8::bf_hi(b.x);
                        v[j][2] = xv[2] * ALPHA + w0 * pg8::bf_lo(a.y) + w1 * pg8::bf_lo(b.y); v[j][3] = xv[3] * ALPHA + w0 * pg8::bf_hi(a.y) + w1 * pg8::bf_hi(b.y); } }
                ln_row(v, lg, lb, lane);
#if DBG_ZROWS
                if (last && (DBG_ZCOND)) { v[0] = f32x4{}; v[1] = f32x4{}; v[2] = f32x4{}; v[3] = f32x4{}; }
#endif
                if (last) store_row_f32(((float*)INP(28)) + (size_t)t * DM, v, lane);
                else { store_row_f32(XRES + (size_t)t * DM, v, lane); store_row_bf16(XB + (size_t)t * DM, v, lane); } }
        }
        SEAM(pb + 11);
    }
    {
        constexpr int l = 1;
        const int pb = 1 + PH_PER_LAYER * l;
        const bool moe = (l & 1) != 0;
        if (IN(pb + 0) && EN(1)) { WSP;
            pg8::Gemm g{XB, (const bf16*)(wsp + WS_WIN) + (size_t)l * NW_IN * 1024, 1024}; pg8::SchedPlain S; S.init(M / 256, NW_IN / 256, 1024, G_, bid);
            pg8::EpiWin E{Hb, Gt};
            pg8::gemm_phase<pg8::EpiWin, pg8::SchedPlain, true, true>(F.lds, g, S, E, wave);
        }
        SEAM(pb + 0);
        if (IN(pb + 1) && EN(2)) { WSP;
            const float* aqn = INP(4) + l * 64; const float* akn = INP(5) + l * 64; const float* cqn = INP(7) + l * 192; const float* ckvn = INP(8) + l * 128;
            for (int t = gw; t < M; t += NGW) { const int s = t & (SEQ - 1); const bf16* hr = Hb + (size_t)t * HP;
                {
                    const u32x2 w = *(const u32x2*)(hr + 4 * lane); float v[4] = {pg8::bf_lo(w.x), pg8::bf_hi(w.x), pg8::bf_lo(w.y), pg8::bf_hi(w.y)};
                    float ss = v[0] * v[0] + v[1] * v[1] + v[2] * v[2] + v[3] * v[3]; ss = sum16(ss);
                    const float rs = 1.0f / sqrtf(ss * (1.f / 64.f) + RMS_EPS); const int d = 4 * (lane & 15); const f32x4 gg = *(const f32x4*)(aqn + d);
                    const f32x2 cs = *(const f32x2*)(ropeA_c + s * 32 + (d >> 1)), sn = *(const f32x2*)(ropeA_s + s * 32 + (d >> 1));
                    const float a0 = v[0] * rs * gg[0], a1 = v[1] * rs * gg[1], a2 = v[2] * rs * gg[2], a3 = v[3] * rs * gg[3];
                    u32x2 o; o.x = pk2((a0 * cs[0] - a1 * sn[0]) * QS64, (a0 * sn[0] + a1 * cs[0]) * QS64); o.y = pk2((a2 * cs[1] - a3 * sn[1]) * QS64, (a2 * sn[1] + a3 * cs[1]) * QS64);
                    *(u32x2*)(QA + (size_t)t * 256 + 4 * lane) = o; }
                if (lane < 32) {
                    const u32x2 w = *(const u32x2*)(hr + 256 + 4 * lane); float v[4] = {pg8::bf_lo(w.x), pg8::bf_hi(w.x), pg8::bf_lo(w.y), pg8::bf_hi(w.y)};
                    float ss = v[0] * v[0] + v[1] * v[1] + v[2] * v[2] + v[3] * v[3]; ss = sum16(ss);
                    const float rs = 1.0f / sqrtf(ss * (1.f / 64.f) + RMS_EPS); const int d = 4 * (lane & 15); const f32x4 gg = *(const f32x4*)(akn + d);
                    const f32x2 cs = *(const f32x2*)(ropeA_c + s * 32 + (d >> 1)), sn = *(const f32x2*)(ropeA_s + s * 32 + (d >> 1));
                    const float a0 = v[0] * rs * gg[0], a1 = v[1] * rs * gg[1], a2 = v[2] * rs * gg[2], a3 = v[3] * rs * gg[3];
                    u32x2 o; o.x = pk2(a0 * cs[0] - a1 * sn[0], a0 * sn[0] + a1 * cs[0]); o.y = pk2(a2 * cs[1] - a3 * sn[1], a2 * sn[1] + a3 * cs[1]);
                    *(u32x2*)(KA + (size_t)t * 128 + 4 * lane) = o; }
                {
                    float v[4] = {0.f, 0.f, 0.f, 0.f};
                    if (lane < 48) { const u32x2 w = *(const u32x2*)(hr + 1280 + 4 * lane); v[0] = pg8::bf_lo(w.x); v[1] = pg8::bf_hi(w.x); v[2] = pg8::bf_lo(w.y); v[3] = pg8::bf_hi(w.y); }
                    const float ss = wave_sum(v[0] * v[0] + v[1] * v[1] + v[2] * v[2] + v[3] * v[3]); const float rs = 1.0f / sqrtf(ss * (1.f / 192.f) + RMS_EPS);
                    u32x2 o = {0u, 0u};
                    if (lane < 48) { const f32x4 gg = *(const f32x4*)(cqn + 4 * lane); o.x = pk2(v[0] * rs * gg[0], v[1] * rs * gg[1]); o.y = pk2(v[2] * rs * gg[2], v[3] * rs * gg[3]); }
                    *(u32x2*)(CQN + (size_t)t * 256 + 4 * lane) = o; }
                {
                    float v[4] = {0.f, 0.f, 0.f, 0.f};
                    if (lane < 32) { const u32x2 w = *(const u32x2*)(hr + 1536 + 4 * lane); v[0] = pg8::bf_lo(w.x); v[1] = pg8::bf_hi(w.x); v[2] = pg8::bf_lo(w.y); v[3] = pg8::bf_hi(w.y); }
                    const float ss = wave_sum(v[0] * v[0] + v[1] * v[1] + v[2] * v[2] + v[3] * v[3]); const float rs = 1.0f / sqrtf(ss * (1.f / 128.f) + RMS_EPS);
                    u32x2 o = {0u, 0u};
                    if (lane < 32) { const f32x4 gg = *(const f32x4*)(ckvn + 4 * lane); o.x = pk2(v[0] * rs * gg[0], v[1] * rs * gg[1]); o.y = pk2(v[2] * rs * gg[2], v[3] * rs * gg[3]); }
                    *(u32x2*)(CKVN + (size_t)t * 256 + 4 * lane) = o; }
                if (lane < 32) {
                    const int j = lane & 7, hh = lane >> 3; const u32x2 w = *(const u32x2*)(hr + 1664 + 4 * j);
                    const float a0 = pg8::bf_lo(w.x), a1 = pg8::bf_hi(w.x), a2 = pg8::bf_lo(w.y), a3 = pg8::bf_hi(w.y);
                    const f32x2 cs = *(const f32x2*)(ropeC_c + s * 16 + 2 * j), sn = *(const f32x2*)(ropeC_s + s * 16 + 2 * j);
                    u32x2 o; o.x = pk2(a0 * cs[0] - a1 * sn[0], a0 * sn[0] + a1 * cs[0]); o.y = pk2(a2 * cs[1] - a3 * sn[1], a2 * sn[1] + a3 * cs[1]);
                    *(u32x2*)(KC + (size_t)t * 384 + hh * 96 + 64 + 4 * j) = o; }
            }
        }
        SEAM(pb + 1);
        if (IN(pb + 2) && EN(3)) { WSP;
            { pg8::Gemm g{CQN, (const bf16*)(wsp + WS_WUQ) + (size_t)l * 512 * 256, 256}; pg8::SchedPlain S; S.init(M / 256, 2, 256, G_, bid);
              pg8::EpiUq E{QC, ropeC_c, ropeC_s}; pg8::gemm_phase<pg8::EpiUq, pg8::SchedPlain, true, true>(F.lds, g, S, E, wave); }
            { pg8::Gemm g{CKVN, (const bf16*)(wsp + WS_WUKV) + (size_t)l * 512 * 256, 256}; pg8::SchedPlain S; S.init(M / 256, 2, 256, G_, bid);
              pg8::EpiUkv E{KC, VC}; pg8::gemm_phase<pg8::EpiUkv, pg8::SchedPlain, true, true>(F.lds, g, S, E, wave); }
        }
        SEAM(pb + 2);
        if (IN(pb + 3) && EN(4)) { WSP;
            for (int u = vcu; u < 256; u += G_) {
#if DBG_LDSFILL
                for (int i = tid; i < 49152 / 4; i += 512) ((LAS unsigned*)F.lds)[i] = DBG_LDSFILL_VAL; __syncthreads();
#endif
                const int b = u >> 5, hh = (u >> 3) & 3, qb = u & 7; const size_t r0 = (size_t)b * SEQ + qb * 256, b0 = (size_t)b * SEQ;
#if DBG_ZERO_AC
                for (int i = tid; i < 256 * 8; i += 512) { const int rr = i >> 3, c8 = i & 7; *(u32x4*)(YS + ((size_t)0 * M + r0 + rr) * 256 + hh * 64 + c8 * 8) = (u32x4){0u, 0u, 0u, 0u}; *(u32x4*)(YS + ((size_t)2 * M + r0 + rr) * 256 + hh * 64 + c8 * 8) = (u32x4){0u, 0u, 0u, 0u}; }
#else
                att::attn_unit<64, 0>(F.lds, QA + r0 * 256 + hh * 64, 256, KA + b0 * 128 + (hh >> 1) * 64, 128, Hb + b0 * HP + OFF_AV + (hh >> 1) * 64, HP, YS + r0 * 256 + hh * 64, 256, SEQ / 64, 0, wave);
                att::attn_unit<96, 0>(F.lds, QC + r0 * 384 + hh * 96, 384, KC + b0 * 384 + hh * 96, 384, VC + b0 * 256 + hh * 64, 256, YS + ((size_t)2 * M + r0) * 256 + hh * 64, 256, SEQ / 64, 0, wave);
#endif
                { const float* rpb = INP(6) + ((size_t)l * 4 + hh) * 15 * 31; LAS float* tab = (LAS float*)(F.lds + att::RPB_OFF);
                  if (tid < 480) { const int dr = tid >> 5, dc = tid & 31; tab[tid] = (dc < 31) ? rpb[dr * 31 + dc] * LOG2E : 0.f; }
                  __syncthreads(); }
#if DBG_ZERO_B
                for (int i = tid; i < 256 * 8; i += 512) { const int rr = i >> 3, c8 = i & 7; *(u32x4*)(YS + ((size_t)1 * M + r0 + rr) * 256 + hh * 64 + c8 * 8) = (u32x4){0u, 0u, 0u, 0u}; }
#else
                att::attn_unit<64, 1>(F.lds, Hb + r0 * HP + OFF_BQ + hh * 64, HP, Hb + b0 * HP + OFF_BK + hh * 64, HP, Hb + b0 * HP + OFF_BV + hh * 64, HP, YS + ((size_t)1 * M + r0) * 256 + hh * 64, 256, NROWS, qb * 4, wave);
#endif
                {
                    const int t0 = u * 64, s0 = t0 & (SEQ - 1); LAS bf16* tile = (LAS bf16*)F.lds;
                    for (int i = tid; i < 94 * 32; i += 512) { const int rr = i >> 5, c8 = i & 31; const int s = s0 - 15 + rr; u32x4 v = {0u, 0u, 0u, 0u};
                        if (s >= 0 && s < SEQ) v = *(const u32x4*)(Hb + (size_t)(t0 - 15 + rr) * HP + 1792 + c8 * 8);
                        *(LAS u32x4*)(tile + rr * 256 + c8 * 8) = v; }
                    __syncthreads();
                    const float* cw = INP(11) + (size_t)l * 31 * 256; const int c4 = 4 * lane;
                    f32x4 acc[8];
                    { const f32x4 bb = *(const f32x4*)(INP(12) + l * 256 + c4);
#pragma unroll
                      for (int j = 0; j < 8; ++j) acc[j] = bb; }
                    for (int k = 0; k < 31; ++k) { const f32x4 wk = *(const f32x4*)(cw + k * 256 + c4);
#pragma unroll
                        for (int j = 0; j < 8; ++j) { const u32x2 w = *(const LAS u32x2*)(tile + (wave * 8 + j + k) * 256 + c4);
                            acc[j][0] += wk[0] * pg8::bf_lo(w.x); acc[j][1] += wk[1] * pg8::bf_hi(w.x); acc[j][2] += wk[2] * pg8::bf_lo(w.y); acc[j][3] += wk[3] * pg8::bf_hi(w.y); } }
                    const f32x4 lg = *(const f32x4*)(INP(13) + l * 256 + c4), lb = *(const f32x4*)(INP(14) + l * 256 + c4);
#pragma unroll
                    for (int j = 0; j < 8; ++j) { f32x4 v = acc[j]; const float mean = wave_sum((v[0] + v[1]) + (v[2] + v[3])) * (1.f / 256.f); v = v - mean;
                        const float var = wave_sum((v[0] * v[0] + v[1] * v[1]) + (v[2] * v[2] + v[3] * v[3])) * (1.f / 256.f); const float rstd = 1.0f / sqrtf(var + LN_EPS);
                        v = v * rstd * lg + lb;
                        u32x2 o; o.x = pk2(v[0] * pg8::sigmoidf_(v[0]), v[1] * pg8::sigmoidf_(v[1])); o.y = pk2(v[2] * pg8::sigmoidf_(v[2]), v[3] * pg8::sigmoidf_(v[3]));
                        *(u32x2*)(YS + ((size_t)3 * M + t0 + wave * 8 + j) * 256 + c4) = o; }
                    __syncthreads();
                }
            }
        }
        SEAM(pb + 3);
        if (IN(pb + 4) && EN(5)) { WSP;
            pg8::Gemm g{YS, (const bf16*)(wsp + WS_WBR) + (size_t)l * 4 * 1024 * 256, 256}; pg8::SchedMerge S; S.init(G_, bid);
            pg8::EpiMerge E{Gt, MG}; pg8::gemm_phase<pg8::EpiMerge, pg8::SchedMerge, true, true>(F.lds, g, S, E, wave);
        }
        SEAM(pb + 4);
        if (IN(pb + 5) && EN(6)) { WSP;
            pg8::Gemm g{MG, (const bf16*)(wsp + WS_WOUT) + (size_t)l * 1024 * 1024, 1024}; pg8::SchedPlain S; S.init(M / 256, 4, 1024, G_, bid);
            pg8::EpiRes E{XRES, Tb}; pg8::gemm_phase<pg8::EpiRes, pg8::SchedPlain, true, true>(F.lds, g, S, E, wave);
        }
        SEAM(pb + 5);
        if (IN(pb + 6) && EN(7)) { WSP;
            const float* lg = INP(17) + l * DM; const float* lb = INP(18) + l * DM; const float* router = INP(22);
            LAS unsigned* lcnt = (LAS unsigned*)(F.lds + LDSCTL_OFF + 64);
            for (int blk = vcu; blk < 256; blk += G_) {
                if (moe) { if (tid < 8) lcnt[tid] = 0u; __syncthreads(); }
                for (int k = 0; k < 8; ++k) { const int t = blk * 64 + wave * 8 + k; f32x4 v[4];
#pragma unroll
                    for (int j = 0; j < 4; ++j) v[j] = *(const f32x4*)(Tb + (size_t)t * DM + 4 * lane + 256 * j);
                    ln_row(v, lg, lb, lane); store_row_f32(XRES + (size_t)t * DM, v, lane);
                    if (!moe) store_row_bf16(XB + (size_t)t * DM, v, lane);
                    else {
                        float lgt[8] = {0.f, 0.f, 0.f, 0.f, 0.f, 0.f, 0.f, 0.f};
#pragma unroll
                        for (int j = 0; j < 4; ++j)
#pragma unroll
                            for (int e4 = 0; e4 < 4; ++e4) { const float xv = v[j][e4]; const float* rr = router + (size_t)(4 * lane + 256 * j + e4) * 8; const f32x4 ra = *(const f32x4*)rr, rb = *(const f32x4*)(rr + 4);
                                lgt[0] += xv * ra[0]; lgt[1] += xv * ra[1]; lgt[2] += xv * ra[2]; lgt[3] += xv * ra[3]; lgt[4] += xv * rb[0]; lgt[5] += xv * rb[1]; lgt[6] += xv * rb[2]; lgt[7] += xv * rb[3]; }
#pragma unroll
                        for (int e = 0; e < 8; ++e) lgt[e] = wave_sum(lgt[e]);
                        int e0 = 0; float l0 = lgt[0];
#pragma unroll
                        for (int e = 1; e < 8; ++e) if (lgt[e] > l0) { l0 = lgt[e]; e0 = e; }
                        int e1 = -1; float l1 = -3.0e38f;
#pragma unroll
                        for (int e = 0; e < 8; ++e) if (e != e0 && lgt[e] > l1) { l1 = lgt[e]; e1 = e; }
                        const float ex = __expf(l1 - l0); const float w0 = 1.0f / (1.0f + ex), w1 = ex / (1.0f + ex);
                        if (lane == 0) { *(u32x4*)(ROUTE + (size_t)t * 4) = (u32x4){(unsigned)e0, (unsigned)e1, __float_as_uint(w0), __float_as_uint(w1)};
                            __hip_atomic_fetch_add(lcnt + e0, 1u, __ATOMIC_RELAXED, __HIP_MEMORY_SCOPE_WORKGROUP); __hip_atomic_fetch_add(lcnt + e1, 1u, __ATOMIC_RELAXED, __HIP_MEMORY_SCOPE_WORKGROUP); }
                    }
                }
                if (moe) { __syncthreads(); if (tid < 8) CNT[blk * 8 + tid] = lcnt[tid]; __syncthreads(); }
            }
        }
        SEAM(pb + 6);
        if (IN(pb + 7) && moe && EN(8)) { WSP;
            LAS float* scr = (LAS float*)(F.lds + wave * 16384);
            {
                const int per_e = (2 * D_FFE / 32) * 16, nit = NEXP * per_e;
                for (int it = gw; it < nit; it += NGW) { const int e = it / per_e, r = it % per_e, rb = r / 16, kb = r % 16; const int tile = rb >> 3, w = rb & 7;
                    cvt_item(((w < 4) ? INP(23) : INP(24)) + (size_t)e * 1024 * D_FFE, D_FFE, tile * 128 + (w & 3) * 32, kb * 64, false, (bf16*)(wsp + WS_MW13) + (size_t)e * 2 * D_FFE * 1024, 1024, rb * 32, scr, lane); }
            }
            __syncthreads();
            LAS unsigned* L = (LAS unsigned*)(F.lds + LDSCTL_OFF + 128);
            for (int blk = vcu; blk < 256; blk += G_) {
                if (tid < 16) L[tid] = 0u;
                __syncthreads();
                if (tid < 256) { const u32x4 c0 = *(const u32x4*)(CNT + tid * 8), c1 = *(const u32x4*)(CNT + tid * 8 + 4); const unsigned c[8] = {c0.x, c0.y, c0.z, c0.w, c1.x, c1.y, c1.z, c1.w};
#pragma unroll
                    for (int e = 0; e < 8; ++e) { __hip_atomic_fetch_add(L + e, c[e], __ATOMIC_RELAXED, __HIP_MEMORY_SCOPE_WORKGROUP); if (tid < blk) __hip_atomic_fetch_add(L + 8 + e, c[e], __ATOMIC_RELAXED, __HIP_MEMORY_SCOPE_WORKGROUP); } }
                __syncthreads();
                if (tid == 0) { unsigned off = 0; for (int e = 0; e < 8; ++e) { L[16 + e] = off; off += ((L[e] + 255u) >> 8) << 8; }
                    L[24] = off >> 8; }
                __syncthreads();
                if (blk == 0 && tid < MAXTILES) { unsigned e = 0;
#pragma unroll
                    for (unsigned k = 1; k < 8; ++k) if ((unsigned)tid >= (L[16 + k] >> 8) && L[k] > 0u) e = k;
                    ((unsigned char*)(META + 16))[tid] = (unsigned char)e; if (tid == 0) META[0] = L[24]; }
                if (wave == 0) { const int t = blk * 64 + lane; const u32x4 r = *(const u32x4*)(ROUTE + (size_t)t * 4); const int e0 = (int)r.x, e1 = (int)r.y; unsigned s0 = 0, s1 = 0;
                    const unsigned long long lt = (1ull << lane) - 1ull;
#pragma unroll
                    for (int e = 0; e < 8; ++e) { const unsigned long long m0 = __ballot(e0 == e), m1 = __ballot(e1 == e); const unsigned base = L[16 + e] + L[8 + e];
                        if (e0 == e) s0 = base + (unsigned)__popcll(m0 & lt); if (e1 == e) s1 = base + (unsigned)__popcll(m0) + (unsigned)__popcll(m1 & lt); }
                    L[32 + 2 * lane] = s0; L[33 + 2 * lane] = s1; *(u32x2*)(SLOT + (size_t)t * 2) = (u32x2){s0, s1}; }
                __syncthreads();
                for (int k = 0; k < 8; ++k) { const int tl = wave * 8 + k, t = blk * 64 + tl; const unsigned s0 = L[32 + 2 * tl], s1 = L[33 + 2 * tl];
                    bf16* d0 = (bf16*)(wsp + WS_XG) + (size_t)s0 * DM, *d1 = (bf16*)(wsp + WS_XG) + (size_t)s1 * DM;
#pragma unroll
                    for (int j = 0; j < 4; ++j) { const f32x4 v = *(const f32x4*)(XRES + (size_t)t * DM + 4 * lane + 256 * j); u32x2 w; w.x = pk2(v[0], v[1]); w.y = pk2(v[2], v[3]);
                        *(u32x2*)(d0 + 4 * lane + 256 * j) = w; *(u32x2*)(d1 + 4 * lane + 256 * j) = w; } }
                __syncthreads();
            }
        }
        if (moe) SEAM(pb + 7);
        if (IN(pb + 8) && EN(9)) { WSP;
            LAS unsigned char* te = F.lds + LDSCTL_OFF + 1024;
            int ntiles = M / 256;
            if (moe) { ntiles = (int)__hip_atomic_load(META, __ATOMIC_RELAXED, __HIP_MEMORY_SCOPE_AGENT); ntiles = ntiles > MAXTILES ? MAXTILES : ntiles; if (tid < MAXTILES) te[tid] = ((const unsigned char*)(META + 16))[tid]; }
            else { if (tid < MAXTILES) te[tid] = 0; }
            __syncthreads();
            ntiles = __builtin_amdgcn_readfirstlane(ntiles);
            if (!moe) { pg8::Gemm g{XB, (const bf16*)(wsp + WS_W13), 1024}; pg8::SchedGroup S; S.init(ntiles, 2 * D_FF / 256, 1024, G_, bid, te);
                pg8::EpiSwiGLU E{(bf16*)(wsp + WS_HID0), D_FF}; pg8::gemm_phase<pg8::EpiSwiGLU, pg8::SchedGroup, true, true>(F.lds, g, S, E, wave); }
            else { pg8::Gemm g{(const bf16*)(wsp + WS_XG), (const bf16*)(wsp + WS_MW13), 1024}; pg8::SchedGroup S; S.init(ntiles, 2 * D_FFE / 256, 1024, G_, bid, te);
                pg8::EpiSwiGLU E{(bf16*)(wsp + WS_MHID), D_FFE}; pg8::gemm_phase<pg8::EpiSwiGLU, pg8::SchedGroup, true, true>(F.lds, g, S, E, wave); }
        }
        SEAM(pb + 8);
        if (IN(pb + 9) && moe && EN(10)) { WSP;
            LAS float* scr = (LAS float*)(F.lds + wave * 16384);
            const int per_e = 32 * (D_FFE / 64), nit = NEXP * per_e;
            for (int it = gw; it < nit; it += NGW) { const int e = it / per_e, r = it % per_e, rb = r / (D_FFE / 64), kb = r % (D_FFE / 64);
                cvt_item(INP(25) + (size_t)e * D_FFE * 1024, 1024, rb * 32, kb * 64, false, (bf16*)(wsp + WS_MW2) + (size_t)e * 1024 * D_FFE, D_FFE, rb * 32, scr, lane); }
        }
        if (moe) SEAM(pb + 9);
        if (IN(pb + 10) && EN(11)) { WSP;
            LAS unsigned char* te = F.lds + LDSCTL_OFF + 1024;
            if (!moe) { pg8::Gemm g{(const bf16*)(wsp + WS_HID0), (const bf16*)(wsp + WS_W2), D_FF}; pg8::SchedPlain S; S.init(M / 256, 4, D_FF, G_, bid);
                pg8::EpiRes E{XRES, Tb}; pg8::gemm_phase<pg8::EpiRes, pg8::SchedPlain, true, true>(F.lds, g, S, E, wave); }
            else { int ntiles = (int)__hip_atomic_load(META, __ATOMIC_RELAXED, __HIP_MEMORY_SCOPE_AGENT); ntiles = ntiles > MAXTILES ? MAXTILES : ntiles; if (tid < MAXTILES) te[tid] = ((const unsigned char*)(META + 16))[tid];
                __syncthreads(); ntiles = __builtin_amdgcn_readfirstlane(ntiles);
                pg8::Gemm g{(const bf16*)(wsp + WS_MHID), (const bf16*)(wsp + WS_MW2), D_FFE}; pg8::SchedGroup S; S.init(ntiles, 4, D_FFE, G_, bid, te);
                pg8::EpiO E{(bf16*)(wsp + WS_XG)}; pg8::gemm_phase<pg8::EpiO, pg8::SchedGroup, true, true>(F.lds, g, S, E, wave); }
        }
        SEAM(pb + 10);
        if (IN(pb + 11) && EN(12)) { WSP;
            const float* lg = INP(26) + l * DM; const float* lb = INP(27) + l * DM; const bool last = (l == DEPTH - 1);
            const bf16* Ob = (const bf16*)(wsp + WS_XG);
            for (int t = gw; t < M; t += NGW) { f32x4 v[4];
                if (!moe) {
#pragma unroll
                    for (int j = 0; j < 4; ++j) v[j] = *(const f32x4*)(Tb + (size_t)t * DM + 4 * lane + 256 * j);
                } else { const u32x4 r = *(const u32x4*)(ROUTE + (size_t)t * 4); const u32x2 sl = *(const u32x2*)(SLOT + (size_t)t * 2); const float w0 = __uint_as_float(r.z), w1 = __uint_as_float(r.w);
#pragma unroll
                    for (int j = 0; j < 4; ++j) { const f32x4 xv = *(const f32x4*)(XRES + (size_t)t * DM + 4 * lane + 256 * j);
                        const u32x2 a = *(const u32x2*)(Ob + (size_t)sl.x * DM + 4 * lane + 256 * j), b = *(const u32x2*)(Ob + (size_t)sl.y * DM + 4 * lane + 256 * j);
                        v[j][0] = xv[0] * ALPHA + w0 * pg8::bf_lo(a.x) + w1 * pg8::bf_lo(b.x); v[j][1] = xv[1] * ALPHA + w0 * pg8::bf_hi(a.x) + w1 * pg8::bf_hi(b.x);
                        v[j][2] = xv[2] * ALPHA + w0 * pg8::bf_lo(a.y) + w1 * pg8::bf_lo(b.y); v[j][3] = xv[3] * ALPHA + w0 * pg8::bf_hi(a.y) + w1 * pg8::bf_hi(b.y); } }
                ln_row(v, lg, lb, lane);
#if DBG_ZROWS
                if (last && (DBG_ZCOND)) { v[0] = f32x4{}; v[1] = f32x4{}; v[2] = f32x4{}; v[3] = f32x4{}; }
#endif
                if (last) store_row_f32(((float*)INP(28)) + (size_t)t * DM, v, lane);
                else { store_row_f32(XRES + (size_t)t * DM, v, lane); store_row_bf16(XB + (size_t)t * DM, v, lane); } }
        }
        SEAM(pb + 11);
    }
#undef IN
#undef SEAM
}


#if DBG_CHK
#undef XRES
#undef XB
#undef Hb
#undef Gt
#undef Tb
#undef QA
#undef KA
#undef CQN
#undef CKVN
#undef QC
#undef KC
#undef VC
#undef MG
#undef YS
#undef ROUTE
#undef SLOT
#undef CNT
#undef META
namespace chk {
__device__ __forceinline__ float b2f(bf16 v) { return __uint_as_float(((unsigned)v) << 16); }
__device__ __forceinline__ float rbf(float f) { unsigned u = __float_as_uint(f); u = (u + 0x7fffu + ((u >> 16) & 1u)) & 0xffff0000u; return __uint_as_float(u); }
__device__ __forceinline__ float sg(float x) { return 1.0f / (1.0f + expf(-x)); }
__device__ __forceinline__ void rec(unsigned* met, int k, float err) { if (!(err == err)) err = 1e30f; atomicMax(met + k, __float_as_uint(fabsf(err))); }
__device__ __forceinline__ int srow(int i) { return 16 * i + ((i * 5) & 15); }
__device__ __forceinline__ float bsum(float v, float* sh) { const int t = threadIdx.x; __syncthreads(); sh[t] = v; __syncthreads(); for (int s = 128; s > 0; s >>= 1) { if (t < s) sh[t] += sh[t + s]; __syncthreads(); } const float r = sh[0]; __syncthreads(); return r; }
__device__ __forceinline__ float bmax(float v, float* sh) { const int t = threadIdx.x; __syncthreads(); sh[t] = v; __syncthreads(); for (int s = 128; s > 0; s >>= 1) { if (t < s) sh[t] = fmaxf(sh[t], sh[t + s]); __syncthreads(); } const float r = sh[0]; __syncthreads(); return r; }
}
__global__ void __launch_bounds__(256) chk_kernel(Args args, int l, int which) {
    using namespace chk;
    __shared__ float sh[256]; __shared__ float sc[2048]; __shared__ float rowbuf[1024];
    unsigned char* ws = args.ws; unsigned* met = (unsigned*)(ws + WS_CTL) + 1024;
    const int tid = threadIdx.x, t = srow(blockIdx.x), s = t & (SEQ - 1), b0 = t - s;
    const bf16* XB = (const bf16*)(ws + WS_XB); const float* XRES = (const float*)(ws + WS_XRES); const bf16* H = (const bf16*)(ws + WS_H); const bf16* G = (const bf16*)(ws + WS_G);
    const float* T = (const float*)(ws + WS_T); const bf16* QA = (const bf16*)(ws + WS_QA); const bf16* KA = (const bf16*)(ws + WS_KA); const bf16* CQN = (const bf16*)(ws + WS_CQN); const bf16* CKVN = (const bf16*)(ws + WS_CKVN);
    const bf16* QC = (const bf16*)(ws + WS_QC); const bf16* KC = (const bf16*)(ws + WS_KC); const bf16* VC = (const bf16*)(ws + WS_VC); const bf16* MG = (const bf16*)(ws + WS_MG); const bf16* YS = (const bf16*)(ws + WS_YS);
    const bf16* HID0 = (const bf16*)(ws + WS_HID0);
#define in args.in
    float worst = 0.f;
    if (which == 2) {
        const float* w = in[3] + (size_t)l * 1024 * D_IN;
        for (int i = tid; i < 1024; i += 256) rowbuf[i] = b2f(XB[(size_t)t * DM + i]);
        __syncthreads();
        for (int c = tid; c < D_IN; c += 256) {
            if (c >= OFF_GLU + 256 && c < OFF_GATE) continue;
            float h = 0.f; for (int k = 0; k < 1024; ++k) h += rowbuf[k] * rbf(w[(size_t)k * D_IN + c]);
            float ref, got;
            if (c < 1280) { ref = (c >= 512 && c < 768) ? h * QS64 : h; got = b2f(H[(size_t)t * HP + c]); }
            else if (c < OFF_CKV) { ref = h; got = b2f(H[(size_t)t * HP + 1280 + (c - OFF_CQ)]); }
            else if (c < OFF_KPE) { ref = h; got = b2f(H[(size_t)t * HP + 1536 + (c - OFF_CKV)]); }
            else if (c < OFF_GLU) { ref = h; got = b2f(H[(size_t)t * HP + 1664 + (c - OFF_KPE)]); }
            else if (c < OFF_GLU + 256) { float g2 = 0.f; for (int k = 0; k < 1024; ++k) g2 += rowbuf[k] * rbf(w[(size_t)k * D_IN + c + 256]); ref = h * sg(g2); got = b2f(H[(size_t)t * HP + 1792 + (c - OFF_GLU)]); }
            else { ref = sg(h); got = b2f(G[((size_t)((c - OFF_GATE) >> 10) * M + t) * DM + ((c - OFF_GATE) & 1023)]); }
            const float er_ = fabsf(ref - got) / (0.05f + fabsf(ref)); worst = fmaxf(worst, er_);
            if (l == 0 && er_ > DBG_TOL) atomicMax(met + 100, 0xFFFFFFFFu - ((unsigned)blockIdx.x * 8192u + (unsigned)c));
            if (l == 0 && er_ > DBG_TOL) { atomicMax(met + 103, (unsigned)c); atomicAdd(met + (c < OFF_GATE ? 104 : 105), 1u); }
        }
        { const float wm = bmax(worst, sh); if (l == 0 && tid == 0 && wm > DBG_TOL) { atomicAdd(met + 101, 1u); atomicMax(met + 102, (unsigned)blockIdx.x); } rec(met + 32 * l, 2, wm); }
    } else if (which == 3) {
        const float* aqn = in[4] + l * 64; const float* akn = in[5] + l * 64; const float* cqn = in[7] + l * 192; const float* ckvn = in[8] + l * 128;
        const float row = (float)(s / GRIDW), col = (float)(s % GRIDW);
        for (int i = tid; i < 256 + 128; i += 256) { const bool isq = i < 256; const int hd = isq ? i / 64 : (i - 256) / 64, d = i % 64; const bf16* src = H + (size_t)t * HP + (isq ? 0 : 256) + hd * 64;
            float ss = 0.f; for (int k = 0; k < 64; ++k) { const float v = b2f(src[k]); ss += v * v; } const float rs = 1.0f / sqrtf(ss / 64.f + 1e-6f); const float* gn = isq ? aqn : akn;
            const int p = d >> 1; const float inv = powf(10000.f, -(float)(p & 15) / 16.f); const float ang = (p < 16 ? row : col) * inv; const float c_ = cosf(ang), s_ = sinf(ang);
            const float x1 = b2f(src[2 * p]) * rs * gn[2 * p], x2 = b2f(src[2 * p + 1]) * rs * gn[2 * p + 1]; float ref = (d & 1) ? (x1 * s_ + x2 * c_) : (x1 * c_ - x2 * s_); if (isq) ref *= QS64;
            const float got = isq ? b2f(QA[(size_t)t * 256 + i]) : b2f(KA[(size_t)t * 128 + (i - 256)]); worst = fmaxf(worst, fabsf(ref - got) / (0.05f + fabsf(ref))); }
        for (int i = tid; i < 256; i += 256) { float ss = 0.f; for (int k = 0; k < 192; ++k) { const float v = b2f(H[(size_t)t * HP + 1280 + k]); ss += v * v; } const float rs = 1.0f / sqrtf(ss / 192.f + 1e-6f);
            const float ref = i < 192 ? b2f(H[(size_t)t * HP + 1280 + i]) * rs * cqn[i] : 0.f; worst = fmaxf(worst, fabsf(ref - b2f(CQN[(size_t)t * 256 + i])) / (0.05f + fabsf(ref)));
            float s2 = 0.f; for (int k = 0; k < 128; ++k) { const float v = b2f(H[(size_t)t * HP + 1536 + k]); s2 += v * v; } const float r2 = 1.0f / sqrtf(s2 / 128.f + 1e-6f);
            const float ref2 = i < 128 ? b2f(H[(size_t)t * HP + 1536 + i]) * r2 * ckvn[i] : 0.f; worst = fmaxf(worst, fabsf(ref2 - b2f(CKVN[(size_t)t * 256 + i])) / (0.05f + fabsf(ref2))); }
        for (int i = tid; i < 128; i += 256) { const int hh = i / 32, d = i % 32, p = d >> 1; const float inv = powf(10000.f, -(float)(p & 7) / 8.f); const float ang = (p < 8 ? row : col) * inv; const float c_ = cosf(ang), s_ = sinf(ang);
            const float x1 = b2f(H[(size_t)t * HP + 1664 + 2 * p]), x2 = b2f(H[(size_t)t * HP + 1664 + 2 * p + 1]); const float ref = (d & 1) ? (x1 * s_ + x2 * c_) : (x1 * c_ - x2 * s_);
            worst = fmaxf(worst, fabsf(ref - b2f(KC[(size_t)t * 384 + hh * 96 + 64 + d])) / (0.05f + fabsf(ref))); }
        rec(met + 32 * l, 3, bmax(worst, sh));
    } else if (which == 4) {
        const float* wq = in[9] + (size_t)l * 192 * 384; const float* wkv = in[10] + (size_t)l * 128 * 512; const float row = (float)(s / GRIDW), col = (float)(s % GRIDW);
        for (int i = tid; i < 384; i += 256) sc[i] = 0.f; __syncthreads();
        for (int c = tid; c < 384; c += 256) { float a = 0.f; for (int k = 0; k < 192; ++k) a += b2f(CQN[(size_t)t * 256 + k]) * rbf(wq[(size_t)k * 384 + c]); sc[c] = a; }
        __syncthreads();
        for (int c = tid; c < 384; c += 256) { const int j = c % 96; float ref;
            if (j < 64) ref = sc[c]; else { const int d = j - 64, p = d >> 1; const float inv = powf(10000.f, -(float)(p & 7) / 8.f); const float ang = (p < 8 ? row : col) * inv; const float c_ = cosf(ang), s_ = sinf(ang);
                const float x1 = sc[c - d + 2 * p], x2 = sc[c - d + 2 * p + 1]; ref = (d & 1) ? (x1 * s_ + x2 * c_) : (x1 * c_ - x2 * s_); }
            ref *= QS96; worst = fmaxf(worst, fabsf(ref - b2f(QC[(size_t)t * 384 + c])) / (0.05f + fabsf(ref))); }
        for (int c = tid; c < 512; c += 256) { float a = 0.f; for (int k = 0; k < 128; ++k) a += b2f(CKVN[(size_t)t * 256 + k]) * rbf(wkv[(size_t)k * 512 + c]); const int hh = c / 128, j = c % 128;
            const float got = j < 64 ? b2f(KC[(size_t)t * 384 + hh * 96 + j]) : b2f(VC[(size_t)t * 256 + hh * 64 + (j - 64)]); worst = fmaxf(worst, fabsf(a - got) / (0.05f + fabsf(a))); }
        rec(met + 32 * l, 4, bmax(worst, sh));
    } else if (which == 5 || which == 6) {
        const bool isA = which == 5; const int DK = isA ? 64 : 96;
        for (int hh = 0; hh < 4; ++hh) {
            const bf16* q = isA ? QA + (size_t)t * 256 + hh * 64 : QC + (size_t)t * 384 + hh * 96;
            for (int k = tid; k < SEQ; k += 256) { const bf16* kp = isA ? KA + (size_t)(b0 + k) * 128 + (hh >> 1) * 64 : KC + (size_t)(b0 + k) * 384 + hh * 96; float a = 0.f; for (int d = 0; d < DK; ++d) a += b2f(q[d]) * b2f(kp[d]); sc[k] = a; }
            __syncthreads();
            float mx = -1e30f; for (int k = tid; k < SEQ; k += 256) mx = fmaxf(mx, sc[k]); mx = bmax(mx, sh);
            float sm = 0.f; for (int k = tid; k < SEQ; k += 256) { sc[k] = exp2f(sc[k] - mx); sm += sc[k]; } sm = bsum(sm, sh);
            if (tid < 64) { float o = 0.f; for (int k = 0; k < SEQ; ++k) { const float v = isA ? b2f(H[(size_t)(b0 + k) * HP + OFF_AV + (hh >> 1) * 64 + tid]) : b2f(VC[(size_t)(b0 + k) * 256 + hh * 64 + tid]); o += sc[k] * v; } o /= sm;
                const float got = b2f(YS[((size_t)(isA ? 0 : 2) * M + t) * 256 + hh * 64 + tid]); worst = fmaxf(worst, fabsf(o - got) / (0.01f + fabsf(o))); }
            __syncthreads();
        }
        rec(met + 32 * l, which, bmax(worst, sh));
    } else if (which == 7) {
        const int r = s / GRIDW, c = s % GRIDW; int rs = r - 4; rs = rs < 0 ? 0 : (rs > NROWS - 8 ? NROWS - 8 : rs); int cs = c - 8; cs = cs < 0 ? 0 : (cs > GRIDW - 16 ? GRIDW - 16 : cs);
        for (int hh = 0; hh < 4; ++hh) { const float* rpb = in[6] + ((size_t)l * 4 + hh) * 15 * 31; const bf16* q = H + (size_t)t * HP + OFF_BQ + hh * 64;
            if (tid < 128) { const int kr = rs + tid / 16, kc = cs + tid % 16; const bf16* kp = H + (size_t)(b0 + kr * GRIDW + kc) * HP + OFF_BK + hh * 64; float a = 0.f; for (int d = 0; d < 64; ++d) a += b2f(q[d]) * b2f(kp[d]);
                int dc = kc - c + 15; dc = dc < 0 ? 0 : (dc > 30 ? 30 : dc); sc[tid] = a + rpb[(kr - r + 7) * 31 + dc] * LOG2E; }
            __syncthreads();
            float mx = -1e30f; if (tid < 128) mx = sc[tid]; mx = bmax(mx, sh); float sm = 0.f; if (tid < 128) { sc[tid] = exp2f(sc[tid] - mx); sm = sc[tid]; } sm = bsum(sm, sh);
            if (tid < 64) { float o = 0.f; for (int k = 0; k < 128; ++k) { const int kr = rs + k / 16, kc = cs + k % 16; o += sc[k] * b2f(H[(size_t)(b0 + kr * GRIDW + kc) * HP + OFF_BV + hh * 64 + tid]); } o /= sm;
                const float got = b2f(YS[((size_t)1 * M + t) * 256 + hh * 64 + tid]); worst = fmaxf(worst, fabsf(o - got) / (0.05f + fabsf(o))); }
            __syncthreads(); }
        rec(met + 32 * l, 7, bmax(worst, sh));
    } else if (which == 8) {
        const float* cw = in[11] + (size_t)l * 31 * 256; float a = in[12][l * 256 + tid];
        for (int k = 0; k < 31; ++k) { const int s2 = s + k - 15; if (s2 >= 0 && s2 < SEQ) a += cw[k * 256 + tid] * b2f(H[(size_t)(b0 + s2) * HP + 1792 + tid]); }
        const float mean = bsum(a, sh) / 256.f; const float dv = a - mean; const float var = bsum(dv * dv, sh) / 256.f; const float y = dv / sqrtf(var + 1e-5f) * in[13][l * 256 + tid] + in[14][l * 256 + tid]; const float ref = y * sg(y);
        worst = fabsf(ref - b2f(YS[((size_t)3 * M + t) * 256 + tid])) / (0.05f + fabsf(ref)); rec(met + 32 * l, 8, bmax(worst, sh));
    } else if (which == 9) {
        const float* wb = in[15] + (size_t)l * 4 * 256 * 1024;
        for (int d = tid; d < 1024; d += 256) { float m = 0.f; for (int n = 0; n < 4; ++n) { float a = 0.f; for (int c = 0; c < 256; ++c) a += b2f(YS[((size_t)n * M + t) * 256 + c]) * rbf(wb[((size_t)n * 256 + c) * 1024 + d]); m += b2f(G[((size_t)n * M + t) * DM + d]) * a; }
            worst = fmaxf(worst, fabsf(m - b2f(MG[(size_t)t * DM + d])) / (0.02f + fabsf(m))); }
        rec(met + 32 * l, 9, bmax(worst, sh));
    } else if (which == 10) {
        const float* wo = in[16] + (size_t)l * 1024 * 1024;
        for (int d = tid; d < 1024; d += 256) { float a = 0.f; for (int k = 0; k < 1024; ++k) a += b2f(MG[(size_t)t * DM + k]) * rbf(wo[(size_t)k * 1024 + d]); const float ref = ALPHA * XRES[(size_t)t * DM + d] + a;
            worst = fmaxf(worst, fabsf(ref - T[(size_t)t * DM + d]) / (0.05f + fabsf(ref))); }
        rec(met + 32 * l, 10, bmax(worst, sh));
    } else if (which == 11 || which == 14) {
        const float* g = (which == 11 ? in[17] : in[26]) + l * DM; const float* bb = (which == 11 ? in[18] : in[27]) + l * DM;
        float sm = 0.f; for (int d = tid; d < 1024; d += 256) sm += T[(size_t)t * DM + d]; const float mean = bsum(sm, sh) / 1024.f; float vq = 0.f; for (int d = tid; d < 1024; d += 256) { const float dv = T[(size_t)t * DM + d] - mean; vq += dv * dv; }
        const float rstd = 1.0f / sqrtf(bsum(vq, sh) / 1024.f + 1e-5f);
        for (int d = tid; d < 1024; d += 256) { const float ref = (T[(size_t)t * DM + d] - mean) * rstd * g[d] + bb[d]; worst = fmaxf(worst, fabsf(ref - XRES[(size_t)t * DM + d]) / (0.05f + fabsf(ref))); }
        rec(met + 32 * l, which, bmax(worst, sh));
    } else if (which == 12) {
        for (int j = tid; j < D_FF; j += 256) { float a = 0.f, b = 0.f; for (int k = 0; k < 1024; ++k) { const float xv = b2f(XB[(size_t)t * DM + k]); a += xv * rbf(in[19][(size_t)k * D_FF + j]); b += xv * rbf(in[20][(size_t)k * D_FF + j]); }
            const float ref = a * sg(a) * b; worst = fmaxf(worst, fabsf(ref - b2f(HID0[(size_t)t * D_FF + j])) / (0.05f + fabsf(ref))); }
        rec(met + 32 * l, 12, bmax(worst, sh));
    } else if (which == 13) {
        for (int d = tid; d < 1024; d += 256) { float a = 0.f; for (int j = 0; j < D_FF; ++j) a += b2f(HID0[(size_t)t * D_FF + j]) * rbf(in[21][(size_t)j * 1024 + d]); const float ref = ALPHA * XRES[(size_t)t * DM + d] + a;
            worst = fmaxf(worst, fabsf(ref - T[(size_t)t * DM + d]) / (0.05f + fabsf(ref))); }
        rec(met + 32 * l, 13, bmax(worst, sh));
    } else if (which == 1) {
        const float* x = in[0] + (size_t)t * DM; float sm = 0.f; for (int d = tid; d < 1024; d += 256) sm += x[d]; const float mean = bsum(sm, sh) / 1024.f; float vq = 0.f; for (int d = tid; d < 1024; d += 256) { const float dv = x[d] - mean; vq += dv * dv; }
        const float rstd = 1.0f / sqrtf(bsum(vq, sh) / 1024.f + 1e-5f);
        for (int d = tid; d < 1024; d += 256) { const float ref = (x[d] - mean) * rstd * in[1][d] + in[2][d]; worst = fmaxf(worst, fabsf(ref - XRES[(size_t)t * DM + d]) / (0.05f + fabsf(ref))); worst = fmaxf(worst, fabsf(ref - b2f(XB[(size_t)t * DM + d])) / (0.05f + fabsf(ref))); }
        rec(met + 32 * l, 1, bmax(worst, sh));
    } else if (which >= 20) {
        const unsigned* ROUTE = (const unsigned*)(ws + WS_ROUTE); const unsigned* SLOT = (const unsigned*)(ws + WS_SLOT); const unsigned* META = (const unsigned*)(ws + WS_META);
        const int e0 = (int)ROUTE[t * 4], e1 = (int)ROUTE[t * 4 + 1]; const float w0 = __uint_as_float(ROUTE[t * 4 + 2]), w1 = __uint_as_float(ROUTE[t * 4 + 3]); const unsigned s0 = SLOT[t * 2], s1 = SLOT[t * 2 + 1];
        const bf16* XG = (const bf16*)(ws + WS_XG); const bf16* MH = (const bf16*)(ws + WS_MHID);
        if (which == 20) { __shared__ float lg[8]; for (int e = 0; e < 8; ++e) { float a = 0.f; for (int d = tid; d < 1024; d += 256) a += XRES[(size_t)t * DM + d] * in[22][(size_t)d * 8 + e]; a = bsum(a, sh); if (tid == 0) lg[e] = a; }
            __syncthreads(); if (tid == 0) { int b0_ = 0; for (int e = 1; e < 8; ++e) if (lg[e] > lg[b0_]) b0_ = e; int b1_ = -1; for (int e = 0; e < 8; ++e) if (e != b0_ && (b1_ < 0 || lg[e] > lg[b1_])) b1_ = e;
                const float m0 = expf(lg[b0_] - lg[b0_]), m1 = expf(lg[b1_] - lg[b0_]); float er = (b0_ != e0 || b1_ != e1) ? 1.0f : 0.f; er = fmaxf(er, fabsf(m0 / (m0 + m1) - w0)); er = fmaxf(er, fabsf(m1 / (m0 + m1) - w1));
                const unsigned te0 = ((const unsigned char*)(META + 16))[s0 >> 8], te1 = ((const unsigned char*)(META + 16))[s1 >> 8]; if ((int)te0 != e0 || (int)te1 != e1 || s0 >= META[0] * 256 || s1 >= META[0] * 256) er = 2.0f; worst = er; } }
        else if (which == 21) { for (int d = tid; d < 1024; d += 256) { const float ref = rbf(XRES[(size_t)t * DM + d]); worst = fmaxf(worst, fabsf(ref - b2f(XG[(size_t)s0 * DM + d]))); worst = fmaxf(worst, fabsf(ref - b2f(XG[(size_t)s1 * DM + d]))); } }
        else if (which == 22) { for (int q = 0; q < 2; ++q) { const int e = q ? e1 : e0; const unsigned sl = q ? s1 : s0; const float* w1p = in[23] + (size_t)e * 1024 * D_FFE; const float* w3p = in[24] + (size_t)e * 1024 * D_FFE;
                for (int j = tid; j < D_FFE; j += 256) { float a = 0.f, b = 0.f; for (int k = 0; k < 1024; ++k) { const float xv = b2f(XG[(size_t)sl * DM + k]); a += xv * rbf(w1p[(size_t)k * D_FFE + j]); b += xv * rbf(w3p[(size_t)k * D_FFE + j]); }
                    const float ref = a * sg(a) * b; worst = fmaxf(worst, fabsf(ref - b2f(MH[(size_t)sl * D_FFE + j])) / (0.05f + fabsf(ref))); } } }
        else if (which == 23) { for (int q = 0; q < 2; ++q) { const int e = q ? e1 : e0; const unsigned sl = q ? s1 : s0; const float* w2p = in[25] + (size_t)e * D_FFE * 1024;
                for (int d = tid; d < 1024; d += 256) { float a = 0.f; for (int j = 0; j < D_FFE; ++j) a += b2f(MH[(size_t)sl * D_FFE + j]) * rbf(w2p[(size_t)j * 1024 + d]); worst = fmaxf(worst, fabsf(a - b2f(XG[(size_t)sl * DM + d])) / (0.02f + fabsf(a))); } } }
        else if (which == 24) { for (int d = tid; d < 1024; d += 256) rowbuf[d] = ALPHA * XRES[(size_t)t * DM + d] + w0 * b2f(XG[(size_t)s0 * DM + d]) + w1 * b2f(XG[(size_t)s1 * DM + d]); __syncthreads();
            float sm = 0.f; for (int d = tid; d < 1024; d += 256) sm += rowbuf[d]; const float mean = bsum(sm, sh) / 1024.f; float vq = 0.f; for (int d = tid; d < 1024; d += 256) { const float dv = rowbuf[d] - mean; vq += dv * dv; } const float rstd = 1.0f / sqrtf(bsum(vq, sh) / 1024.f + 1e-5f);
            for (int d = tid; d < 1024; d += 256) { const float ref = (rowbuf[d] - mean) * rstd * in[26][l * DM + d] + in[27][l * DM + d]; worst = fmaxf(worst, fabsf(ref - args.out[(size_t)t * DM + d]) / (0.05f + fabsf(ref))); } }
        rec(met + 32 * l, which, bmax(worst, sh));
    }
}
#undef in
__global__ void chk_report(Args args) {
    const unsigned* met = (const unsigned*)(args.ws + WS_CTL) + 1024;
#if DBG_REPORT == 0
    int bad = -1;
    for (int k = 0; k < 64; ++k) { const float v = __uint_as_float(met[k]); if (v > DBG_TOL) { bad = k; break; } }
    if (bad >= 0) args.out[0] = 100.0f + 10.0f * (float)bad;
#elif DBG_REPORT == 1
    int mask = 0; for (int k = 0; k < 4; ++k) if (__uint_as_float(met[DBG_K0 + k]) > DBG_TOL) mask |= 1 << k;
    args.out[0] = 100.0f + 10.0f * (float)mask;
#elif DBG_REPORT == 7
    args.out[0] = 100.0f + 10.0f * (float)(met[101] >> 4);
#elif DBG_REPORT == 8
    args.out[0] = 100.0f + 10.0f * (float)(met[102] >> 5);
#elif DBG_REPORT == 9
    args.out[0] = 100.0f + 10.0f * (float)(met[102] & 31u);
#elif DBG_REPORT == 10
    args.out[0] = 100.0f + 10.0f * (float)(met[103] >> 8);
#elif DBG_REPORT == 11
    args.out[0] = 100.0f + 10.0f * (float)(met[104] > 60u ? 60u : met[104]);
#elif DBG_REPORT == 12
    { unsigned v = met[105] >> 8; args.out[0] = 100.0f + 10.0f * (float)(v > 80u ? 80u : v); }
#elif DBG_REPORT == 13
    { const unsigned key = 0xFFFFFFFFu - met[100]; args.out[0] = 100.0f + 10.0f * (float)(key & 7u); }
#elif DBG_REPORT == 3
    { const unsigned key = 0xFFFFFFFFu - met[100]; args.out[0] = 100.0f + 10.0f * (float)((key >> 13) >> 5); }
#elif DBG_REPORT == 4
    { const unsigned key = 0xFFFFFFFFu - met[100]; args.out[0] = 100.0f + 10.0f * (float)((key >> 13) & 31u); }
#elif DBG_REPORT == 5
    { const unsigned key = 0xFFFFFFFFu - met[100]; args.out[0] = 100.0f + 10.0f * (float)((key & 8191u) >> 8); }
#elif DBG_REPORT == 6
    { const unsigned key = 0xFFFFFFFFu - met[100]; args.out[0] = 100.0f + 10.0f * (float)(((key & 8191u) >> 3) & 31u); }
#else
    float v = __uint_as_float(met[DBG_K0]) * 100.0f; v = v > 9000.f ? 9000.f : v; args.out[0] = 10.0f + v;
#endif
}
#endif

extern "C" void kernel_launch(void* const* d_in, const int* in_sizes, int n_in, void* d_out, int out_size, void* d_ws, size_t ws_size, hipStream_t stream) {
    static int grid = 0;
    if (grid == 0) {
        if (n_in != 28 || in_sizes[0] != M * DM || out_size != M * DM || ws_size < WS_END) { fprintf(stderr, "kernel_launch: unexpected shapes (n_in %d, in0 %d, out %d, ws %zu, need %zu); nothing launched\n", n_in, n_in > 0 ? in_sizes[0] : -1, out_size, ws_size, (size_t)WS_END); grid = -1; return; }
        int dev = 0, cus = 0, per_cu = 0;
        if (hipGetDevice(&dev) != hipSuccess || hipDeviceGetAttribute(&cus, hipDeviceAttributeMultiprocessorCount, dev) != hipSuccess) { grid = -1; return; }
        if (hipFuncSetAttribute((const void*)fwd, hipFuncAttributeMaxDynamicSharedMemorySize, LDS_BYTES) != hipSuccess) { fprintf(stderr, "kernel_launch: hipFuncSetAttribute failed\n"); grid = -1; return; }
        if (hipOccupancyMaxActiveBlocksPerMultiprocessor(&per_cu, (const void*)fwd, NWAVES * 64, LDS_BYTES) != hipSuccess || per_cu < 1) fprintf(stderr, "kernel_launch: occupancy query reports %d\n", per_cu);
        (void)hipGetLastError();
        grid = cus;
    }
    if (grid < 0) return;
    (void)hipMemsetAsync((char*)d_ws + WS_CTL, 0, CTL_ZERO_BYTES, stream);
    Args a{};
    for (int i = 0; i < 28; ++i) a.in[i] = (const float*)d_in[i];
    a.out = (float*)d_out; a.ws = (unsigned char*)d_ws;
#if MK_ONE_LAUNCH
    a.ph_lo = 0; a.ph_hi = 1 + PH_PER_LAYER + 12;
    hipLaunchKernelGGL(fwd, dim3(grid), dim3(NWAVES * 64), LDS_BYTES, stream, a);
#else
    for (int p = 0; p < N_PHASES; ++p) {
        const int r = (p - 1) % PH_PER_LAYER, l = (p - 1) / PH_PER_LAYER;
        if (p > 0 && (r > 11 || ((l & 1) == 0 && (r == 7 || r == 9)))) continue;
        a.ph_lo = p; a.ph_hi = p + 1;
        for (int rep_ = 0; rep_ < 1 + (int)(((REP_MASK) >> (p == 0 ? 0 : r + 1)) & 1u); ++rep_)
        hipLaunchKernelGGL(fwd, dim3(grid), dim3(NWAVES * 64), LDS_BYTES, stream, a);
#if DBG_CHK
        {   const bool moe_ = (l & 1) != 0;
#define CHK(w) hipLaunchKernelGGL(chk_kernel, dim3(1024), dim3(256), 0, stream, a, l, (w))
            if (p == 0) { const int l = 0; CHK(1); }
            else if (r == 0) CHK(2); else if (r == 1) CHK(3); else if (r == 2) CHK(4); else if (r == 3) { CHK(5); CHK(6); CHK(7); CHK(8); } else if (r == 4) CHK(9); else if (r == 5) CHK(10); else if (r == 6) CHK(11);
            else if (r == 7 && moe_) { CHK(20); CHK(21); } else if (r == 8) { if (moe_) CHK(22); else CHK(12); } else if (r == 10) { if (moe_) CHK(23); else CHK(13); } else if (r == 11) { if (moe_) CHK(24); else CHK(14); }
#undef CHK
        }
#endif
    }
#if DBG_CHK
    hipLaunchKernelGGL(chk_report, dim3(1), dim3(1), 0, stream, a);
#endif
#endif
}
```
